# Optimizing an MI355X kernel written in HIP

```python
import jax, jax.numpy as jnp
from jax import lax
import numpy as np

D_MODEL = 1024
BATCH = 8
SEQ = 4096
DEPTH = 2

MEM_LEN = 256
N_EVEN = (DEPTH + 1) // 2
N_ODD = DEPTH // 2
PF_WIDTH = D_MODEL
POOL_GROUPS = 4
POOL_WINDOWS = (2, 4, 8, 16)
POOL_DIM = PF_WIDTH // 2 // POOL_GROUPS
FOURIER_HEADS = 4
FOURIER_DIM = PF_WIDTH // 2 // FOURIER_HEADS
HG_EXPAND = 128
HG_HEADS = D_MODEL // HG_EXPAND
HG_DIM = HG_HEADS * HG_EXPAND
HG_N_PROJ = 5
HG_CHUNK = 64
XA_HEADS = 4
XA_HEAD_DIM = D_MODEL // XA_HEADS
MOE_GROUPS = 4
MOE_PER_GROUP = 8
MOE_EXPERTS = MOE_GROUPS * MOE_PER_GROUP
MOE_TOPK = 2
MOE_HIDDEN = D_MODEL // 2
N_SUBLAYERS = 3
DN_ALPHA = (2.0 * DEPTH) ** 0.25
DN_BETA = (8.0 * DEPTH) ** -0.25
LN_EPS = 1e-5

kernel_name = "hybrid_pool_fourier_hgrn2_hmoe_encoder"


def layer_norm(x, g, b):
    xf = x.astype(jnp.float32)
    mu = jnp.mean(xf, axis=-1, keepdims=True)
    var = jnp.mean(jnp.square(xf - mu), axis=-1, keepdims=True)
    y = (xf - mu) * lax.rsqrt(var + LN_EPS) * g.astype(jnp.float32) + b.astype(jnp.float32)
    return y.astype(x.dtype)


def centred_pool_minus_identity(u):
    S = u.shape[1]
    uf = u.astype(jnp.float32)
    cs = jnp.cumsum(uf, axis=1)
    cs = jnp.concatenate([jnp.zeros_like(cs[:, :1]), cs], axis=1)
    t = np.arange(S)
    outs = []
    for gi, w in enumerate(POOL_WINDOWS):
        lo = np.clip(t - w // 2, 0, S)
        hi = np.clip(t + w // 2, 0, S)
        cnt = (hi - lo).astype(np.float32)
        window_sum = cs[:, hi, gi] - cs[:, lo, gi]
        outs.append(window_sum / cnt[None, :, None])
    pooled = jnp.stack(outs, axis=2)
    return (pooled - uf).astype(u.dtype)


def fourier_heads(u, ln_g):
    uf = u.astype(jnp.float32)
    mu = jnp.mean(uf, axis=-1, keepdims=True)
    var = jnp.mean(jnp.square(uf - mu), axis=-1, keepdims=True)
    un = (uf - mu) * lax.rsqrt(var + LN_EPS) * ln_g.astype(jnp.float32)
    return jnp.real(jnp.fft.fft2(un, axes=(1, 3), norm="ortho")).astype(u.dtype)


def pool_fourier_mixer(x, w_in, pool_w, pool_scale, fourier_ln_g, fourier_w, w_out):
    B, S, _ = x.shape
    half = PF_WIDTH // 2
    u = x @ w_in
    ua = u[..., :half].reshape(B, S, POOL_GROUPS, POOL_DIM)
    ub = u[..., half:].reshape(B, S, FOURIER_HEADS, FOURIER_DIM)
    ya = jnp.einsum('bsgc,gcd->bsgd', centred_pool_minus_identity(ua), pool_w)
    ya = ya.reshape(B, S, half) * pool_scale
    yb = jnp.einsum('bshc,hcd->bshd', fourier_heads(ub, fourier_ln_g), fourier_w)
    yb = yb.reshape(B, S, half)
    return jnp.concatenate([ya, yb], axis=-1) @ w_out


def gla_chunked(q, k, v, logf):
    B, S, H, Dk = q.shape
    Dv = v.shape[-1]
    L = HG_CHUNK
    NC = S // L

    def chunks(a):
        return a.reshape(B, NC, L, H, a.shape[-1]).transpose(0, 3, 1, 2, 4)

    q, k, v, logf = chunks(q), chunks(k), chunks(v), chunks(logf)
    b = jnp.cumsum(logf, axis=3)
    b_ref = b[:, :, :, L // 2:L // 2 + 1]
    qt = q * jnp.exp(b - b_ref)
    kt = k * jnp.exp(b_ref - b)
    scores = jnp.einsum('bhnlk,bhnmk->bhnlm', qt, kt)
    tril = np.tril(np.ones((L, L), dtype=bool))
    scores = jnp.where(tril, scores, 0.0)
    o_intra = jnp.einsum('bhnlm,bhnmv->bhnlv', scores, v)
    b_last = b[:, :, :, -1:]
    u_chunk = jnp.einsum('bhnlk,bhnlv->bhnkv', k * jnp.exp(b_last - b), v)
    decay = jnp.exp(b_last[:, :, :, 0])

    def step(state, inp):
        d, u_c = inp
        return d[..., None] * state + u_c, state

    _, s_prev = lax.scan(step, jnp.zeros((B, H, Dk, Dv), jnp.float32),
                         (jnp.moveaxis(decay, 2, 0), jnp.moveaxis(u_chunk, 2, 0)))
    s_prev = jnp.moveaxis(s_prev, 0, 2)
    o_inter = jnp.einsum('bhnlk,bhnkv->bhnlv', q * jnp.exp(b), s_prev)
    o = o_intra + o_inter
    return o.transpose(0, 2, 3, 1, 4).reshape(B, S, H, Dv)


def hgrn2_mixer(x, w_in, lower_bound, norm_g, w_out):
    B, S, _ = x.shape
    proj = (x @ w_in).astype(jnp.float32).reshape(B, S, HG_N_PROJ, HG_HEADS, HG_EXPAND)
    q = jax.nn.silu(proj[:, :, 0])
    i = proj[:, :, 1]
    g = proj[:, :, 4]
    lb = lower_bound.astype(jnp.float32).reshape(2, HG_HEADS, HG_EXPAND)

    def direction(d, reverse):
        f = lb[d] + (1.0 - lb[d]) * jax.nn.sigmoid(proj[:, :, 2 + d])
        args = (q, 1.0 - f, i, jnp.log(f))
        if reverse:
            return jnp.flip(gla_chunked(*[jnp.flip(a, axis=1) for a in args]), axis=1)
        return gla_chunked(*args)

    o = direction(0, False) + direction(1, True)
    o = o * lax.rsqrt(jnp.mean(jnp.square(o), axis=-1, keepdims=True) + LN_EPS)
    o = o * norm_g.astype(jnp.float32) * jax.nn.silu(g)
    return o.reshape(B, S, HG_DIM).astype(x.dtype) @ w_out


def memory_cross_attention(x, mem, wq, wkv, wo):
    B, S, _ = x.shape
    M = mem.shape[1]
    q = (x @ wq).reshape(B, S, XA_HEADS, XA_HEAD_DIM)
    kv = (mem @ wkv).reshape(B, M, 2, XA_HEADS, XA_HEAD_DIM)
    k, v = kv[:, :, 0], kv[:, :, 1]
    s = jnp.einsum('bshd,bmhd->bhsm', q, k).astype(jnp.float32) * (XA_HEAD_DIM ** -0.5)
    p = jax.nn.softmax(s, axis=-1).astype(x.dtype)
    o = jnp.einsum('bhsm,bmhd->bshd', p, v).reshape(B, S, D_MODEL)
    return o @ wo


def hier_moe(x, w_group, b_group, w_expert, b_expert, w_gate, w_up, w_down):
    B, S, D = x.shape
    T = B * S
    xt = x.reshape(T, D)
    g_logits = (xt @ w_group).astype(jnp.float32) + b_group.astype(jnp.float32)
    p_grp, g_idx = lax.top_k(jax.nn.softmax(g_logits, axis=-1), 1)
    e_logits = ((xt @ w_expert).astype(jnp.float32) + b_expert.astype(jnp.float32))
    e_logits = e_logits.reshape(T, MOE_GROUPS, MOE_PER_GROUP)
    e_sel = jnp.take_along_axis(e_logits, g_idx[:, :, None], axis=1)[:, 0]
    p_exp, e_local = lax.top_k(jax.nn.softmax(e_sel, axis=-1), MOE_TOPK)
    gates = p_grp * p_exp / jnp.sum(p_exp, axis=-1, keepdims=True)
    experts = g_idx * MOE_PER_GROUP + e_local
    e_flat = experts.reshape(-1)
    order = jnp.argsort(e_flat)
    tok_sorted = (jnp.arange(T * MOE_TOPK, dtype=jnp.int32) // MOE_TOPK)[order]
    gate_sorted = gates.reshape(-1)[order]
    sizes = jnp.bincount(e_flat, length=MOE_EXPERTS).astype(jnp.int32)
    xs = xt[tok_sorted]
    h = jax.nn.silu(lax.ragged_dot(xs, w_gate, sizes)) * lax.ragged_dot(xs, w_up, sizes)
    y = lax.ragged_dot(h, w_down, sizes).astype(jnp.float32) * gate_sorted[:, None]
    out = jax.ops.segment_sum(y, tok_sorted, num_segments=T)
    return out.astype(x.dtype).reshape(B, S, D)


def setup_inputs(seed: int = 0) -> dict:
    key = jax.random.key(seed)
    ks = jax.random.split(key, 26)
    D = D_MODEL
    half = PF_WIDTH // 2

    def nrm(k, shape, scale):
        return jax.random.normal(k, shape, jnp.float32) * scale

    xa_wk = nrm(ks[13], (DEPTH, D, D), D ** -0.5)
    xa_wv = nrm(ks[14], (DEPTH, D, D), DN_BETA * D ** -0.5)
    return {
        "x": nrm(ks[0], (BATCH, SEQ, D), 1.0),
        "mem": nrm(ks[1], (BATCH, MEM_LEN, D), 1.0),
        "pf_w_in": nrm(ks[2], (N_EVEN, D, PF_WIDTH), D ** -0.5),
        "pf_pool_w": nrm(ks[3], (N_EVEN, POOL_GROUPS, POOL_DIM, POOL_DIM), POOL_DIM ** -0.5),
        "pf_pool_scale": 1.0 + nrm(ks[4], (N_EVEN, half), 0.02),
        "pf_fourier_ln_g": 1.0 + nrm(ks[5], (N_EVEN, FOURIER_HEADS, FOURIER_DIM), 0.02),
        "pf_fourier_w": nrm(ks[6], (N_EVEN, FOURIER_HEADS, FOURIER_DIM, FOURIER_DIM), FOURIER_DIM ** -0.5),
        "pf_w_out": nrm(ks[7], (N_EVEN, PF_WIDTH, D), DN_BETA * PF_WIDTH ** -0.5),
        "hg_w_in": nrm(ks[8], (N_ODD, D, HG_N_PROJ * HG_DIM), D ** -0.5),
        "hg_lower_bounds": 1.0 + nrm(ks[9], (DEPTH, 2, HG_DIM), 0.1),
        "hg_norm_g": 1.0 + nrm(ks[10], (N_ODD, HG_EXPAND), 0.02),
        "hg_w_out": nrm(ks[11], (N_ODD, HG_DIM, D), DN_BETA * HG_DIM ** -0.5),
        "xa_wq": nrm(ks[12], (DEPTH, D, D), D ** -0.5),
        "xa_wkv": jnp.concatenate([xa_wk, xa_wv], axis=-1),
        "xa_wo": nrm(ks[15], (DEPTH, D, D), DN_BETA * D ** -0.5),
        "moe_w_group": nrm(ks[16], (DEPTH, D, MOE_GROUPS), D ** -0.5),
        "moe_b_group": nrm(ks[17], (DEPTH, MOE_GROUPS), 0.01),
        "moe_w_expert": nrm(ks[18], (DEPTH, D, MOE_EXPERTS), D ** -0.5),
        "moe_b_expert": nrm(ks[19], (DEPTH, MOE_EXPERTS), 0.01),
        "moe_w_gate": nrm(ks[20], (DEPTH, MOE_EXPERTS, D, MOE_HIDDEN), D ** -0.5),
        "moe_w_up": nrm(ks[21], (DEPTH, MOE_EXPERTS, D, MOE_HIDDEN), D ** -0.5),
        "moe_w_down": nrm(ks[22], (DEPTH, MOE_EXPERTS, MOE_HIDDEN, D), DN_BETA * MOE_HIDDEN ** -0.5),
        "ln_g": 1.0 + nrm(ks[23], (DEPTH, N_SUBLAYERS, D), 0.02),
        "ln_b": nrm(ks[24], (DEPTH, N_SUBLAYERS, D), 0.02),
    }


def reference(x, mem, pf_w_in, pf_pool_w, pf_pool_scale, pf_fourier_ln_g, pf_fourier_w, pf_w_out,
              hg_w_in, hg_lower_bounds, hg_norm_g, hg_w_out, xa_wq, xa_wkv, xa_wo,
              moe_w_group, moe_b_group, moe_w_expert, moe_b_expert, moe_w_gate, moe_w_up, moe_w_down,
              ln_g, ln_b):
    lb_all = jnp.cumsum(jax.nn.softmax(hg_lower_bounds.astype(jnp.float32), axis=0), axis=0)
    lb_all = lb_all - lb_all[:1]
    for l in range(DEPTH):
        j = l // 2
        if l % 2 == 0:
            h = pool_fourier_mixer(x, pf_w_in[j], pf_pool_w[j], pf_pool_scale[j],
                                   pf_fourier_ln_g[j], pf_fourier_w[j], pf_w_out[j])
        else:
            h = hgrn2_mixer(x, hg_w_in[j], lb_all[l], hg_norm_g[j], hg_w_out[j])
        x = layer_norm(DN_ALPHA * x + h, ln_g[l, 0], ln_b[l, 0])
        h = memory_cross_attention(x, mem, xa_wq[l], xa_wkv[l], xa_wo[l])
        x = layer_norm(DN_ALPHA * x + h, ln_g[l, 1], ln_b[l, 1])
        h = hier_moe(x, moe_w_group[l], moe_b_group[l], moe_w_expert[l], moe_b_expert[l],
                     moe_w_gate[l], moe_w_up[l], moe_w_down[l])
        x = layer_norm(DN_ALPHA * x + h, ln_g[l, 2], ln_b[l, 2])
    return x
```

```cpp
#include <hip/hip_runtime.h>
#include <stdint.h>
#include <stdio.h>

#ifndef ONE_LAUNCH
#define ONE_LAUNCH 1
#endif

#define LAS __attribute__((address_space(3)))
typedef unsigned short bf16_t;
typedef short bf16x8 __attribute__((ext_vector_type(8)));
typedef float f32x4 __attribute__((ext_vector_type(4)));
typedef float f32x2 __attribute__((ext_vector_type(2)));
typedef unsigned u32x4 __attribute__((ext_vector_type(4)));
typedef unsigned u32x2 __attribute__((ext_vector_type(2)));

constexpr int NB = 8, SEQ = 4096, DM = 1024, NTOK = NB * SEQ, MEML = 256;
constexpr float DN_ALPHA = 1.4142135623730951f;
constexpr float LN_EPS = 1e-5f;
constexpr int NTHR = 512;
constexpr int LDS_BYTES = 163840;
constexpr int LDS_MISC = 160 * 1024 - 256;

constexpr size_t KiB = 1024, MiB = 1024 * 1024;
constexpr size_t WS_CTL = 0;
constexpr size_t CTL_ZERO_BYTES = 16 * KiB;
constexpr size_t WS_W1DFT = 64 * KiB, WS_W2DFT = 128 * KiB, WS_TW = 192 * KiB, WS_PQT = 256 * KiB, WS_LB1 = 512 * KiB;
constexpr size_t WS_HIST = 576 * KiB, WS_TILEEXP = 640 * KiB;
constexpr size_t WS_ROWTOK = 2 * MiB + 512 * KiB;
constexpr size_t WS_TOKE = 1 * MiB, WS_TOKG = 1 * MiB + 256 * KiB, WS_POSS = 1 * MiB + 512 * KiB, WS_GPOS = 2 * MiB;
constexpr size_t WS_W1CAT = 4 * MiB, WS_PFWOUT = 6 * MiB, WS_HGWIN = 8 * MiB, WS_HGWOUT = 18 * MiB;
constexpr size_t WS_WQN1 = 20 * MiB, WS_WOT1 = 22 * MiB, WS_KB1 = 24 * MiB, WS_VB1 = 28 * MiB, WS_KM = 32 * MiB, WS_VW = 48 * MiB, WS_XB = 64 * MiB;
constexpr size_t ARENA = 128 * MiB;
constexpr size_t WS_WGU = ARENA, WS_WDN = ARENA + 64 * MiB;
constexpr size_t ACT = ARENA + 96 * MiB;
constexpr size_t WS_WK = ACT, WS_WV = ACT + 4 * MiB, WS_MEMBF = ACT + 8 * MiB, WS_WQN0 = ACT + 12 * MiB, WS_WOT0 = ACT + 14 * MiB, WS_KB0 = ACT + 16 * MiB, WS_VB0 = ACT + 20 * MiB;
constexpr size_t WS_U = ACT, WS_UN = ACT + 64 * MiB, WS_YCAT = ACT + 96 * MiB, WS_ZT = ACT + 160 * MiB, WS_YP = ACT + 224 * MiB, WS_H0 = ACT;
constexpr size_t WS_SC = ACT, WS_HX = ACT + 64 * MiB;
constexpr size_t WS_XSY = ACT, WS_HID = ACT + 144 * MiB;
constexpr size_t WS_PROJ = ARENA, WS_OF = ARENA + 320 * MiB, WS_OB = ARENA + 384 * MiB;
constexpr size_t WS_END = ARENA + 448 * MiB;
constexpr int MPAD_MAX = 73728;

__device__ __forceinline__ float bf2f(bf16_t b) { return __uint_as_float(((unsigned)b) << 16); }
typedef __bf16 bf16x2_t __attribute__((ext_vector_type(2)));
__device__ __forceinline__ unsigned cvt_pk_bf16(float lo, float hi) { const bf16x2_t v = __builtin_convertvector((f32x2){lo, hi}, bf16x2_t); return __builtin_bit_cast(unsigned, v); }
__device__ __forceinline__ bf16_t f2bf(float f) { return (bf16_t)(cvt_pk_bf16(f, 0.f) & 0xffffu); }
__device__ __forceinline__ float lo_bf(unsigned w) { return __uint_as_float(w << 16); }
__device__ __forceinline__ float hi_bf(unsigned w) { return __uint_as_float(w & 0xffff0000u); }
__device__ __forceinline__ float fast_sigmoid(float p) { return __builtin_amdgcn_rcpf(1.0f + __builtin_amdgcn_exp2f(p * -1.4426950408889634f)); }
#define GAS __attribute__((address_space(1)))
template <class V> __device__ __forceinline__ void gstore(void* p, const V v) { *(GAS V*)p = v; }
template <class V> __device__ __forceinline__ V gload(const void* p) { return *(const GAS V*)p; }
__device__ __forceinline__ float wave_sum(float v) {
#pragma unroll
    for (int o = 32; o >= 1; o >>= 1) v += __shfl_xor(v, o);
    return v;
}
__device__ __forceinline__ float wave_max(float v) {
#pragma unroll
    for (int o = 32; o >= 1; o >>= 1) v = fmaxf(v, __shfl_xor(v, o));
    return v;
}

#define XB_TMO      128
#define XB_XCNT(j)  (256  + 64 * (j))
#define XB_XSUB(j)  (1280 + 64 * (j))
#define XB_XGEN(j)  (2304 + 64 * (j))
#define XB_TOP      3328
#define XB_TOPGEN   3392
#define XCD_BAR_WORDS 3456
#define XB_SPIN_CAP (1u << 22)

__device__ __forceinline__ unsigned xb_ld(unsigned* p)              { return __hip_atomic_load(p, __ATOMIC_RELAXED, __HIP_MEMORY_SCOPE_AGENT); }
__device__ __forceinline__ unsigned xb_add(unsigned* p, unsigned v) { return __hip_atomic_fetch_add(p, v, __ATOMIC_RELAXED, __HIP_MEMORY_SCOPE_AGENT); }
__device__ __forceinline__ unsigned xb_xcc_id() { return (unsigned)__builtin_amdgcn_s_getreg((3 << 11) | 20) & 0xFu; }
#define XB_SPIN(cond, bar) do { unsigned _sp = 0; while (cond) { __builtin_amdgcn_s_sleep(1); \
    if ((++_sp & 255u) == 0u) { if (xb_ld(&(bar)[XB_TMO])) break; if (_sp > XB_SPIN_CAP) { atomicAdd(&(bar)[XB_TMO], 1u); break; } } } } while (0)

struct XcdBarrier { unsigned* bar; unsigned x; volatile LAS unsigned* st; int wave; };

__device__ __forceinline__ XcdBarrier xcd_barrier_post(unsigned* bar, volatile LAS unsigned* st, int wave_id) {
    XcdBarrier b; b.bar = bar; b.x = xb_xcc_id(); b.st = st; b.wave = wave_id;
    if (wave_id == 0 && __builtin_amdgcn_mbcnt_hi(~0u, __builtin_amdgcn_mbcnt_lo(~0u, 0u)) == 0u) (void)xb_add(&bar[XB_XCNT(b.x)], 1u);
    return b;
}
__device__ __forceinline__ void xcd_barrier_complete(unsigned* bar, unsigned x, unsigned& nloc, unsigned& nx) {
    const unsigned G = gridDim.x * gridDim.y * gridDim.z;
    unsigned sum, cnt, mine, sp = 0u;
    for (;;) {
        sum = 0u; cnt = 0u; mine = 0u;
#pragma unroll
        for (unsigned j = 0; j < 16; ++j) { const unsigned c = xb_ld(&bar[XB_XCNT(j)]); sum += c; cnt += (c > 0u) ? 1u : 0u; mine = (j == x) ? c : mine; }
        if (sum == G) break;
        __builtin_amdgcn_s_sleep(1);
        if ((++sp & 255u) == 0u) { if (xb_ld(&bar[XB_TMO])) break; if (sp > XB_SPIN_CAP) { atomicAdd(&bar[XB_TMO], 1u); break; } }
    }
    nloc = mine > 0u ? mine : 1u; nx = cnt > 0u ? cnt : 1u;
}
__device__ __forceinline__ void xcd_barrier_core(const XcdBarrier& b) {
    if (b.wave == 0 && __builtin_amdgcn_mbcnt_hi(~0u, __builtin_amdgcn_mbcnt_lo(~0u, 0u)) == 0u) {
        unsigned* bar = b.bar;
        __builtin_amdgcn_s_waitcnt(0);
        unsigned nloc = b.st[0], nx = b.st[1];
        if (nloc == 0u) { xcd_barrier_complete(bar, b.x, nloc, nx); b.st[0] = nloc; b.st[1] = nx; }
        const unsigned old = xb_add(&bar[XB_XSUB(b.x)], 1u);
        const unsigned gen = old / nloc;
        if (old + 1u == (gen + 1u) * nloc) {
            __builtin_amdgcn_fence(__ATOMIC_RELEASE, "agent");
            asm volatile("s_waitcnt vmcnt(0)" ::: "memory");
            const unsigned og = xb_add(&bar[XB_TOP], 1u);
            const unsigned tg = og / nx;
            if (og + 1u == (tg + 1u) * nx) xb_add(&bar[XB_TOPGEN], 1u);
            else XB_SPIN(xb_ld(&bar[XB_TOPGEN]) == tg, bar);
            __builtin_amdgcn_fence(__ATOMIC_ACQUIRE, "agent");
            xb_add(&bar[XB_XGEN(b.x)], 1u);
            asm volatile("s_waitcnt vmcnt(0)" ::: "memory");
        } else {
            XB_SPIN(xb_ld(&bar[XB_XGEN(b.x)]) == gen, bar);
            __builtin_amdgcn_fence(__ATOMIC_ACQUIRE, "agent");
            asm volatile("s_waitcnt vmcnt(0)" ::: "memory");
        }
    }
}
__device__ __forceinline__ void xcd_barrier(const XcdBarrier& b) {
    asm volatile("s_waitcnt vmcnt(0)" ::: "memory");
    __syncthreads();
    xcd_barrier_core(b);
    __syncthreads();
}

constexpr int BM = 256, BK = 64, HALF = 128, HTB = HALF * BK * 2, STAGE_BYTES = 8 * HTB, NXCD = 8, WGM = 8;

__device__ __forceinline__ int lds_byte(int r, int c) { const int st = (r >> 4) * 2 + (c >> 5), rr = r & 15, cc = c & 31, ob = rr * 64 + cc * 2; return st * 1024 + (ob ^ (((ob >> 9) & 1) << 5)); }
__device__ __forceinline__ void stage_rc(int b, int& R, int& C) { const int st = b / 1024, sb = b % 1024, swz = sb ^ (((sb >> 9) & 1) << 5); R = (st >> 1) * 16 + swz / 64; C = (st & 1) * 32 + (swz % 64) / 2; }
__device__ __forceinline__ int perm32(int rho) { const int n = rho >> 4, i = rho & 15; return 8 * (i >> 2) + 4 * n + (i & 3); }

struct GemmD { const bf16_t* A; const bf16_t* B; int lda, ldb; unsigned kstepA, kstepB; int K; };
struct Unit { int pm, pn, b; unsigned offA, offB; };

struct SchedB {
    static constexpr bool GATHER = false;
    int nM, nN, nB, G, c, bdiv; unsigned bsA_hi, bsA_lo, bsB_hi, bsB_lo, tsA, tsB;
    __device__ __forceinline__ bool next(int i, Unit& u) const {
        const int nMt = nB * nM, nwg = nMt * nN;
        const long L = (unsigned)i * G + c; if (L >= nwg) return false;
        int wgid = (int)L; { const int q = nwg / NXCD, r = nwg % NXCD, xcd = wgid % NXCD, off = wgid / NXCD; wgid = (xcd < r ? xcd * (q + 1) : r * (q + 1) + (xcd - r) * q) + off; }
        const int nig = WGM * nN, gid = wgid / nig, fm = gid * WGM, gsz = (nMt - fm) < WGM ? (nMt - fm) : WGM;
        const int pmt = fm + ((wgid % nig) % gsz); u.pn = (wgid % nig) / gsz;
        u.b = pmt / nM; u.pm = pmt - u.b * nM;
        const int hi = u.b / bdiv, lo = u.b - hi * bdiv;
        u.offA = (unsigned)hi * bsA_hi + (unsigned)lo * bsA_lo + (unsigned)u.pm * tsA; u.offB = (unsigned)hi * bsB_hi + (unsigned)lo * bsB_lo + (unsigned)u.pn * tsB;
        return true;
    }
};
template <bool GATHER_>
struct SchedMoe {
    static constexpr bool GATHER = GATHER_;
    int nM, nN, G, c; const int* tile_exp; unsigned tsA, tsB, esB; const int* rowtok;
    __device__ __forceinline__ bool next(int i, Unit& u) const {
        const int nwg = nM * nN;
        const long L = (unsigned)i * G + c; if (L >= nwg) return false;
        int wgid = (int)L; { const int q = nwg / NXCD, r = nwg % NXCD, xcd = wgid % NXCD, off = wgid / NXCD; wgid = (xcd < r ? xcd * (q + 1) : r * (q + 1) + (xcd - r) * q) + off; }
        const int nig = WGM * nN, gid = wgid / nig, fm = gid * WGM, gsz = (nM - fm) < WGM ? (nM - fm) : WGM;
        u.pm = fm + ((wgid % nig) % gsz); u.pn = (wgid % nig) / gsz;
        u.b = __builtin_amdgcn_readfirstlane(tile_exp[u.pm]);
        u.offA = (unsigned)u.pm * tsA; u.offB = (unsigned)u.b * esB + (unsigned)u.pn * tsB;
        return true;
    }
};

struct EpiBf16 {
    static constexpr bool PERM = true;
    bf16_t* O; int ldc; int bdiv; unsigned bs_hi, bs_lo;
    __device__ __forceinline__ void operator()(f32x4 (&acc)[2][2][4][2], const Unit& u, int wr, int wc, int fr_, int fq_) const {
        int fr = fr_, fq = fq_; asm volatile("" : "+v"(fr), "+v"(fq));
        const int hi = u.b / bdiv, lo = u.b - hi * bdiv;
        bf16_t* base = O + (size_t)((unsigned)hi * bs_hi + (unsigned)lo * bs_lo);
        const int row0 = u.pm * BM + wr * 64 + fr, col0 = u.pn * BM + wc * 32 + 8 * fq;
#pragma unroll
        for (int ai = 0; ai < 2; ++ai)
#pragma unroll
            for (int m = 0; m < 4; ++m) { bf16_t* rowp = base + (size_t)(row0 + ai * HALF + m * 16) * ldc + col0;
#pragma unroll
                for (int bj = 0; bj < 2; ++bj) { const f32x4 v0 = acc[ai][bj][m][0], v1 = acc[ai][bj][m][1];
                    u32x4 w; w.x = cvt_pk_bf16(v0[0], v0[1]); w.y = cvt_pk_bf16(v0[2], v0[3]); w.z = cvt_pk_bf16(v1[0], v1[1]); w.w = cvt_pk_bf16(v1[2], v1[3]);
                    gstore<u32x4>(rowp + bj * HALF, w); } }
    }
};
struct EpiSoftmax {
    static constexpr bool PERM = true;
    bf16_t* P; float scale; LAS float* ex;
    __device__ __forceinline__ void operator()(f32x4 (&acc)[2][2][4][2], const Unit& u, int wr, int wc, int fr_, int fq_) const {
        int fr = fr_, fq = fq_; asm volatile("" : "+v"(fr), "+v"(fq));
#pragma unroll
        for (int ai = 0; ai < 2; ++ai)
#pragma unroll
            for (int m = 0; m < 4; ++m) {
                float mx = -3.0e38f;
#pragma unroll
                for (int bj = 0; bj < 2; ++bj)
#pragma unroll
                    for (int n = 0; n < 2; ++n) { acc[ai][bj][m][n] = acc[ai][bj][m][n] * scale; const f32x4 x = acc[ai][bj][m][n]; mx = fmaxf(mx, fmaxf(fmaxf(x[0], x[1]), fmaxf(x[2], x[3]))); }
                mx = fmaxf(mx, __shfl_xor(mx, 16)); mx = fmaxf(mx, __shfl_xor(mx, 32));
                float sm = 0.f;
#pragma unroll
                for (int bj = 0; bj < 2; ++bj)
#pragma unroll
                    for (int n = 0; n < 2; ++n) { f32x4 x = acc[ai][bj][m][n]; x[0] = __expf(x[0] - mx); x[1] = __expf(x[1] - mx); x[2] = __expf(x[2] - mx); x[3] = __expf(x[3] - mx); acc[ai][bj][m][n] = x; sm += (x[0] + x[1]) + (x[2] + x[3]); }
                sm += __shfl_xor(sm, 16); sm += __shfl_xor(sm, 32);
                if (fq == 0) *(LAS f32x2*)(ex + ((ai * HALF + wr * 64 + m * 16 + fr) * 4 + wc) * 2) = (f32x2){mx, sm};
            }
        asm volatile("s_waitcnt lgkmcnt(0)" ::: "memory"); __builtin_amdgcn_s_barrier(); asm volatile("" ::: "memory");
        bf16_t* base = P + ((size_t)(u.b >> 2) * SEQ + (size_t)(u.pm * BM + wr * 64 + fr)) * 1024 + (u.b & 3) * 256 + wc * 32 + 8 * fq;
#pragma unroll
        for (int ai = 0; ai < 2; ++ai)
#pragma unroll
            for (int m = 0; m < 4; ++m) {
                const LAS float* ep = ex + (ai * HALF + wr * 64 + m * 16 + fr) * 8;
                const f32x4 a = *(const LAS f32x4*)ep, b = *(const LAS f32x4*)(ep + 4);
                const float M = fmaxf(fmaxf(a[0], a[2]), fmaxf(b[0], b[2]));
                const float tot = a[1] * __expf(a[0] - M) + a[3] * __expf(a[2] - M) + b[1] * __expf(b[0] - M) + b[3] * __expf(b[2] - M);
                const float f = __expf(ep[2 * wc] - M) / tot;
                bf16_t* rowp = base + (size_t)(ai * HALF + m * 16) * 1024;
#pragma unroll
                for (int bj = 0; bj < 2; ++bj) { const f32x4 v0 = acc[ai][bj][m][0] * f, v1 = acc[ai][bj][m][1] * f;
                    u32x4 w; w.x = cvt_pk_bf16(v0[0], v0[1]); w.y = cvt_pk_bf16(v0[2], v0[3]); w.z = cvt_pk_bf16(v1[0], v1[1]); w.w = cvt_pk_bf16(v1[2], v1[3]);
                    gstore<u32x4>(rowp + bj * HALF, w); }
            }
    }
};
struct EpiFft1 {
    static constexpr bool PERM = true;
    bf16_t* Y; const float* tw;
    __device__ __forceinline__ void operator()(f32x4 (&acc)[2][2][4][2], const Unit& u, int wr, int wc, int fr_, int fq_) const {
        int fr = fr_, fq = fq_; asm volatile("" : "+v"(fr), "+v"(fq));
        bf16_t* base = Y + (size_t)u.b * (64 * 128 * 2 * 64);
#pragma unroll
        for (int bj = 0; bj < 2; ++bj) {
            const int c0 = u.pn * BM + bj * HALF + wc * 32 + 8 * fq, d = c0 >> 6, a0 = c0 & 63;
#pragma unroll
            for (int hf = 0; hf < 2; ++hf) {
                const int e = 32 * wr + 16 * hf + fr;
                const float* twp = tw + ((size_t)e * 64 + a0) * 2;
                const f32x4 t0 = gload<f32x4>(twp), t1 = gload<f32x4>(twp + 4), t2 = gload<f32x4>(twp + 8), t3 = gload<f32x4>(twp + 12);
                const f32x4 re0 = acc[0][bj][hf][0], re1 = acc[0][bj][hf][1], im0 = acc[0][bj][hf + 2][0], im1 = acc[0][bj][hf + 2][1];
                float yr[8], yi[8];
                yr[0] = re0[0] * t0[0] - im0[0] * t0[1]; yi[0] = re0[0] * t0[1] + im0[0] * t0[0];
                yr[1] = re0[1] * t0[2] - im0[1] * t0[3]; yi[1] = re0[1] * t0[3] + im0[1] * t0[2];
                yr[2] = re0[2] * t1[0] - im0[2] * t1[1]; yi[2] = re0[2] * t1[1] + im0[2] * t1[0];
                yr[3] = re0[3] * t1[2] - im0[3] * t1[3]; yi[3] = re0[3] * t1[3] + im0[3] * t1[2];
                yr[4] = re1[0] * t2[0] - im1[0] * t2[1]; yi[4] = re1[0] * t2[1] + im1[0] * t2[0];
                yr[5] = re1[1] * t2[2] - im1[1] * t2[3]; yi[5] = re1[1] * t2[3] + im1[1] * t2[2];
                yr[6] = re1[2] * t3[0] - im1[2] * t3[1]; yi[6] = re1[2] * t3[1] + im1[2] * t3[0];
                yr[7] = re1[3] * t3[2] - im1[3] * t3[3]; yi[7] = re1[3] * t3[3] + im1[3] * t3[2];
                bf16_t* p = base + (((size_t)e * 128 + d) * 2) * 64 + a0;
                u32x4 wr4, wi4;
                wr4.x = cvt_pk_bf16(yr[0], yr[1]); wr4.y = cvt_pk_bf16(yr[2], yr[3]); wr4.z = cvt_pk_bf16(yr[4], yr[5]); wr4.w = cvt_pk_bf16(yr[6], yr[7]);
                wi4.x = cvt_pk_bf16(yi[0], yi[1]); wi4.y = cvt_pk_bf16(yi[2], yi[3]); wi4.z = cvt_pk_bf16(yi[4], yi[5]); wi4.w = cvt_pk_bf16(yi[6], yi[7]);
                gstore<u32x4>(p, wr4); gstore<u32x4>(p + 64, wi4);
            }
        }
    }
};
struct EpiFft2 {
    static constexpr bool PERM = true;
    bf16_t* Yc;
    __device__ __forceinline__ void operator()(f32x4 (&acc)[2][2][4][2], const Unit& u, int wr, int wc, int fr_, int fq_) const {
        int fr = fr_, fq = fq_; asm volatile("" : "+v"(fr), "+v"(fq));
        if (wr != 0) return;
        const int b = u.b >> 2, h = u.b & 3;
#pragma unroll
        for (int bj = 0; bj < 2; ++bj) {
            const int n0 = u.pn * BM + bj * HALF + wc * 32 + 8 * fq, e = n0 >> 7, d0 = n0 & 127;
#pragma unroll
            for (int m = 0; m < 4; ++m) {
                const int c = 16 * m + fr, sp = 64 * c + e;
                bf16_t* p = Yc + ((size_t)(b * SEQ + sp)) * DM + 512 + h * 128 + d0;
                const f32x4 v0 = acc[0][bj][m][0], v1 = acc[0][bj][m][1];
                u32x4 w; w.x = cvt_pk_bf16(v0[0], v0[1]); w.y = cvt_pk_bf16(v0[2], v0[3]); w.z = cvt_pk_bf16(v1[0], v1[1]); w.w = cvt_pk_bf16(v1[2], v1[3]);
                *(u32x4*)p = w;
            }
        }
    }
};
struct EpiGU {
    static constexpr bool PERM = true;
    bf16_t* Hd;
    __device__ __forceinline__ void operator()(f32x4 (&acc)[2][2][4][2], const Unit& u, int wr, int wc, int fr_, int fq_) const {
        int fr = fr_, fq = fq_; asm volatile("" : "+v"(fr), "+v"(fq));
        const int row0 = u.pm * BM + wr * 64 + fr, col0 = u.pn * 128 + wc * 32 + 8 * fq;
#pragma unroll
        for (int ai = 0; ai < 2; ++ai)
#pragma unroll
            for (int m = 0; m < 4; ++m) {
                float o[8];
#pragma unroll
                for (int n = 0; n < 2; ++n)
#pragma unroll
                    for (int j = 0; j < 4; ++j) { const float g = acc[ai][0][m][n][j], up = acc[ai][1][m][n][j]; o[n * 4 + j] = g * fast_sigmoid(g) * up; }
                u32x4 w; w.x = cvt_pk_bf16(o[0], o[1]); w.y = cvt_pk_bf16(o[2], o[3]); w.z = cvt_pk_bf16(o[4], o[5]); w.w = cvt_pk_bf16(o[6], o[7]);
                gstore<u32x4>(Hd + (size_t)(row0 + ai * HALF + m * 16) * 512 + col0, w);
            }
    }
};
struct EpiDown {
    static constexpr bool PERM = true;
    bf16_t* Y; const float* gpos;
    __device__ __forceinline__ void operator()(f32x4 (&acc)[2][2][4][2], const Unit& u, int wr, int wc, int fr_, int fq_) const {
        int fr = fr_, fq = fq_; asm volatile("" : "+v"(fr), "+v"(fq));
        const int row0 = u.pm * BM + wr * 64 + fr, col0 = u.pn * BM + wc * 32 + 8 * fq;
#pragma unroll
        for (int ai = 0; ai < 2; ++ai)
#pragma unroll
            for (int m = 0; m < 4; ++m) { const int row = row0 + ai * HALF + m * 16; const float gt = gpos[row]; bf16_t* rowp = Y + (size_t)row * DM + col0;
#pragma unroll
                for (int bj = 0; bj < 2; ++bj) { const f32x4 v0 = acc[ai][bj][m][0] * gt, v1 = acc[ai][bj][m][1] * gt;
                    u32x4 w; w.x = cvt_pk_bf16(v0[0], v0[1]); w.y = cvt_pk_bf16(v0[2], v0[3]); w.z = cvt_pk_bf16(v1[0], v1[1]); w.w = cvt_pk_bf16(v1[2], v1[3]);
                    gstore<u32x4>(rowp + bj * HALF, w); } }
    }
};
struct EpiProjA {
    static constexpr bool PERM = true;
    bf16_t* P;
    __device__ __forceinline__ void operator()(f32x4 (&acc)[2][2][4][2], const Unit& u, int wr, int wc, int fr_, int fq_) const {
        int fr = fr_, fq = fq_; asm volatile("" : "+v"(fr), "+v"(fq));
        const int sec = u.pn >> 2;
        const int row0 = u.pm * BM + wr * 64 + fr, col0 = (sec == 2 ? 4096 : sec * 1024) + (u.pn & 3) * BM + wc * 32 + 8 * fq;
        if (sec == 1) {
#pragma unroll
            for (int ai = 0; ai < 2; ++ai)
#pragma unroll
                for (int m = 0; m < 4; ++m) { bf16_t* rowp = P + (size_t)(row0 + ai * HALF + m * 16) * 5120 + col0;
#pragma unroll
                    for (int bj = 0; bj < 2; ++bj) { const f32x4 v0 = acc[ai][bj][m][0], v1 = acc[ai][bj][m][1];
                        u32x4 w; w.x = cvt_pk_bf16(v0[0], v0[1]); w.y = cvt_pk_bf16(v0[2], v0[3]); w.z = cvt_pk_bf16(v1[0], v1[1]); w.w = cvt_pk_bf16(v1[2], v1[3]);
                        gstore<u32x4>(rowp + bj * HALF, w); } }
        } else {
#pragma unroll
            for (int ai = 0; ai < 2; ++ai)
#pragma unroll
                for (int m = 0; m < 4; ++m) { bf16_t* rowp = P + (size_t)(row0 + ai * HALF + m * 16) * 5120 + col0;
#pragma unroll
                    for (int bj = 0; bj < 2; ++bj) {
                        float o[8];
#pragma unroll
                        for (int n = 0; n < 2; ++n)
#pragma unroll
                            for (int j = 0; j < 4; ++j) { const float p = acc[ai][bj][m][n][j]; o[n * 4 + j] = p * fast_sigmoid(p); }
                        u32x4 w; w.x = cvt_pk_bf16(o[0], o[1]); w.y = cvt_pk_bf16(o[2], o[3]); w.z = cvt_pk_bf16(o[4], o[5]); w.w = cvt_pk_bf16(o[6], o[7]);
                        gstore<u32x4>(rowp + bj * HALF, w); } }
        }
    }
};
struct EpiProjB {
    static constexpr bool PERM = true;
    bf16_t* P; const float* lb;
    __device__ __forceinline__ void operator()(f32x4 (&acc)[2][2][4][2], const Unit& u, int wr, int wc, int fr_, int fq_) const {
        int fr = fr_, fq = fq_; asm volatile("" : "+v"(fr), "+v"(fq));
        const int row0 = u.pm * BM + wr * 64 + fr, col0 = u.pn * BM + wc * 32 + 8 * fq;
        float lbv[2][8];
#pragma unroll
        for (int bj = 0; bj < 2; ++bj) { const float* lp = lb + col0 + bj * HALF; const f32x4 l0 = *(const f32x4*)lp, l1 = gload<f32x4>(lp + 4);
#pragma unroll
            for (int j = 0; j < 4; ++j) { lbv[bj][j] = l0[j]; lbv[bj][4 + j] = l1[j]; } }
#pragma unroll
        for (int ai = 0; ai < 2; ++ai)
#pragma unroll
            for (int m = 0; m < 4; ++m) { bf16_t* rowp = P + (size_t)(row0 + ai * HALF + m * 16) * 5120 + 2048 + col0;
#pragma unroll
                for (int bj = 0; bj < 2; ++bj) {
                    float o[8];
#pragma unroll
                    for (int n = 0; n < 2; ++n)
#pragma unroll
                        for (int j = 0; j < 4; ++j) { const float sg = fast_sigmoid(acc[ai][bj][m][n][j]); o[n * 4 + j] = __builtin_amdgcn_logf(sg + lbv[bj][n * 4 + j] * (1.0f - sg)); }
                    u32x4 w; w.x = cvt_pk_bf16(o[0], o[1]); w.y = cvt_pk_bf16(o[2], o[3]); w.z = cvt_pk_bf16(o[4], o[5]); w.w = cvt_pk_bf16(o[6], o[7]);
                    gstore<u32x4>(rowp + bj * HALF, w); } }
    }
};

template <class Epi, class Sched>
__device__ __forceinline__ void gemm_phase(LAS unsigned char* lds, const GemmD g, const Sched& S, const Epi& E, const int wave_id) {
    int lane_ = (int)__builtin_amdgcn_mbcnt_hi(~0u, __builtin_amdgcn_mbcnt_lo(~0u, 0u)); asm volatile("" : "+v"(lane_));
    const int lane = lane_, wid = wave_id, tid = wid * 64 + lane, wr = wid >> 2, wc = wid & 3, fr = lane & 15, fq = lane >> 4;
    const int nt = g.K / BK;
    unsigned voffA[2], voffB[2];
#pragma unroll
    for (int i = 0; i < 2; ++i) { int R, C; stage_rc(tid * 16 + i * 8192, R, C); const int Rb = Epi::PERM ? ((R & ~31) + perm32(R & 31)) : R;
        voffA[i] = (unsigned)(R * g.lda + C) * 2u; voffB[i] = (unsigned)(Rb * g.ldb + C) * 2u; }
    const unsigned kstepA = g.kstepA, kstepB = g.kstepB;
    const unsigned hstepA = (unsigned)HALF * g.lda * 2, hstepB = (unsigned)HALF * g.ldb * 2;
    unsigned gcur[2][2], gnxt[2][2]; int gR[2], gC[2];
#pragma unroll
    for (int i = 0; i < 2; ++i) { stage_rc(tid * 16 + i * 8192, gR[i], gC[i]); }
#define PG8_GLOAD(dst, pm_) do { if constexpr (Sched::GATHER) { _Pragma("unroll") for (int h_ = 0; h_ < 2; ++h_) _Pragma("unroll") for (int i_ = 0; i_ < 2; ++i_) \
        dst[h_][i_] = (unsigned)S.rowtok[(pm_) * BM + h_ * HALF + gR[i_]] * (unsigned)(g.lda * 2) + (unsigned)gC[i_] * 2u; } } while (0)
#define PG8_STAGE_A(b, h, pn_, pg_, gv_) do { if constexpr (Sched::GATHER) PG8_STAGE(PG8_SA(b, h), pg_, gv_); else PG8_STAGE(PG8_SA(b, h), pn_, voffA); } while (0)
    const unsigned ldsw = (unsigned)wid * 1024u;
    const int aoff = lds_byte(wr * 64 + fr, fq * 8), boff = lds_byte(wc * 32 + fr, fq * 8);
#define PG8_SA(b, h) (((b) * 2 + (h)) * HTB)
#define PG8_SB(b, h) ((4 + (b) * 2 + (h)) * HTB)
#define PG8_STAGE(bufoff, gbase, voff) do { _Pragma("unroll") for (int _i = 0; _i < 2; ++_i) \
        __builtin_amdgcn_global_load_lds((const unsigned*)((const char*)(gbase) + (voff)[_i]), (LAS unsigned*)(lds + (bufoff) + ldsw + _i * 8192), 16, 0, 0); } while (0)
#define PG8_LDA(dst, b, h) do { _Pragma("unroll") for (int m = 0; m < 4; ++m) _Pragma("unroll") for (int k = 0; k < 2; ++k) dst[m][k] = *(const LAS bf16x8*)(lds + PG8_SA(b, h) + aoff + m * 2048 + k * 1024); } while (0)
#define PG8_LDB(dst, b, h) do { _Pragma("unroll") for (int n = 0; n < 2; ++n) _Pragma("unroll") for (int k = 0; k < 2; ++k) dst[n][k] = *(const LAS bf16x8*)(lds + PG8_SB(b, h) + boff + n * 2048 + k * 1024); } while (0)
#define PG8_MMA(ai, bj, At, Bt) do { __builtin_amdgcn_s_setprio(1); _Pragma("unroll") for (int m = 0; m < 4; ++m) _Pragma("unroll") for (int n = 0; n < 2; ++n) _Pragma("unroll") for (int k = 0; k < 2; ++k) \
        acc[ai][bj][m][n] = __builtin_amdgcn_mfma_f32_16x16x32_bf16(Bt[n][k], At[m][k], acc[ai][bj][m][n], 0, 0, 0); __builtin_amdgcn_s_setprio(0); } while (0)
#define PG8_WAIT_V(n) asm volatile("s_waitcnt vmcnt(" #n ")" ::: "memory")
#define PG8_WAIT_L(n) asm volatile("s_waitcnt lgkmcnt(" #n ")" ::: "memory")
#define PG8_BAR __builtin_amdgcn_s_barrier()
#define PG8_SCHED __builtin_amdgcn_sched_barrier(0)
    Unit cur, nxt; int ui = 0;
    if (!S.next(0, cur)) return;
    f32x4 acc[2][2][4][2];
#pragma unroll
    for (int a = 0; a < 2; ++a)
#pragma unroll
        for (int b = 0; b < 2; ++b)
#pragma unroll
            for (int m = 0; m < 4; ++m)
#pragma unroll
                for (int n = 0; n < 2; ++n) acc[a][b][m][n] = (f32x4){0.f, 0.f, 0.f, 0.f};
    bf16x8 At[4][2], B0[2][2], B1[2][2];
    const char* cA = (const char*)g.A + (Sched::GATHER ? 0u : cur.offA); const char* cB = (const char*)g.B + cur.offB;
    PG8_GLOAD(gcur, cur.pm);
    PG8_STAGE(PG8_SB(0, 0), cB, voffB); PG8_STAGE_A(0, 0, cA, cA, gcur[0]); PG8_STAGE(PG8_SB(0, 1), cB + hstepB, voffB); PG8_STAGE_A(0, 1, cA + hstepA, cA, gcur[1]);
    if (wr == 1) PG8_BAR;
    PG8_WAIT_V(4); PG8_BAR;
    PG8_STAGE(PG8_SB(1, 0), cB + kstepB, voffB); PG8_STAGE_A(1, 0, cA + kstepA, cA + kstepA, gcur[0]); PG8_STAGE(PG8_SB(1, 1), cB + hstepB + kstepB, voffB);
    PG8_WAIT_V(6); PG8_BAR;
    for (;;) {
        const bool has_next = S.next(ui + 1, nxt);
        const char* nA = has_next ? (const char*)g.A + (Sched::GATHER ? 0u : nxt.offA) : cA; const char* nB = has_next ? (const char*)g.B + nxt.offB : cB;
        if constexpr (Sched::GATHER) { if (has_next) PG8_GLOAD(gnxt, nxt.pm); else {
#pragma unroll
            for (int h_ = 0; h_ < 2; ++h_) { gnxt[h_][0] = gcur[h_][0]; gnxt[h_][1] = gcur[h_][1]; } } }
        for (int t = 0; t < nt; t += 2) {
            const bool last = (t == nt - 2);
            const char* a1 = cA + (size_t)(t + 1) * kstepA;
            const char* a2 = last ? nA : cA + (size_t)(t + 2) * kstepA; const char* b2 = last ? nB : cB + (size_t)(t + 2) * kstepB;
            const char* a3 = a2 + kstepA; const char* b3 = b2 + kstepB;
            unsigned gs0[2], gs1[2];
            if constexpr (Sched::GATHER) { gs0[0] = last ? gnxt[0][0] : gcur[0][0]; gs0[1] = last ? gnxt[0][1] : gcur[0][1]; gs1[0] = last ? gnxt[1][0] : gcur[1][0]; gs1[1] = last ? gnxt[1][1] : gcur[1][1]; }
            PG8_LDB(B0, 0, 0); PG8_SCHED; PG8_LDA(At, 0, 0); PG8_STAGE_A(1, 1, a1 + hstepA, a1, gcur[1]);
            PG8_WAIT_L(8); PG8_BAR; PG8_WAIT_L(0); PG8_MMA(0, 0, At, B0); PG8_BAR; PG8_SCHED;
            PG8_LDB(B1, 0, 1); PG8_STAGE(PG8_SB(0, 0), b2, voffB);
            PG8_BAR; PG8_WAIT_L(0); PG8_MMA(0, 1, At, B1); PG8_BAR;
            PG8_LDA(At, 0, 1); PG8_STAGE_A(0, 0, a2, a2, gs0);
            PG8_BAR; PG8_WAIT_L(0); PG8_MMA(1, 0, At, B0); PG8_BAR; PG8_SCHED;
            PG8_STAGE(PG8_SB(0, 1), b2 + hstepB, voffB);
            PG8_WAIT_V(6); PG8_BAR; PG8_MMA(1, 1, At, B1); PG8_BAR;
            PG8_LDB(B0, 1, 0); PG8_SCHED; PG8_LDA(At, 1, 0); PG8_STAGE_A(0, 1, a2 + hstepA, a2, gs1);
            PG8_WAIT_L(8); PG8_BAR; PG8_WAIT_L(0); PG8_MMA(0, 0, At, B0); PG8_BAR; PG8_SCHED;
            PG8_LDB(B1, 1, 1); PG8_STAGE(PG8_SB(1, 0), b3, voffB);
            PG8_BAR; PG8_WAIT_L(0); PG8_MMA(0, 1, At, B1); PG8_BAR;
            PG8_LDA(At, 1, 1); PG8_STAGE_A(1, 0, a3, a3, gs0);
            PG8_BAR; PG8_WAIT_L(0); PG8_MMA(1, 0, At, B0); PG8_BAR; PG8_SCHED;
            PG8_STAGE(PG8_SB(1, 1), b3 + hstepB, voffB);
            PG8_WAIT_V(6); PG8_BAR; PG8_MMA(1, 1, At, B1); PG8_BAR;
        }
        E(acc, cur, wr, wc, fr, fq);
        if (!has_next) break;
#pragma unroll
        for (int a = 0; a < 2; ++a)
#pragma unroll
            for (int b = 0; b < 2; ++b)
#pragma unroll
                for (int m = 0; m < 4; ++m)
#pragma unroll
                    for (int n = 0; n < 2; ++n) acc[a][b][m][n] = (f32x4){0.f, 0.f, 0.f, 0.f};
        cur = nxt; cA = nA; cB = nB; ++ui;
        if constexpr (Sched::GATHER) {
#pragma unroll
            for (int h_ = 0; h_ < 2; ++h_) { gcur[h_][0] = gnxt[h_][0]; gcur[h_][1] = gnxt[h_][1]; } }
    }
    PG8_WAIT_V(0);
    if (wr == 0) PG8_BAR;
    PG8_BAR;
#undef PG8_SA
#undef PG8_SB
#undef PG8_STAGE
#undef PG8_STAGE_A
#undef PG8_GLOAD
#undef PG8_LDA
#undef PG8_LDB
#undef PG8_MMA
#undef PG8_WAIT_V
#undef PG8_WAIT_L
#undef PG8_BAR
#undef PG8_SCHED
}

struct Args { const float* in[24]; float* out; unsigned char* ws; int ph_lo, ph_hi; };
typedef const float* cfp_t;
typedef const __attribute__((address_space(4))) cfp_t* InPtr;
struct Frame {
    InPtr in; float* out; unsigned char* ws; LAS unsigned char* lds; int tid, lane, wave, G, vb;
};
#define WSP(T, off) ((T*)(F.ws + (off)))
template <class T> __device__ __forceinline__ T* launder_ptr(T* p) {
    int z = 0; asm volatile("" : "+s"(z)); return (T*)((char*)p + z);
}
__device__ __forceinline__ Frame relaunder(const Frame& F0) {
    Frame F = F0; int ln = (int)__builtin_amdgcn_mbcnt_hi(~0u, __builtin_amdgcn_mbcnt_lo(~0u, 0u)); asm volatile("" : "+v"(ln));
    F.lane = ln; F.wave = F0.wave; F.tid = F0.wave * 64 + ln;
    F.ws = launder_ptr(F0.ws); F.out = launder_ptr(F0.out);
    { int g = F0.G, v = F0.vb; asm volatile("" : "+v"(g), "+v"(v)); F.G = __builtin_amdgcn_readfirstlane(g); F.vb = __builtin_amdgcn_readfirstlane(v); }
    return F;
}

__device__ __forceinline__ SchedB mk_sched(const Frame& F, int nB, int nM, int nN, int bdiv, unsigned bsA_hi, unsigned bsA_lo, unsigned bsB_hi, unsigned bsB_lo, unsigned tsA, unsigned tsB, int crot = 0) {
    SchedB S; S.nM = nM; S.nN = nN; S.nB = nB; S.G = F.G; S.c = (F.vb + crot) % F.G; S.bdiv = bdiv; S.bsA_hi = bsA_hi; S.bsA_lo = bsA_lo; S.bsB_hi = bsB_hi; S.bsB_lo = bsB_lo; S.tsA = tsA; S.tsB = tsB; return S;
}
__device__ __forceinline__ void gemm_plain(const Frame& F, const bf16_t* A, int lda, const bf16_t* Bw, int M, int N, int K, bf16_t* O, int ldc, int crot = 0) {
    GemmD g{A, Bw, lda, K, 128, 128, K};
    SchedB S = mk_sched(F, 1, M / 256, N / 256, 1, 0, 0, 0, 0, (unsigned)256 * lda * 2, (unsigned)256 * K * 2, crot);
    EpiBf16 E{O, ldc, 1, 0, 0};
    gemm_phase<EpiBf16, SchedB>(F.lds, g, S, E, F.wave);
}

struct TDesc { const float* src; int ldsrc; bf16_t* dst; int ldd; };
struct MatMap {
    const float* src; int ldsrc, nnt; bf16_t* dst; int ldd;
    __device__ __forceinline__ TDesc operator()(int tl) const { const int kt = tl / nnt, ntl = tl - kt * nnt; return TDesc{src + (size_t)kt * 64 * ldsrc + ntl * 64, ldsrc, dst + (size_t)ntl * 64 * ldd + kt * 64, ldd}; }
};
struct MoeMap {
    const float* wg; const float* wu; const float* wd; bf16_t* WGU; bf16_t* WDN;
    __device__ __forceinline__ TDesc operator()(int tl) const {
        const int e = tl / 384, r = tl - e * 384, which = r >> 7, q = r & 127;
        if (which < 2) { const int kt = q >> 3, ntl = q & 7, k0 = kt * 64, n0 = ntl * 64; const int row0 = (n0 >> 7) * 256 + which * 128 + (n0 & 127);
            return TDesc{(which ? wu : wg) + (size_t)e * 524288 + (size_t)k0 * 512 + n0, 512, WGU + (size_t)e * 1048576 + (size_t)row0 * 1024 + k0, 1024}; }
        const int kt = q >> 4, ntl = q & 15, k0 = kt * 64, n0 = ntl * 64;
        return TDesc{wd + (size_t)e * 524288 + (size_t)k0 * 1024 + n0, 1024, WDN + (size_t)e * 524288 + (size_t)n0 * 512 + k0, 512};
    }
};
template <class Map>
__device__ __forceinline__ void tconv_run_sub(const Frame& F, int ntiles, const Map& M, int wgi, int nwg) {
    LAS float* tile = (LAS float*)F.lds;
    const int t = F.tid, r = t >> 3, cg = t & 7;
    for (int base = wgi * 4; base < ntiles; base += nwg * 4) {
        f32x4 v[4][2]; TDesc d[4];
#pragma unroll
        for (int q = 0; q < 4; ++q) { d[q] = M(min(base + q, ntiles - 1));
            v[q][0] = gload<f32x4>(d[q].src + (size_t)r * d[q].ldsrc + cg * 8); v[q][1] = gload<f32x4>(d[q].src + (size_t)r * d[q].ldsrc + cg * 8 + 4); }
#pragma unroll
        for (int q = 0; q < 4; ++q)
#pragma unroll
            for (int j = 0; j < 4; ++j) { tile[q * 4160 + r * 65 + cg * 8 + j] = v[q][0][j]; tile[q * 4160 + r * 65 + cg * 8 + 4 + j] = v[q][1][j]; }
        __syncthreads();
#pragma unroll
        for (int q = 0; q < 4; ++q) {
            float o[8];
#pragma unroll
            for (int j = 0; j < 8; ++j) o[j] = tile[q * 4160 + (cg * 8 + j) * 65 + r];
            u32x4 w; w.x = cvt_pk_bf16(o[0], o[1]); w.y = cvt_pk_bf16(o[2], o[3]); w.z = cvt_pk_bf16(o[4], o[5]); w.w = cvt_pk_bf16(o[6], o[7]);
            if (base + q < ntiles) gstore<u32x4>(d[q].dst + (size_t)r * d[q].ldd + cg * 8, w);
        }
        __syncthreads();
    }
}
template <class Map>
__device__ __forceinline__ void tconv_run(const Frame& F, int ntiles, const Map& M, int rot) { tconv_run_sub(F, ntiles, M, (F.vb + rot) % F.G, F.G); }
__device__ __forceinline__ void tconv_matrix(const Frame& F, const float* src, int ldsrc, int Kd, int Nd, bf16_t* dst, int ldd, int rot) {
    MatMap M{src, ldsrc, Nd / 64, dst, ldd};
    tconv_run(F, (Kd / 64) * (Nd / 64), M, rot);
}
__device__ __forceinline__ void moe_convert(const Frame& F0, int l) {
    const Frame F = relaunder(F0);
    MoeMap M{F.in[19] + (size_t)l * 32 * 524288, F.in[20] + (size_t)l * 32 * 524288, F.in[21] + (size_t)l * 32 * 524288, l ? (bf16_t*)F.out : WSP(bf16_t, WS_WGU), l ? (bf16_t*)F.out + (size_t)33554432 : WSP(bf16_t, WS_WDN)};
    tconv_run(F, 32 * 384, M, 0);
}
constexpr size_t X_PRO_ELEMS = (size_t)NTOK * DM / 2;
__device__ __forceinline__ void conv_f32_bf16_sub(const Frame& F, const float* src, bf16_t* dst, size_t n, int wgi, int nwg) {
    for (size_t i = ((size_t)wgi * NTHR + F.tid) * 8; i < n; i += (size_t)nwg * NTHR * 8) {
        const f32x4 a = gload<f32x4>(src + i), b = gload<f32x4>(src + i + 4);
        u32x4 w; w.x = cvt_pk_bf16(a[0], a[1]); w.y = cvt_pk_bf16(a[2], a[3]); w.z = cvt_pk_bf16(b[0], b[1]); w.w = cvt_pk_bf16(b[2], b[3]);
        gstore<u32x4>(dst + i, w); }
}
__device__ __forceinline__ void conv_f32_bf16(const Frame& F, const float* src, bf16_t* dst, size_t n) {
    for (size_t i = ((size_t)F.vb * NTHR + F.tid) * 8; i < n; i += (size_t)F.G * NTHR * 8) {
        const f32x4 a = gload<f32x4>(src + i), b = gload<f32x4>(src + i + 4);
        u32x4 w; w.x = cvt_pk_bf16(a[0], a[1]); w.y = cvt_pk_bf16(a[2], a[3]); w.z = cvt_pk_bf16(b[0], b[1]); w.w = cvt_pk_bf16(b[2], b[3]);
        gstore<u32x4>(dst + i, w); }
}

__device__ __forceinline__ void p_prologue(const Frame& F0) {
    const Frame F = relaunder(F0);
    tconv_matrix(F, F.in[2] + 512, 1024, 1024, 512, WSP(bf16_t, WS_W1CAT) + (size_t)512 * 1024, 1024, 0);
    tconv_matrix(F, F.in[7], 1024, 1024, 1024, WSP(bf16_t, WS_PFWOUT), 1024, 32);
    { const int dsec[5] = {0, 1, 3, 4, 2};
#pragma unroll
      for (int sc = 0; sc < 5; ++sc) tconv_matrix(F, F.in[8] + sc * 1024, 5120, 1024, 1024, WSP(bf16_t, WS_HGWIN) + (size_t)dsec[sc] * 1048576, 1024, 96 + sc * 64); }
    tconv_matrix(F, F.in[11], 1024, 1024, 1024, WSP(bf16_t, WS_HGWOUT), 1024, 160);
    for (int l = 0; l < 2; ++l) {
        tconv_matrix(F, F.in[13] + (size_t)l * 2097152, 2048, 1024, 1024, WSP(bf16_t, WS_WK) + (size_t)l * 1048576, 1024, 32 + l * 256);
        tconv_matrix(F, F.in[13] + (size_t)l * 2097152 + 1024, 2048, 1024, 1024, WSP(bf16_t, WS_WV) + (size_t)l * 1048576, 1024, 96 + l * 256);
        tconv_matrix(F, F.in[14] + (size_t)l * 1048576, 1024, 1024, 1024, WSP(bf16_t, l ? WS_WOT1 : WS_WOT0), 1024, 160 + l * 256);
        conv_f32_bf16(F, F.in[12] + (size_t)l * 1048576, WSP(bf16_t, l ? WS_WQN1 : WS_WQN0), (size_t)1048576);
    }
    if (F.G != 256) moe_convert(F, 0);
    conv_f32_bf16(F, F.in[0], WSP(bf16_t, WS_XB), F.G == 256 ? X_PRO_ELEMS : (size_t)NTOK * DM);
    conv_f32_bf16(F, F.in[1], WSP(bf16_t, WS_MEMBF), (size_t)NB * MEML * DM);
    const int gt = F.vb * NTHR + F.tid, gn = F.G * NTHR;
    { const float* win = F.in[2]; const float* pw = F.in[3]; const float* ps = F.in[4]; bf16_t* W1 = WSP(bf16_t, WS_W1CAT);
      LAS float* wl = (LAS float*)F.lds;
      for (int kb = F.vb; kb < 256; kb += F.G) {
          __syncthreads();
#pragma unroll
          for (int j = 0; j < 4; ++j) wl[j * 512 + F.tid] = win[(size_t)(kb * 4 + j) * 1024 + F.tid];
          __syncthreads();
          const int gd = F.tid, g = gd >> 7, d = gd & 127; const float* pp = pw + (size_t)g * 16384 + d;
          float a0 = 0.f, a1 = 0.f, a2 = 0.f, a3 = 0.f;
#pragma unroll 8
          for (int c = 0; c < 128; ++c) { const float p = pp[c * 128]; a0 += wl[g * 128 + c] * p; a1 += wl[512 + g * 128 + c] * p; a2 += wl[1024 + g * 128 + c] * p; a3 += wl[1536 + g * 128 + c] * p; }
          const float sc = ps[gd];
          u32x2 w; w.x = cvt_pk_bf16(a0 * sc, a1 * sc); w.y = cvt_pk_bf16(a2 * sc, a3 * sc);
          gstore<u32x2>(W1 + (size_t)gd * 1024 + kb * 4, w); }
      __syncthreads(); }
    { const float* fw = F.in[6]; bf16_t* PQ = WSP(bf16_t, WS_PQT); const float norm = 0.0013810679320049757f;
      LAS float* tb = (LAS float*)F.lds;
      __syncthreads();
      if (F.tid < 128) { const float ang = (float)F.tid * (1.0f / 64.0f); tb[F.tid] = cospif(ang); tb[128 + F.tid] = sinpif(ang); }
      __syncthreads();
      for (int idx = gt; idx < 4 * 256 * 128; idx += gn) { const int h = idx >> 15, r = (idx >> 7) & 255, c = idx & 127, d = r & 127, isq = r >> 7; float a = 0.f;
          const float* fp = fw + (size_t)h * 16384 + d; const LAS float* tp = tb + isq * 128;
#pragma unroll 8
          for (int m = 0; m < 128; ++m) a += tp[(m * c) & 127] * fp[m * 128];
          PQ[idx] = f2bf(a * norm); }
      __syncthreads(); }
    { bf16_t* W1d = WSP(bf16_t, WS_W1DFT); bf16_t* W2d = WSP(bf16_t, WS_W2DFT); float* TW = WSP(float, WS_TW);
      for (int idx = gt; idx < 256 * 128; idx += gn) { const int r = idx >> 7, k = idx & 127, ri = k >> 6, bb = k & 63; float v1 = 0.f, v2 = 0.f;
          if (r < 128) { const int e = 32 * (r >> 6) + (r & 31), ro = (r >> 5) & 1; const float ang = (float)((e * bb) & 63) * (1.0f / 32.0f); const float cs = cospif(ang), sn = sinpif(ang);
              v1 = ro == 0 ? (ri == 0 ? cs : -sn) : (ri == 0 ? sn : cs); }
          if (r < 64) { const float ang = (float)((r * bb) & 63) * (1.0f / 32.0f); v2 = ri == 0 ? cospif(ang) : -sinpif(ang); }
          W1d[idx] = f2bf(v1); W2d[idx] = f2bf(v2); }
      for (int idx = gt; idx < 64 * 64; idx += gn) { const int e = idx >> 6, a = idx & 63; const float ang = (float)((e * a) & 4095) * (1.0f / 2048.0f); TW[idx * 2] = cospif(ang); TW[idx * 2 + 1] = sinpif(ang); } }
    { const float* lbin = F.in[9]; float* LB = WSP(float, WS_LB1);
      for (int idx = gt; idx < 2048; idx += gn) { const float v0 = lbin[idx], v1 = lbin[2048 + idx]; LB[idx] = 1.0f / (1.0f + expf(v0 - v1)); } }
}

__device__ __forceinline__ void p_kv_a(const Frame& F0) {
    const Frame F = relaunder(F0);
    gemm_plain(F, WSP(bf16_t, WS_MEMBF), 1024, WSP(bf16_t, WS_WK), 2048, 1024, 1024, WSP(bf16_t, WS_KB0), 1024, 0);
    gemm_plain(F, WSP(bf16_t, WS_MEMBF), 1024, WSP(bf16_t, WS_WV), 2048, 1024, 1024, WSP(bf16_t, WS_VB0), 1024, 32);
    gemm_plain(F, WSP(bf16_t, WS_MEMBF), 1024, WSP(bf16_t, WS_WK) + 1048576, 2048, 1024, 1024, WSP(bf16_t, WS_KB1), 1024, 64);
    gemm_plain(F, WSP(bf16_t, WS_MEMBF), 1024, WSP(bf16_t, WS_WV) + 1048576, 2048, 1024, 1024, WSP(bf16_t, WS_VB1), 1024, 96);
    if (F.G == 256 && F.vb >= 32 && F.vb < 160) conv_f32_bf16_sub(F, F.in[0] + X_PRO_ELEMS, WSP(bf16_t, WS_XB) + X_PRO_ELEMS, (size_t)NTOK * DM - X_PRO_ELEMS, F.vb - 32, 128);
}
__device__ __forceinline__ void p_kv_b(const Frame& F0, int l) {
    const Frame F = relaunder(F0);
    const bf16_t* KB = WSP(bf16_t, l ? WS_KB1 : WS_KB0); const bf16_t* VB = WSP(bf16_t, l ? WS_VB1 : WS_VB0);
    const bf16_t* WQN = WSP(bf16_t, l ? WS_WQN1 : WS_WQN0); const bf16_t* WOT = WSP(bf16_t, l ? WS_WOT1 : WS_WOT0);
    { GemmD g{KB, WQN, 1024, 1024, 128, 128, 256};
      SchedB S = mk_sched(F, 32, 1, 4, 4, (unsigned)256 * 1024 * 2, (unsigned)256 * 2, 0, (unsigned)256 * 2, 0, (unsigned)256 * 1024 * 2);
      EpiBf16 E{WSP(bf16_t, WS_KM), 1024, 1, (unsigned)256 * 1024, 0};
      gemm_phase<EpiBf16, SchedB>(F.lds, g, S, E, F.wave); }
    { GemmD g{WOT, VB, 1024, 1024, 128, 128, 256};
      SchedB S = mk_sched(F, 32, 4, 1, 4, 0, (unsigned)256 * 2, (unsigned)256 * 1024 * 2, (unsigned)256 * 2, (unsigned)256 * 1024 * 2, 0, 128);
      EpiBf16 E{WSP(bf16_t, WS_VW), 1024, 4, (unsigned)1024 * 1024, 256};
      gemm_phase<EpiBf16, SchedB>(F.lds, g, S, E, F.wave); }
}

__device__ __forceinline__ void p_pool_hln(const Frame& F0) {
    const Frame F = relaunder(F0);
    const bf16_t* U = WSP(bf16_t, WS_U); bf16_t* YC = WSP(bf16_t, WS_YCAT); bf16_t* UN = WSP(bf16_t, WS_UN); const float* lng = F.in[5];
    const int l = F.lane, g = l >> 4, w2 = 1 << g;
    float gam[8];
#pragma unroll
    for (int j = 0; j < 8; ++j) gam[j] = lng[8 * l + j];
#define POOL_LOAD(o_, u_, a_, d_, i_) do { const int s_ = s0 + (i_); o_ = gload<u32x4>(Ub + (size_t)s_ * DM); u_ = gload<u32x4>(Ub + (size_t)s_ * DM + 512); \
        a_ = gload<u32x4>(Ub + (size_t)min(s_ + w2, SEQ - 1) * DM); d_ = gload<u32x4>(Ub + (size_t)max(s_ - w2, 0) * DM); } while (0)
#define POOL_BODY(o_, u_, a_, d_, i_) do { const int s = s0 + (i_), tk = t0 + (i_); \
        const int lo = max(s - w2, 0), hi = min(s + w2, SEQ); \
        const u32x4 own = o_; \
        const float inv = 1.0f / (float)(hi - lo); \
        float o[8]; \
        o[0] = sum[0] * inv - lo_bf(own.x); o[1] = sum[1] * inv - hi_bf(own.x); o[2] = sum[2] * inv - lo_bf(own.y); o[3] = sum[3] * inv - hi_bf(own.y); \
        o[4] = sum[4] * inv - lo_bf(own.z); o[5] = sum[5] * inv - hi_bf(own.z); o[6] = sum[6] * inv - lo_bf(own.w); o[7] = sum[7] * inv - hi_bf(own.w); \
        u32x4 w; w.x = cvt_pk_bf16(o[0], o[1]); w.y = cvt_pk_bf16(o[2], o[3]); w.z = cvt_pk_bf16(o[4], o[5]); w.w = cvt_pk_bf16(o[6], o[7]); \
        gstore<u32x4>(YC + (size_t)tk * DM + 8 * l, w); \
        { const float ka = (s + w2 < SEQ) ? 1.0f : 0.0f, kd = (s - w2 >= 0) ? 1.0f : 0.0f; const u32x4 va = a_, vd = d_;        \
          sum[0] += ka * lo_bf(va.x) - kd * lo_bf(vd.x); sum[1] += ka * hi_bf(va.x) - kd * hi_bf(vd.x); sum[2] += ka * lo_bf(va.y) - kd * lo_bf(vd.y); sum[3] += ka * hi_bf(va.y) - kd * hi_bf(vd.y); \
          sum[4] += ka * lo_bf(va.z) - kd * lo_bf(vd.z); sum[5] += ka * hi_bf(va.z) - kd * hi_bf(vd.z); sum[6] += ka * lo_bf(va.w) - kd * lo_bf(vd.w); sum[7] += ka * hi_bf(va.w) - kd * hi_bf(vd.w); } \
          \
        const u32x4 ub = u_; \
        float x[8] = {lo_bf(ub.x), hi_bf(ub.x), lo_bf(ub.y), hi_bf(ub.y), lo_bf(ub.z), hi_bf(ub.z), lo_bf(ub.w), hi_bf(ub.w)}; \
        float sm = ((x[0] + x[1]) + (x[2] + x[3])) + ((x[4] + x[5]) + (x[6] + x[7])); \
        sm += __shfl_xor(sm, 1); sm += __shfl_xor(sm, 2); sm += __shfl_xor(sm, 4); sm += __shfl_xor(sm, 8); \
        const float mu = sm * (1.0f / 128.0f); \
        float qq = 0.f; \
        _Pragma("unroll") for (int j = 0; j < 8; ++j) { x[j] -= mu; qq += x[j] * x[j]; } \
        qq += __shfl_xor(qq, 1); qq += __shfl_xor(qq, 2); qq += __shfl_xor(qq, 4); qq += __shfl_xor(qq, 8); \
        const float rs = rsqrtf(qq * (1.0f / 128.0f) + LN_EPS); \
        _Pragma("unroll") for (int j = 0; j < 8; ++j) x[j] = x[j] * rs * gam[j]; \
        const int np = 64 * (s & 63) + (s >> 6); \
        u32x4 w2v; w2v.x = cvt_pk_bf16(x[0], x[1]); w2v.y = cvt_pk_bf16(x[2], x[3]); w2v.z = cvt_pk_bf16(x[4], x[5]); w2v.w = cvt_pk_bf16(x[6], x[7]); \
        gstore<u32x4>(UN + ((size_t)(b * SEQ + np)) * 512 + 8 * l, w2v); } while (0)
    for (int run = F.vb * 8 + F.wave; run < NTOK / 16; run += F.G * 8) {
        const int t0 = run * 16, b = t0 >> 12, s0 = t0 & 4095;
        const bf16_t* Ub = U + (size_t)b * SEQ * DM + 8 * l;
        float sum[8];
#pragma unroll
        for (int j = 0; j < 8; ++j) sum[j] = 0.f;
        {
            const int lo = max(s0 - w2, 0), hi = min(s0 + w2, SEQ);
            u32x4 wv[16];
#pragma unroll
            for (int d = 0; d < 16; ++d) { const int r = s0 - 8 + d; const int rc = min(max(r, 0), SEQ - 1); wv[d] = gload<u32x4>(Ub + (size_t)rc * DM); }
#pragma unroll
            for (int d = 0; d < 16; ++d) { const int r = s0 - 8 + d; const float k = (r >= lo && r < hi) ? 1.0f : 0.0f; const u32x4 v = wv[d];
                sum[0] += k * lo_bf(v.x); sum[1] += k * hi_bf(v.x); sum[2] += k * lo_bf(v.y); sum[3] += k * hi_bf(v.y); sum[4] += k * lo_bf(v.z); sum[5] += k * hi_bf(v.z); sum[6] += k * lo_bf(v.w); sum[7] += k * hi_bf(v.w); }
        }
        u32x4 oA, uA, aA, dA, oB, uB, aB, dB;
        POOL_LOAD(oA, uA, aA, dA, 0);
#pragma unroll 1
        for (int i = 0; i < 16; i += 2) {
            POOL_LOAD(oB, uB, aB, dB, i + 1);
            POOL_BODY(oA, uA, aA, dA, i);
            if (i + 2 < 16) POOL_LOAD(oA, uA, aA, dA, i + 2);
            POOL_BODY(oB, uB, aB, dB, i + 1);
        }
    }
#undef POOL_LOAD
#undef POOL_BODY
}

template <int MODE, bool XF32, bool FINAL>
__device__ __forceinline__ void p_ln(const Frame& F0, const float* xin, const bf16_t* hsrc, int l, int j3) {
    const Frame F = relaunder(F0);
    float* X = F.out; bf16_t* XB = WSP(bf16_t, WS_XB);
    const float* gam = F.in[22] + (size_t)(l * 3 + j3) * 1024; const float* bet = F.in[23] + (size_t)(l * 3 + j3) * 1024;
    const int ln = F.lane;
    float gv[16], bv[16];
#pragma unroll
    for (int ii = 0; ii < 2; ++ii)
#pragma unroll
        for (int j = 0; j < 8; ++j) { gv[ii * 8 + j] = gam[ii * 512 + ln * 8 + j]; bv[ii * 8 + j] = bet[ii * 512 + ln * 8 + j]; }
    LAS float* WR = (LAS float*)F.lds;
#define WR_PERM(c_) ((((c_) >> 9) * 2 + (((c_) >> 2) & 1)) * 256 + (((c_) >> 3) & 63) * 4 + ((c_) & 3))
    LAS int* hist = (LAS int*)(F.lds + 36 * 4096);
    float rbias_g = 0.f, rbias_e = 0.f;
    if (MODE == 1) {
        const float* wgp = F.in[15] + (size_t)l * 4096; const float* wep = F.in[17] + (size_t)l * 32768;
        for (int c = F.tid; c < 1024; c += NTHR) { const f32x4 v = gload<f32x4>(wgp + c * 4);
#pragma unroll
            for (int j = 0; j < 4; ++j) WR[j * 1024 + WR_PERM(c)] = v[j]; }
        for (int idx = F.tid; idx < 8192; idx += NTHR) { const int c = idx & 1023, q4 = idx >> 10; const f32x4 v = gload<f32x4>(wep + c * 32 + q4 * 4);
#pragma unroll
            for (int j = 0; j < 4; ++j) WR[(4 + q4 * 4 + j) * 1024 + WR_PERM(c)] = v[j]; }
        rbias_g = F.in[16][l * 4 + (ln & 3)]; rbias_e = F.in[18][l * 32 + (ln & 31)];
        __syncthreads();
    }
    const int2* POSS = WSP(int2, WS_POSS);
    if (MODE == 1) { int* ROWTOK = WSP(int, WS_ROWTOK); for (int i = F.vb * NTHR + F.tid; i < MPAD_MAX; i += F.G * NTHR) ROWTOK[i] = 0; }
    for (int ch = F.vb; ch < NTOK / 128; ch += F.G) {
        if (MODE == 1) { if (F.tid < 32) hist[F.tid] = 0; __syncthreads(); }
        const int t0 = ch * 128 + F.wave * 16;
        int2 myps = make_int2(0, 0);
        if (MODE == 2) myps = POSS[t0 + (ln & 15)];
        f32x4 nxf[4]; u32x4 nxb[2], nh0[2], nh1[2];
#define LN_LOAD(tt, ii_) do { const int t_ = (tt); const bf16_t* h0_ = hsrc + (size_t)t_ * DM; const bf16_t* h1_ = h0_; \
            if (MODE == 2) { const int p0_ = __shfl(myps.x, (ii_)), p1_ = __shfl(myps.y, (ii_)); h0_ = hsrc + (size_t)p0_ * DM; h1_ = hsrc + (size_t)p1_ * DM; } \
            _Pragma("unroll") for (int ii = 0; ii < 2; ++ii) { const int c0 = ii * 512 + ln * 8; \
                if (XF32) { nxf[ii * 2] = gload<f32x4>(xin + (size_t)t_ * DM + c0); nxf[ii * 2 + 1] = gload<f32x4>(xin + (size_t)t_ * DM + c0 + 4); } \
                else nxb[ii] = gload<u32x4>(XB + (size_t)t_ * DM + c0); \
                nh0[ii] = gload<u32x4>(h0_ + c0); if (MODE == 2) nh1[ii] = gload<u32x4>(h1_ + c0); } } while (0)
        LN_LOAD(t0, 0);
        for (int i = 0; i < 16; ++i) {
            const int t = t0 + i;
            float y[16];
#pragma unroll
            for (int ii = 0; ii < 2; ++ii) {
                float xx[8];
                if (XF32) {
#pragma unroll
                    for (int j = 0; j < 4; ++j) { xx[j] = nxf[ii * 2][j]; xx[4 + j] = nxf[ii * 2 + 1][j]; } }
                else { const u32x4 xv = nxb[ii];
                    xx[0] = lo_bf(xv.x); xx[1] = hi_bf(xv.x); xx[2] = lo_bf(xv.y); xx[3] = hi_bf(xv.y); xx[4] = lo_bf(xv.z); xx[5] = hi_bf(xv.z); xx[6] = lo_bf(xv.w); xx[7] = hi_bf(xv.w); }
                const u32x4 hv = nh0[ii];
                float hh[8] = {lo_bf(hv.x), hi_bf(hv.x), lo_bf(hv.y), hi_bf(hv.y), lo_bf(hv.z), hi_bf(hv.z), lo_bf(hv.w), hi_bf(hv.w)};
                if (MODE == 2) { const u32x4 h2 = nh1[ii];
                    hh[0] += lo_bf(h2.x); hh[1] += hi_bf(h2.x); hh[2] += lo_bf(h2.y); hh[3] += hi_bf(h2.y); hh[4] += lo_bf(h2.z); hh[5] += hi_bf(h2.z); hh[6] += lo_bf(h2.w); hh[7] += hi_bf(h2.w); }
#pragma unroll
                for (int j = 0; j < 8; ++j) y[ii * 8 + j] = DN_ALPHA * xx[j] + hh[j];
            }
            if (i + 1 < 16) LN_LOAD(t + 1, i + 1);
            float sm = 0.f;
#pragma unroll
            for (int j = 0; j < 16; ++j) sm += y[j];
            sm = wave_sum(sm);
            const float mu = sm * (1.0f / 1024.0f);
            float q = 0.f;
#pragma unroll
            for (int j = 0; j < 16; ++j) { y[j] -= mu; q += y[j] * y[j]; }
            q = wave_sum(q);
            const float rs = rsqrtf(q * (1.0f / 1024.0f) + LN_EPS);
#pragma unroll
            for (int j = 0; j < 16; ++j) y[j] = y[j] * rs * gv[j] + bv[j];
#pragma unroll
            for (int ii = 0; ii < 2; ++ii) {
                const int c0 = ii * 512 + ln * 8;
                if (FINAL) {
                    gstore<f32x4>(X + (size_t)t * DM + c0, (f32x4){y[ii * 8 + 0], y[ii * 8 + 1], y[ii * 8 + 2], y[ii * 8 + 3]});
                    gstore<f32x4>(X + (size_t)t * DM + c0 + 4, (f32x4){y[ii * 8 + 4], y[ii * 8 + 5], y[ii * 8 + 6], y[ii * 8 + 7]});
                } else {
                    u32x4 w; w.x = cvt_pk_bf16(y[ii * 8 + 0], y[ii * 8 + 1]); w.y = cvt_pk_bf16(y[ii * 8 + 2], y[ii * 8 + 3]); w.z = cvt_pk_bf16(y[ii * 8 + 4], y[ii * 8 + 5]); w.w = cvt_pk_bf16(y[ii * 8 + 6], y[ii * 8 + 7]);
                    gstore<u32x4>(XB + (size_t)t * DM + c0, w);
                }
            }
            if (MODE == 1) {
                const bool b0 = ln & 1, b1 = ln & 2, b2 = ln & 4;
#define ROUTER_DOT(dst, jj_) do { f32x2 a2 = (f32x2){0.f, 0.f}; _Pragma("unroll") for (int ii = 0; ii < 2; ++ii) { \
                    const f32x4 w0 = *(const LAS f32x4*)(WR + (jj_) * 1024 + ii * 512 + ln * 4), w1 = *(const LAS f32x4*)(WR + (jj_) * 1024 + ii * 512 + 256 + ln * 4); \
                    a2 += (f32x2){y[ii * 8 + 0], y[ii * 8 + 1]} * (f32x2){w0[0], w0[1]}; a2 += (f32x2){y[ii * 8 + 2], y[ii * 8 + 3]} * (f32x2){w0[2], w0[3]}; \
                    a2 += (f32x2){y[ii * 8 + 4], y[ii * 8 + 5]} * (f32x2){w1[0], w1[1]}; a2 += (f32x2){y[ii * 8 + 6], y[ii * 8 + 7]} * (f32x2){w1[2], w1[3]}; } \
                    dst = a2[0] + a2[1]; } while (0)
                float gq[4];
#pragma unroll
                for (int j = 0; j < 4; ++j) ROUTER_DOT(gq[j], j);
                float gv1[2];
#pragma unroll
                for (int k = 0; k < 2; ++k) { const float keep = b0 ? gq[2 * k + 1] : gq[2 * k], send = b0 ? gq[2 * k] : gq[2 * k + 1]; gv1[k] = keep + __shfl_xor(send, 1); }
                float gsum; { const float keep = b1 ? gv1[1] : gv1[0], send = b1 ? gv1[0] : gv1[1]; gsum = keep + __shfl_xor(send, 2); }
                gsum += __shfl_xor(gsum, 4); gsum += __shfl_xor(gsum, 8); gsum += __shfl_xor(gsum, 16); gsum += __shfl_xor(gsum, 32);
                gsum += rbias_g;
                float lg[4];
#pragma unroll
                for (int j = 0; j < 4; ++j) lg[j] = __shfl(gsum, j);
                int gi = 0; float gm = lg[0];
#pragma unroll
                for (int j = 1; j < 4; ++j) if (lg[j] > gm) { gm = lg[j]; gi = j; }
                float den = 0.f;
#pragma unroll
                for (int j = 0; j < 4; ++j) den += __expf(lg[j] - gm);
                const float pg = 1.0f / den;
                const int gib = __builtin_amdgcn_readfirstlane(gi) * 8 + 4;
                float eq[8];
#pragma unroll
                for (int j = 0; j < 8; ++j) ROUTER_DOT(eq[j], gib + j);
                float ev1[4], ev2[2];
#pragma unroll
                for (int k = 0; k < 4; ++k) { const float keep = b0 ? eq[2 * k + 1] : eq[2 * k], send = b0 ? eq[2 * k] : eq[2 * k + 1]; ev1[k] = keep + __shfl_xor(send, 1); }
#pragma unroll
                for (int k = 0; k < 2; ++k) { const float keep = b1 ? ev1[2 * k + 1] : ev1[2 * k], send = b1 ? ev1[2 * k] : ev1[2 * k + 1]; ev2[k] = keep + __shfl_xor(send, 2); }
                float esum; { const float keep = b2 ? ev2[1] : ev2[0], send = b2 ? ev2[0] : ev2[1]; esum = keep + __shfl_xor(send, 4); }
                esum += __shfl_xor(esum, 8); esum += __shfl_xor(esum, 16); esum += __shfl_xor(esum, 32);
                esum += __shfl(rbias_e, gi * 8 + (ln & 7));
                float le[8];
#pragma unroll
                for (int j = 0; j < 8; ++j) le[j] = __shfl(esum, j);
#undef ROUTER_DOT
                int i0 = 0; float m0 = le[0];
#pragma unroll
                for (int j = 1; j < 8; ++j) if (le[j] > m0) { m0 = le[j]; i0 = j; }
                int i1 = -1; float m1 = -3.0e38f;
#pragma unroll
                for (int j = 0; j < 8; ++j) if (j != i0 && le[j] > m1) { m1 = le[j]; i1 = j; }
                const float p1 = __expf(m1 - m0), rden = 1.0f / (1.0f + p1);
                if (ln == 0) {
                    const int e0 = gi * 8 + i0, e1 = gi * 8 + i1;
                    WSP(int2, WS_TOKE)[t] = make_int2(e0, e1);
                    WSP(float2, WS_TOKG)[t] = make_float2(pg * rden, pg * p1 * rden);
                    atomicAdd((int*)&hist[e0], 1); atomicAdd((int*)&hist[e1], 1);
                }
            }
        }
#undef LN_LOAD
        if (MODE == 1) { __syncthreads(); if (F.tid < 32) WSP(int, WS_HIST)[ch * 32 + F.tid] = hist[F.tid]; __syncthreads(); }
    }
}

__device__ __forceinline__ void p_dispatch(const Frame& F0) {
    const Frame F = relaunder(F0);
    LAS int* hsum = (LAS int*)F.lds; LAS int* hpre = hsum + 32; LAS int* off = hsum + 64; LAS int* cursor = hsum + 128;
    const int* HIST = WSP(int, WS_HIST); const int2* TOKE = WSP(int2, WS_TOKE); const float2* TOKG = WSP(float2, WS_TOKG);
    int2* POSS = WSP(int2, WS_POSS); float* GPOS = WSP(float, WS_GPOS); int* TEXP = WSP(int, WS_TILEEXP);
    int* ROWTOK = WSP(int, WS_ROWTOK);
    for (int ch = F.vb; ch < NTOK / 128; ch += F.G) {
        if (F.tid < 32) { hsum[F.tid] = 0; hpre[F.tid] = 0; cursor[F.tid] = 0; }
        __syncthreads();
        { const int e = F.tid & 31, part = F.tid >> 5; int tot = 0, pre = 0;
          for (int cc = part * 16; cc < part * 16 + 16; ++cc) { const int v = HIST[cc * 32 + e]; tot += v; if (cc < ch) pre += v; }
          atomicAdd((int*)&hsum[e], tot); atomicAdd((int*)&hpre[e], pre); }
        __syncthreads();
        if (F.tid == 0) { int o = 0; for (int e = 0; e < 32; ++e) { off[e] = o; o += (hsum[e] + 255) & ~255; } off[32] = o; }
        __syncthreads();
        if (ch == 0) { const int ntile = off[32] >> 8;
            if (F.tid < 320) { int e = 0; for (int k = 0; k < 32; ++k) if (F.tid * 256 >= off[k + 1]) e = k + 1; if (F.tid < ntile) TEXP[F.tid] = e < 32 ? e : 31; }
            if (F.tid == 0) TEXP[320] = ntile; }
        {
            const int t0 = ch * 128 + F.wave * 16;
            int p0 = 0, p1 = 0;
            if (F.lane < 16) { const int t = t0 + F.lane; const int2 ee = TOKE[t]; const float2 gg = TOKG[t];
                const int r0 = atomicAdd((int*)&cursor[ee.x], 1); const int r1 = atomicAdd((int*)&cursor[ee.y], 1);
                p0 = off[ee.x] + hpre[ee.x] + r0; p1 = off[ee.y] + hpre[ee.y] + r1;
                POSS[t] = make_int2(p0, p1); GPOS[p0] = gg.x; GPOS[p1] = gg.y; ROWTOK[p0] = t; ROWTOK[p1] = t; }
        }
        __syncthreads();
    }
}

typedef short s16x4 __attribute__((ext_vector_type(4)));
typedef float f32x16 __attribute__((ext_vector_type(16)));
__device__ __forceinline__ s16x4 tr16(const LAS unsigned char* p) { return __builtin_amdgcn_ds_read_tr16_b64_v4i16((LAS s16x4*)p); }
__device__ __forceinline__ bf16x8 cat8(s16x4 a, s16x4 b) { return (bf16x8){a[0], a[1], a[2], a[3], b[0], b[1], b[2], b[3]}; }
constexpr int GQ_S = 288, GV_S = 128, GT_S = 128, GST_S = 288, GA_S = 128;
constexpr int G_QR = 0, G_LR = 64 * GQ_S, G_VR = 2 * 64 * GQ_S, G_VRSZ = 64 * GV_S, G_QTT = G_VR + 2 * G_VRSZ, G_TSZ = 128 * GT_S, G_KTT = G_QTT + 2 * G_TSZ,
              G_ST = G_KTT + 2 * G_TSZ, G_AM = G_ST + 64 * GST_S, G_VEC = G_AM + 64 * GA_S, G_VECSZ = 3 * 512, G_END = G_VEC + 2 * G_VECSZ;
static_assert(G_END <= LDS_MISC, "GLA LDS map");
static_assert((G_VR % 128) == 0 && (G_QTT % 128) == 0 && (G_KTT % 128) == 0 && (G_ST % 128) == 0 && (G_AM % 128) == 0 && (G_TSZ % 128) == 0 && (G_VRSZ % 128) == 0, "GLA LDS alignment");

struct GlaLane { int w, g, c, q, p, hi, c32, blk; };
__device__ __forceinline__ const LAS unsigned char* vbase(const LAS unsigned char* p) { asm volatile("" : "+v"(p)); return p; }
__device__ __forceinline__ LAS unsigned char* vbasew(LAS unsigned char* p) { asm volatile("" : "+v"(p)); return p; }
__device__ __forceinline__ const LAS unsigned char* lxor(const LAS unsigned char* p, unsigned x) { return (const LAS unsigned char*)(uintptr_t)((unsigned)(uintptr_t)p ^ x); }
__device__ __forceinline__ LAS unsigned char* lxorw(LAS unsigned char* p, unsigned x) { return (LAS unsigned char*)(uintptr_t)((unsigned)(uintptr_t)p ^ x); }
__device__ __forceinline__ int s13(int r) { return ((r >> 1) & 1) | (((r >> 3) & 1) << 1); }
__device__ __forceinline__ int s31(int r) { return ((r >> 3) & 1) | (((r >> 1) & 1) << 1); }
__device__ __forceinline__ void gla_secB(const GlaLane& t, const LAS unsigned char* QR, const LAS unsigned char* LR, LAS unsigned char* QTT, LAS unsigned char* KTT, LAS float* vec) {
    const int w = t.w, g = t.g, c = t.c, q = t.q, p = t.p;
    const int k = 16 * w + c;
    const LAS unsigned char* lb8 = vbase(LR + (8 * g + q) * GQ_S + (((16 * w + 4 * p) * 2) ^ ((g & 1) << 7)));
    const LAS unsigned char* lb4 = vbase(LR + (4 * g + q) * GQ_S + (((16 * w + 4 * p) * 2) ^ (((g >> 1) & 1) << 7)));
    const LAS unsigned char* qb4 = vbase(QR + (4 * g + q) * GQ_S + (((16 * w + 4 * p) * 2) ^ (((g >> 1) & 1) << 7)));
    s16x4 b0 = tr16(lb8), b1 = tr16(lb8 + 4 * GQ_S), b2 = tr16(lb8 + 32 * GQ_S), b3 = tr16(lb8 + 36 * GQ_S);
    s16x4 qv[4], lv[4];
#pragma unroll
    for (int lt = 0; lt < 4; ++lt) { qv[lt] = tr16(qb4 + 16 * lt * GQ_S); lv[lt] = tr16(lb4 + 16 * lt * GQ_S); }
    bf16x8 bf[2]; bf[0] = cat8(b0, b1); bf[1] = cat8(b2, b3);
    f32x4 cb[4];
#pragma unroll
    for (int lt = 0; lt < 4; ++lt) {
        cb[lt] = (f32x4){0.f, 0.f, 0.f, 0.f};
#pragma unroll
        for (int ks = 0; ks < 2; ++ks) {
            if (ks == 1 && lt < 2) continue;
            bf16x8 tri;
#pragma unroll
            for (int j = 0; j < 8; ++j) tri[j] = (32 * ks + 8 * g + j <= 16 * lt + c) ? (short)0x3F80 : (short)0;
            cb[lt] = __builtin_amdgcn_mfma_f32_16x16x32_bf16(tri, bf[ks], cb[lt], 0, 0, 0);
        }
    }
    const float bmid = __shfl(cb[2][0], c), blast = __shfl(cb[3][3], 48 + c);
    LAS unsigned char* qw = vbasew(QTT + k * GT_S + 32 * s13(c) + 16 * ((g >> 1) ^ (c & 1)) + 8 * ((g & 1) ^ ((c >> 2) & 1)));
    LAS unsigned char* kw = vbasew(KTT + k * GT_S + 32 * s13(c) + 16 * ((g >> 1) ^ ((c >> 2) & 1)) + 8 * (g & 1));
#pragma unroll
    for (int lt = 0; lt < 4; ++lt) {
        float qt[4], kt[4], fe[4];
#pragma unroll
        for (int e = 0; e < 4; ++e) fe[e] = __builtin_amdgcn_exp2f(bf2f((bf16_t)lv[lt][e]));
        float up[4], dn[4];
        up[0] = __builtin_amdgcn_exp2f(cb[lt][0] - bmid); up[1] = up[0] * fe[1]; up[2] = up[1] * fe[2]; up[3] = up[2] * fe[3];
        dn[3] = __builtin_amdgcn_exp2f(bmid - cb[lt][3]); dn[2] = dn[3] * fe[3]; dn[1] = dn[2] * fe[2]; dn[0] = dn[1] * fe[1];
#pragma unroll
        for (int e = 0; e < 4; ++e) qt[e] = bf2f((bf16_t)qv[lt][e]) * up[e];
        kt[0] = dn[0] - dn[0] * fe[0]; kt[1] = dn[1] - dn[0]; kt[2] = dn[2] - dn[1]; kt[3] = dn[3] - dn[2];
        u32x2 wq, wk; wq.x = cvt_pk_bf16(qt[0], qt[1]); wq.y = cvt_pk_bf16(qt[2], qt[3]); wk.x = cvt_pk_bf16(kt[0], kt[1]); wk.y = cvt_pk_bf16(kt[2], kt[3]);
        *(LAS u32x2*)lxorw(qw, 32 * lt) = wq;
        *(LAS u32x2*)lxorw(kw, 32 * lt) = wk;
    }
    if (g == 0) { vec[k] = __builtin_amdgcn_exp2f(bmid); vec[128 + k] = __builtin_amdgcn_exp2f(blast); vec[256 + k] = __builtin_amdgcn_exp2f(blast - bmid); }
}
__device__ __forceinline__ void gla_secC(const GlaLane& t, const f32x16& S, const LAS float* ebm, LAS unsigned char* ST, const LAS unsigned char* QTT, const LAS unsigned char* KTT, LAS unsigned char* AM) {
    const int w = t.w, g = t.g, c = t.c, q = t.q, p = t.p, hi = t.hi, c32 = t.c32;
    const int kb = w >> 1, vb = w & 1, v = 32 * vb + c32;
    int ti = w;
    int mt = ti < 4 ? 0 : (ti < 7 ? 1 : (ti < 9 ? 2 : 3)), lt = ti - (mt == 0 ? 0 : (mt == 1 ? 3 : (mt == 2 ? 5 : 6)));
    const int sl = s13(8 * g + q);
    const LAS unsigned char* kl0 = vbase(KTT + (8 * g + q) * GT_S + 32 * sl + 16 * (p >> 1) + 8 * (p & 1));
    const LAS unsigned char* kl4 = vbase(KTT + (8 * g + q + 4) * GT_S + 32 * sl + 16 * ((p >> 1) ^ 1) + 8 * (p & 1));
    const LAS unsigned char* ql0 = vbase(QTT + (8 * g + q) * GT_S + 32 * sl + 16 * ((p >> 1) ^ (q & 1)) + 8 * (p & 1));
    const LAS unsigned char* ql4 = vbase(QTT + (8 * g + q + 4) * GT_S + 32 * sl + 16 * ((p >> 1) ^ (q & 1)) + 8 * ((p & 1) ^ 1));
    const LAS unsigned char* ka0 = vbase(lxor(kl0, 32 * mt)); const LAS unsigned char* ka4 = vbase(lxor(kl4, 32 * mt));
    const LAS unsigned char* qa0 = vbase(lxor(ql0, 32 * lt)); const LAS unsigned char* qa4 = vbase(lxor(ql4, 32 * lt));
    s16x4 ka[8], qb[8];
#pragma unroll
    for (int ks = 0; ks < 4; ++ks) { ka[2 * ks] = tr16(ka0 + 32 * ks * GT_S); ka[2 * ks + 1] = tr16(ka4 + 32 * ks * GT_S);
        qb[2 * ks] = tr16(qa0 + 32 * ks * GT_S); qb[2 * ks + 1] = tr16(qa4 + 32 * ks * GT_S); }
    const LAS unsigned char* eb = vbase((const LAS unsigned char*)(ebm + 32 * kb + 4 * hi));
    f32x4 em[4];
#pragma unroll
    for (int gg = 0; gg < 4; ++gg) em[gg] = *(const LAS f32x4*)(eb + 32 * gg);
    const int su = (c32 >> 2) & 1;
    LAS unsigned char* st0 = vbasew(ST + v * GST_S + 64 * kb + 8 * hi + 16 * su);
    LAS unsigned char* st1 = vbasew(ST + v * GST_S + 64 * kb + 8 * hi + 16 * (su ^ 1));
#pragma unroll
    for (int gg = 0; gg < 4; ++gg) {
        u32x2 ws; ws.x = cvt_pk_bf16(S[4 * gg + 0] * em[gg][0], S[4 * gg + 1] * em[gg][1]); ws.y = cvt_pk_bf16(S[4 * gg + 2] * em[gg][2], S[4 * gg + 3] * em[gg][3]);
        *(LAS u32x2*)(((gg & 1) ? st1 : st0) + 32 * (gg >> 1)) = ws;
    }
    LAS unsigned char* aml = vbasew(AM + c * GA_S + 32 * s13(c) + 16 * ((g >> 1) ^ (c & 1)) + 8 * (g & 1));
    for (;;) {
        f32x4 a4 = (f32x4){0.f, 0.f, 0.f, 0.f};
#pragma unroll
        for (int ks = 0; ks < 4; ++ks) a4 = __builtin_amdgcn_mfma_f32_16x16x32_bf16(cat8(ka[2 * ks], ka[2 * ks + 1]), cat8(qb[2 * ks], qb[2 * ks + 1]), a4, 0, 0, 0);
        if (mt == lt) {
#pragma unroll
            for (int r = 0; r < 4; ++r) a4[r] = (4 * g + r <= c) ? a4[r] : 0.f;
        }
        u32x2 wa; wa.x = cvt_pk_bf16(a4[0], a4[1]); wa.y = cvt_pk_bf16(a4[2], a4[3]);
        *(LAS u32x2*)(lxorw(aml, 32 * mt) + 16 * lt * GA_S) = wa;
        ti += 8; if (ti >= 10) break;
        mt = ti < 9 ? 2 : 3; lt = 3;
        const LAS unsigned char* kb0 = vbase(lxor(kl0, 32 * mt)); const LAS unsigned char* kb4 = vbase(lxor(kl4, 32 * mt));
        const LAS unsigned char* qc0 = lxor(ql0, 96); const LAS unsigned char* qc4 = lxor(ql4, 96);
#pragma unroll
        for (int ks = 0; ks < 4; ++ks) { ka[2 * ks] = tr16(kb0 + 32 * ks * GT_S); ka[2 * ks + 1] = tr16(kb4 + 32 * ks * GT_S);
            qb[2 * ks] = tr16(qc0 + 32 * ks * GT_S); qb[2 * ks + 1] = tr16(qc4 + 32 * ks * GT_S); }
    }
}
__device__ __forceinline__ void gla_secD(const GlaLane& t, f32x16& S, const LAS unsigned char* AM, const LAS unsigned char* QTT, const LAS unsigned char* KTT, const LAS unsigned char* VR,
                                         const LAS unsigned char* ST, const LAS float* vec, bf16_t* orow  ) {
    const int w = t.w, g = t.g, c = t.c, q = t.q, p = t.p, hi = t.hi, c32 = t.c32, blk = t.blk;
    const int lt = w & 3, vt0 = 2 * (w >> 2);
    const int nka = lt < 2 ? 1 : 2;
    const int kb = w >> 1, vb = w & 1;
    bf16x8 bA[2], sa[2][4], kaw[4];
    s16x4 bq[8], va[2][4], vw[8];
    const int sl = s13(8 * g + q);
    const LAS unsigned char* amb = vbase(AM + (16 * lt + c) * GA_S + 32 * ((g >> 1) ^ s13(c)) + 16 * ((g & 1) ^ (c & 1)));
    const LAS unsigned char* qt0 = vbase(QTT + (8 * g + q) * GT_S + 32 * (lt ^ sl) + 16 * ((p >> 1) ^ (q & 1)) + 8 * (p & 1));
    const LAS unsigned char* qt4 = vbase(QTT + (8 * g + q + 4) * GT_S + 32 * (lt ^ sl) + 16 * ((p >> 1) ^ (q & 1)) + 8 * ((p & 1) ^ 1));
    const LAS unsigned char* vrb = vbase(VR + (8 * g + q) * GV_S + 32 * (vt0 ^ s31(8 * g + q)) + 8 * p);
    const LAS unsigned char* stb = vbase(ST + (16 * vt0 + c) * GST_S + 32 * (g >> 1) + 16 * ((g & 1) ^ ((c >> 2) & 1)));
#pragma unroll
    for (int ks = 0; ks < 2; ++ks) bA[ks] = *(const LAS bf16x8*)lxor(amb, 64 * ks);
#pragma unroll
    for (int ks = 0; ks < 4; ++ks) { bq[2 * ks] = tr16(qt0 + 32 * ks * GT_S); bq[2 * ks + 1] = tr16(qt4 + 32 * ks * GT_S); }
#pragma unroll
    for (int vi = 0; vi < 2; ++vi) {
        const LAS unsigned char* vv = lxor(vrb, 32 * vi);
#pragma unroll
        for (int ks = 0; ks < 2; ++ks) { va[vi][2 * ks] = tr16(vv + 32 * ks * GV_S); va[vi][2 * ks + 1] = tr16(vv + (32 * ks + 4) * GV_S); }
#pragma unroll
        for (int ks = 0; ks < 4; ++ks) sa[vi][ks] = *(const LAS bf16x8*)(stb + 16 * vi * GST_S + 64 * ks); }
#pragma unroll
    for (int vi = 0; vi < 2; ++vi) {
        const int vt = vt0 + vi;
        f32x4 o4 = (f32x4){0.f, 0.f, 0.f, 0.f};
#pragma unroll
        for (int ks = 0; ks < 2; ++ks) if (ks < nka) o4 = __builtin_amdgcn_mfma_f32_16x16x32_bf16(cat8(va[vi][2 * ks], va[vi][2 * ks + 1]), bA[ks], o4, 0, 0, 0);
#pragma unroll
        for (int ks = 0; ks < 4; ++ks) o4 = __builtin_amdgcn_mfma_f32_16x16x32_bf16(sa[vi][ks], cat8(bq[2 * ks], bq[2 * ks + 1]), o4, 0, 0, 0);
        u32x2 wo; wo.x = cvt_pk_bf16(o4[0], o4[1]); wo.y = cvt_pk_bf16(o4[2], o4[3]);
        gstore<u32x2>(orow + 16 * vt + 4 * g, wo);
    }
    const LAS unsigned char* ktb = vbase(KTT + (32 * kb + c32) * GT_S + 32 * s13(c32) + 16 * (hi ^ ((c32 >> 2) & 1)));
    const LAS unsigned char* vwb = vbase(VR + (8 * hi + q) * GV_S + 32 * ((2 * vb + blk) ^ s31(8 * hi + q)) + 8 * p);
#pragma unroll
    for (int ks = 0; ks < 4; ++ks) { kaw[ks] = *(const LAS bf16x8*)lxor(ktb, 32 * ks);
        vw[2 * ks] = tr16(vwb + 16 * ks * GV_S); vw[2 * ks + 1] = tr16(vwb + (16 * ks + 4) * GV_S); }
    const LAS unsigned char* veb = vbase((const LAS unsigned char*)(vec + 128 + 32 * kb + 4 * hi));
    f32x4 el[4], ed[4];
#pragma unroll
    for (int gg = 0; gg < 4; ++gg) { el[gg] = *(const LAS f32x4*)(veb + 32 * gg); ed[gg] = *(const LAS f32x4*)(veb + 512 + 32 * gg); }
    f32x16 W;
#pragma unroll
    for (int j = 0; j < 16; ++j) W[j] = 0.f;
#pragma unroll
    for (int ks = 0; ks < 4; ++ks) W = __builtin_amdgcn_mfma_f32_32x32x16_bf16(kaw[ks], cat8(vw[2 * ks], vw[2 * ks + 1]), W, 0, 0, 0);
#pragma unroll
    for (int gg = 0; gg < 4; ++gg)
#pragma unroll
        for (int r = 0; r < 4; ++r) S[4 * gg + r] = el[gg][r] * S[4 * gg + r] + ed[gg][r] * W[4 * gg + r];
}

__device__ __forceinline__ void p_gla(const Frame& F0) {
    const Frame F = relaunder(F0);
    const bf16_t* PR = WSP(bf16_t, WS_PROJ);
    LAS unsigned char* L = F.lds;
    const int tid = F.tid, lane = F.lane;
    GlaLane t; t.w = F.wave; t.g = lane >> 4; t.c = lane & 15; t.q = t.c >> 2; t.p = lane & 3; t.hi = lane >> 5; t.c32 = lane & 31; t.blk = (lane >> 4) & 1;
    constexpr int NCH = SEQ / 64;
    for (int un0 = F.vb; un0 < 256; un0 += F.G) {
        const int un = (((un0 >> 5) * 8 + (un0 & 7)) << 2) | ((un0 >> 3) & 3);
        const int b = un >> 5, h = (un >> 2) & 7, dir = (un >> 1) & 1, vh = un & 1;
        bf16_t* O = WSP(bf16_t, dir ? WS_OB : WS_OF);
        const bf16_t* prb = PR + (size_t)b * SEQ * 5120 + h * 128;
        __syncthreads();
        for (int i = tid; i < 64 * GA_S / 4; i += NTHR) ((LAS unsigned*)(L + G_AM))[i] = 0u;
        f32x16 S;
#pragma unroll
        for (int j = 0; j < 16; ++j) S[j] = 0.f;
        u32x4 qreg[2], lreg[2], vreg;
#define GLA_LOAD(n) do { _Pragma("unroll") for (int i_ = 0; i_ < 2; ++i_) { const int idx = tid + 512 * i_, r_ = idx >> 4, c16 = idx & 15; const int tau = (n) * 64 + r_, t_ = dir ? (SEQ - 1 - tau) : tau; \
            const bf16_t* rp = prb + (size_t)t_ * 5120; qreg[i_] = gload<u32x4>(rp + c16 * 8); lreg[i_] = gload<u32x4>(rp + (2 + dir) * 1024 + c16 * 8); } \
          { const int r_ = tid >> 3, c16 = tid & 7; const int tau = (n) * 64 + r_, t_ = dir ? (SEQ - 1 - tau) : tau; vreg = gload<u32x4>(prb + (size_t)t_ * 5120 + 1024 + vh * 64 + c16 * 8); } } while (0)
#define GLA_WRITE(pv) do { _Pragma("unroll") for (int i_ = 0; i_ < 2; ++i_) { const int idx = tid + 512 * i_, r_ = idx >> 4, c16 = idx & 15; \
            const int co_ = (c16 * 16) ^ (((r_ >> 3) & 1) << 7); *(LAS u32x4*)(L + G_QR + r_ * GQ_S + co_) = qreg[i_]; *(LAS u32x4*)(L + G_LR + r_ * GQ_S + co_) = lreg[i_]; } \
          { const int r_ = tid >> 3, c16 = tid & 7; *(LAS u32x4*)(L + G_VR + (pv) * G_VRSZ + r_ * GV_S + 32 * ((c16 >> 1) ^ s31(r_)) + 16 * (c16 & 1)) = vreg; } } while (0)
        GLA_LOAD(0); GLA_WRITE(0); GLA_LOAD(1);
        __syncthreads();
        gla_secB(t, L + G_QR, L + G_LR, L + G_QTT, L + G_KTT, (LAS float*)(L + G_VEC));
        for (int n = 0; n < NCH; ++n) {
            const int pb = n & 1;
            __syncthreads();
            if (n + 1 < NCH) { GLA_WRITE(pb ^ 1); if (n + 2 < NCH) GLA_LOAD(n + 2); }
            gla_secC(t, S, (const LAS float*)(L + G_VEC + pb * G_VECSZ), L + G_ST, L + G_QTT + pb * G_TSZ, L + G_KTT + pb * G_TSZ, L + G_AM);
            __syncthreads();
            { const int tau = n * 64 + 16 * (t.w & 3) + t.c, tt = dir ? (SEQ - 1 - tau) : tau;
              gla_secD(t, S, L + G_AM, L + G_QTT + pb * G_TSZ, L + G_KTT + pb * G_TSZ, L + G_VR + pb * G_VRSZ, L + G_ST, (const LAS float*)(L + G_VEC + pb * G_VECSZ),
                       O + ((size_t)(b * SEQ + tt)) * DM + h * 128 + vh * 64); }
            if (n + 1 < NCH) gla_secB(t, L + G_QR, L + G_LR, L + G_QTT + (pb ^ 1) * G_TSZ, L + G_KTT + (pb ^ 1) * G_TSZ, (LAS float*)(L + G_VEC + (pb ^ 1) * G_VECSZ));
        }
#undef GLA_LOAD
#undef GLA_WRITE
    }
    __syncthreads();
}

__device__ __forceinline__ void p_gate(const Frame& F0) {
    const Frame F = relaunder(F0);
    bf16_t* OFp = WSP(bf16_t, WS_OF); const bf16_t* OBp = WSP(bf16_t, WS_OB); const bf16_t* PR = WSP(bf16_t, WS_PROJ); const float* ng = F.in[10];
    const int ln = F.lane;
    float gv[8];
#pragma unroll
    for (int j = 0; j < 8; ++j) gv[j] = ng[(8 * ln + j) & 127];
    for (int tb = (F.vb * 8 + F.wave) * 2; tb < NTOK; tb += F.G * 8 * 2) {
        u32x4 av[2][2], bv[2][2], gqv[2][2];
#pragma unroll
        for (int u2 = 0; u2 < 2; ++u2)
#pragma unroll
            for (int ii = 0; ii < 2; ++ii) { const int t = tb + u2, c0 = ii * 512 + ln * 8;
                av[u2][ii] = gload<u32x4>(OFp + (size_t)t * DM + c0); bv[u2][ii] = gload<u32x4>(OBp + (size_t)t * DM + c0); gqv[u2][ii] = gload<u32x4>(PR + (size_t)t * 5120 + 4096 + c0); }
#pragma unroll
        for (int u2 = 0; u2 < 2; ++u2)
#pragma unroll
        for (int ii = 0; ii < 2; ++ii) {
            const int t = tb + u2, c0 = ii * 512 + ln * 8;
            const u32x4 a = av[u2][ii], bq = bv[u2][ii], gq = gqv[u2][ii];
            float o[8] = {lo_bf(a.x) + lo_bf(bq.x), hi_bf(a.x) + hi_bf(bq.x), lo_bf(a.y) + lo_bf(bq.y), hi_bf(a.y) + hi_bf(bq.y), lo_bf(a.z) + lo_bf(bq.z), hi_bf(a.z) + hi_bf(bq.z), lo_bf(a.w) + lo_bf(bq.w), hi_bf(a.w) + hi_bf(bq.w)};
            const float gs[8] = {lo_bf(gq.x), hi_bf(gq.x), lo_bf(gq.y), hi_bf(gq.y), lo_bf(gq.z), hi_bf(gq.z), lo_bf(gq.w), hi_bf(gq.w)};
            float q = 0.f;
#pragma unroll
            for (int j = 0; j < 8; ++j) q += o[j] * o[j];
            q += __shfl_xor(q, 1); q += __shfl_xor(q, 2); q += __shfl_xor(q, 4); q += __shfl_xor(q, 8);
            const float rs = rsqrtf(q * (1.0f / 128.0f) + LN_EPS);
#pragma unroll
            for (int j = 0; j < 8; ++j) o[j] = o[j] * rs * gv[j] * gs[j];
            u32x4 w; w.x = cvt_pk_bf16(o[0], o[1]); w.y = cvt_pk_bf16(o[2], o[3]); w.z = cvt_pk_bf16(o[4], o[5]); w.w = cvt_pk_bf16(o[6], o[7]);
            gstore<u32x4>(OFp + (size_t)t * DM + c0, w);
        }
    }
}

constexpr int FILL_TILES = 1, MOE_TILES = 32 * 384;
constexpr int TAIL_GU = 20, TAIL_DN = 16, FILL_L1_FS = 16;
__device__ __forceinline__ int moe_idle_wgs(int ntile, int G) { const int rem = (ntile * 4) % G; return rem > 0 ? G - rem : 0; }
__device__ __forceinline__ int moe_tail_done(int ntile, int G) { const int d = moe_idle_wgs(ntile, G) * (TAIL_GU + TAIL_DN); return d < MOE_TILES ? d : MOE_TILES; }
__device__ __forceinline__ bf16_t* moe_wgu(const Frame& F, int l) { return l ? (bf16_t*)F.out : WSP(bf16_t, WS_WGU); }
__device__ __forceinline__ bf16_t* moe_wdn(const Frame& F, int l) { return l ? (bf16_t*)F.out + (size_t)33554432 : WSP(bf16_t, WS_WDN); }
__device__ __forceinline__ void fill_tile(const Frame& F, int gid) {
    int ln = (int)__builtin_amdgcn_mbcnt_hi(~0u, __builtin_amdgcn_mbcnt_lo(~0u, 0u)); asm volatile("" : "+v"(ln));
    const int l = gid >= MOE_TILES ? 1 : 0, tl = gid - l * MOE_TILES;
    MoeMap M{F.in[19] + (size_t)l * 32 * 524288, F.in[20] + (size_t)l * 32 * 524288, F.in[21] + (size_t)l * 32 * 524288, moe_wgu(F, l), moe_wdn(F, l)};
    const TDesc d = M(tl);
    LAS unsigned char* img = F.lds + (F.wave - 1) * 8192;
    const int kp = ln >> 3, ng = ln & 7;
    f32x4 v[4][2][2];
#pragma unroll
    for (int p = 0; p < 4; ++p)
#pragma unroll
        for (int h = 0; h < 2; ++h) { const float* sp = d.src + (size_t)(16 * p + 2 * kp + h) * d.ldsrc + 8 * ng; v[p][h][0] = gload<f32x4>(sp); v[p][h][1] = gload<f32x4>(sp + 4); }
#pragma unroll
    for (int p = 0; p < 4; ++p)
#pragma unroll
        for (int j = 0; j < 8; ++j) { const int n = 8 * ng + j, kd = (8 * p + kp) ^ (ng << 2);
            *(LAS unsigned*)(img + n * 128 + kd * 4) = cvt_pk_bf16(v[p][0][j >> 2][j & 3], v[p][1][j >> 2][j & 3]); }
    asm volatile("s_waitcnt lgkmcnt(0)" ::: "memory");
#pragma unroll
    for (int r = 0; r < 8; ++r) { const int n = 8 * r + kp, kc = ng;
        const u32x4 w = *(const LAS u32x4*)(img + n * 128 + ((kc ^ r) << 4));
        gstore<u32x4>(d.dst + (size_t)n * d.ldd + 8 * kc, w); }
    asm volatile("s_waitcnt lgkmcnt(0)" ::: "memory");
}
__device__ __forceinline__ void xcd_barrier_fill(const XcdBarrier& b, const Frame& F0, int& fs) {
    asm volatile("s_waitcnt vmcnt(0)" ::: "memory");
    __syncthreads();
    if (b.wave == 0) xcd_barrier_core(b);
    else if (F0.G == 256) {
        const Frame F = relaunder(F0);
#pragma unroll
        for (int i = 0; i < FILL_TILES; ++i) {
            if (fs < 7) { const int q = fs * 7 + (F.wave - 1); const int gid = q * 256 + F.vb; if (gid < MOE_TILES) fill_tile(F, gid); }
            else if (fs >= FILL_L1_FS && fs < FILL_L1_FS + 8) {
                const int ntile = __builtin_amdgcn_readfirstlane(WSP(int, WS_TILEEXP)[320]);
                const int q = (fs - FILL_L1_FS) * 7 + (F.wave - 1); const int tl = moe_tail_done(ntile, F.G) + q * 256 + F.vb; if (tl < MOE_TILES) fill_tile(F, MOE_TILES + tl); }
        }
    }
    ++fs;
    __syncthreads();
}

struct MoeOffMap { MoeMap M; int off; __device__ __forceinline__ TDesc operator()(int tl) const { return M(tl + off); } };
__device__ __forceinline__ void moe_tail_convert(const Frame& F, int ntile, int which) {
    const int idle = moe_idle_wgs(ntile, F.G), rem = F.G - idle, j = F.vb - rem;
    if (F.G != 256 || idle == 0 || j < 0) return;
    const int per = which ? TAIL_DN : TAIL_GU, first = which ? idle * TAIL_GU : 0;
    int cnt = idle * per; if (first + cnt > MOE_TILES) cnt = MOE_TILES - first; if (cnt <= 0) return;
    MoeOffMap T{MoeMap{F.in[19] + (size_t)32 * 524288, F.in[20] + (size_t)32 * 524288, F.in[21] + (size_t)32 * 524288, (bf16_t*)F.out, (bf16_t*)F.out + (size_t)33554432}, first};
    __syncthreads();
    tconv_run_sub(F, cnt, T, j, idle);
}
__device__ __forceinline__ bool phase_in(int lo, int hi, int k) {
#if ONE_LAUNCH
    asm volatile("" : "+s"(lo), "+s"(hi));
#endif
    return lo <= k && k < hi;
}
constexpr int N_PHASES = 34;
__global__ void __launch_bounds__(NTHR, 2) mk_fwd(Args args) {
    extern __shared__ __attribute__((aligned(1024))) unsigned char lds_raw[];
    Frame F0;
    const __attribute__((address_space(4))) Args* kp = (const __attribute__((address_space(4))) Args*)__builtin_amdgcn_kernarg_segment_ptr();
    F0.in = (InPtr)(kp->in); F0.out = kp->out; F0.ws = kp->ws; F0.lds = (LAS unsigned char*)lds_raw;
    F0.tid = threadIdx.x; F0.lane = F0.tid & 63; F0.wave = __builtin_amdgcn_readfirstlane(F0.tid >> 6); F0.G = gridDim.x; F0.vb = blockIdx.x;
    volatile LAS unsigned* misc = (volatile LAS unsigned*)(F0.lds + LDS_MISC);
    if (F0.tid < 4) misc[F0.tid] = 0u;
    __syncthreads();
    XcdBarrier bar; bar.bar = (unsigned*)(F0.ws + WS_CTL); bar.x = 0; bar.st = misc; bar.wave = F0.wave;
#if ONE_LAUNCH
    bar = xcd_barrier_post((unsigned*)(F0.ws + WS_CTL), misc, F0.wave);
#endif
#if ONE_LAUNCH
    int lo = 0, hi = N_PHASES;
#define OPAQUE_RANGE() do { asm volatile("" : "+s"(lo), "+s"(hi)); } while (0)
#else
    const int lo = kp->ph_lo, hi = kp->ph_hi;
#define OPAQUE_RANGE() do { } while (0)
#endif
#ifndef PHASE_MASK
#define PHASE_MASK 0xFFFFFFFFFFull
#endif
#define IN(k) ((((unsigned long long)PHASE_MASK >> (k)) & 1ull) && phase_in(lo, hi, (k)))
#define SEAM(k) do { if (IN(k) && IN((k) + 1)) xcd_barrier_fill(bar, F0, fs); } while (0)
#define INC(k) ((((unsigned long long)PHASE_MASK >> (9 + (k))) & 1ull) && phase_in(lo, hi, pb + (k)))
#define SEAMC(k) do { if (lo <= pb + (k) && pb + (k) + 1 < hi) xcd_barrier_fill(bar, F0, fs); } while (0)

#ifndef REPEAT_MASK
#define REPEAT_MASK 0ull
#endif
#define NREP(k) ((((unsigned long long)REPEAT_MASK >> (k)) & 1ull) ? 2 : 1)
    int fs = 0;
    if (IN(0)) { p_prologue(F0); } SEAM(0);
    if (IN(1)) { p_kv_a(F0); xcd_barrier_fill(bar, F0, fs); p_kv_b(F0, 0); } SEAM(1);
    for (int l = 0; l < 2; ++l) {
        if (l == 0) {
            if (IN(2)) { const Frame F = relaunder(F0); gemm_plain(F, WSP(bf16_t, WS_XB), 1024, WSP(bf16_t, WS_W1CAT), NTOK, 1024, 1024, WSP(bf16_t, WS_U), 1024); } SEAM(2);
            if (IN(3)) { p_pool_hln(F0); } SEAM(3);
            if (IN(4)) { const Frame F = relaunder(F0);
                GemmD g{WSP(bf16_t, WS_PQT), WSP(bf16_t, WS_UN), 128, 512, 128, 128, 128};
                SchedB S = mk_sched(F, 32, 1, 16, 4, 0, (unsigned)256 * 128 * 2, (unsigned)SEQ * 512 * 2, (unsigned)128 * 2, 0, (unsigned)256 * 512 * 2);
                EpiBf16 E{WSP(bf16_t, WS_ZT), 4096, 1, (unsigned)256 * 4096, 0};
                gemm_phase<EpiBf16, SchedB>(F.lds, g, S, E, F.wave);
            } SEAM(4);
            if (IN(5)) { const Frame F = relaunder(F0);
                GemmD g{WSP(bf16_t, WS_W1DFT), WSP(bf16_t, WS_ZT), 128, 64, 128, (unsigned)128 * 4096 * 2, 128};
                SchedB S = mk_sched(F, 32, 1, 32, 1, 0, 0, (unsigned)256 * 4096 * 2, 0, 0, (unsigned)256 * 64 * 2);
                EpiFft1 E{WSP(bf16_t, WS_YP), WSP(float, WS_TW)};
                gemm_phase<EpiFft1, SchedB>(F.lds, g, S, E, F.wave);
            } SEAM(5);
            if (IN(6)) { const Frame F = relaunder(F0);
                GemmD g{WSP(bf16_t, WS_W2DFT), WSP(bf16_t, WS_YP), 128, 128, 128, 128, 128};
                SchedB S = mk_sched(F, 32, 1, 32, 1, 0, 0, (unsigned)8192 * 128 * 2, 0, 0, (unsigned)256 * 128 * 2);
                EpiFft2 E{WSP(bf16_t, WS_YCAT)};
                gemm_phase<EpiFft2, SchedB>(F.lds, g, S, E, F.wave);
            } SEAM(6);
            if (IN(7)) { const Frame F = relaunder(F0); gemm_plain(F, WSP(bf16_t, WS_YCAT), 1024, WSP(bf16_t, WS_PFWOUT), NTOK, 1024, 1024, WSP(bf16_t, WS_H0), 1024); } SEAM(7);
            if (IN(8)) { p_ln<0, true, false>(F0, F0.in[0], (bf16_t*)(F0.ws + WS_H0), 0, 0); } SEAM(8);
        } else {
            if (IN(19)) { const Frame F = relaunder(F0);
                { GemmD g{WSP(bf16_t, WS_XB), WSP(bf16_t, WS_HGWIN), 1024, 1024, 128, 128, 1024};
                  SchedB S = mk_sched(F, 1, NTOK / 256, 12, 1, 0, 0, 0, 0, (unsigned)256 * 1024 * 2, (unsigned)256 * 1024 * 2);
                  EpiProjA E{WSP(bf16_t, WS_PROJ)};
                  gemm_phase<EpiProjA, SchedB>(F.lds, g, S, E, F.wave); }
                { GemmD g{WSP(bf16_t, WS_XB), WSP(bf16_t, WS_HGWIN) + (size_t)3072 * 1024, 1024, 1024, 128, 128, 1024};
                  SchedB S = mk_sched(F, 1, NTOK / 256, 8, 1, 0, 0, 0, 0, (unsigned)256 * 1024 * 2, (unsigned)256 * 1024 * 2);
                  EpiProjB E{WSP(bf16_t, WS_PROJ), WSP(float, WS_LB1)};
                  gemm_phase<EpiProjB, SchedB>(F.lds, g, S, E, F.wave); }
            } SEAM(19);
            if (IN(20)) { { p_gla(F0); } } SEAM(20);
            if (IN(21)) { p_gate(F0); p_kv_b(F0, 1); } SEAM(21);
            if (IN(22)) { const Frame F = relaunder(F0); gemm_plain(F, WSP(bf16_t, WS_OF), 1024, WSP(bf16_t, WS_HGWOUT), NTOK, 1024, 1024, WSP(bf16_t, WS_OB), 1024); } SEAM(22);
            if (IN(23)) { p_ln<0, false, false>(F0, nullptr, (bf16_t*)(F0.ws + WS_OB), 1, 0); if (F0.G != 256) { __syncthreads(); moe_convert(F0, 1); } } SEAM(23);
        }
        const int pb = l ? 24 : 9;
        if (INC(1)) { const Frame F = relaunder(F0);
            GemmD g{WSP(bf16_t, WS_XB), WSP(bf16_t, WS_KM), 1024, 1024, 128, 128, 1024};
            SchedB S = mk_sched(F, 32, 16, 1, 4, (unsigned)SEQ * 1024 * 2, 0, (unsigned)4 * 256 * 1024 * 2, (unsigned)256 * 1024 * 2, (unsigned)256 * 1024 * 2, 0);
            EpiSoftmax E{WSP(bf16_t, WS_SC), 0.0625f, (LAS float*)(F.lds + STAGE_BYTES)};
            gemm_phase<EpiSoftmax, SchedB>(F.lds, g, S, E, F.wave);
        } SEAMC(1);
        if (INC(3)) { const Frame F = relaunder(F0);
            GemmD g{WSP(bf16_t, WS_SC), WSP(bf16_t, WS_VW), 1024, 1024, 128, 128, 1024};
            SchedB S = mk_sched(F, 8, 16, 4, 1, (unsigned)SEQ * 1024 * 2, 0, (unsigned)1024 * 1024 * 2, 0, (unsigned)256 * 1024 * 2, (unsigned)256 * 1024 * 2);
            EpiBf16 E{WSP(bf16_t, WS_HX), 1024, 1, (unsigned)SEQ * 1024, 0};
            gemm_phase<EpiBf16, SchedB>(F.lds, g, S, E, F.wave);
        } SEAMC(3);
        if (INC(5)) { p_ln<1, false, false>(F0, nullptr, (bf16_t*)(F0.ws + WS_HX), l, 1); } SEAMC(5);
        if (INC(6)) { p_dispatch(F0); } SEAMC(6);
        if (INC(7)) { const Frame F = relaunder(F0);
            const int ntile = __builtin_amdgcn_readfirstlane(WSP(int, WS_TILEEXP)[320]);
            GemmD g{WSP(bf16_t, WS_XB), l ? (bf16_t*)F.out : WSP(bf16_t, WS_WGU), 1024, 1024, 128, 128, 1024};
            SchedMoe<true> S{ntile, 4, F.G, F.vb, WSP(int, WS_TILEEXP), (unsigned)256 * 1024 * 2, (unsigned)256 * 1024 * 2, (unsigned)1048576 * 2, WSP(int, WS_ROWTOK)};
            EpiGU E{WSP(bf16_t, WS_HID)};
            gemm_phase<EpiGU, SchedMoe<true>>(F.lds, g, S, E, F.wave);
            if (l == 0) moe_tail_convert(F, ntile, 0);
        } SEAMC(7);
        if (INC(8)) { const Frame F = relaunder(F0);
            const int ntile = __builtin_amdgcn_readfirstlane(WSP(int, WS_TILEEXP)[320]);
            GemmD g{WSP(bf16_t, WS_HID), l ? (bf16_t*)F.out + (size_t)33554432 : WSP(bf16_t, WS_WDN), 512, 512, 128, 128, 512};
            SchedMoe<false> S{ntile, 4, F.G, F.vb, WSP(int, WS_TILEEXP), (unsigned)256 * 512 * 2, (unsigned)256 * 512 * 2, (unsigned)524288 * 2, nullptr};
            EpiDown E{WSP(bf16_t, WS_XSY), WSP(float, WS_GPOS)};
            gemm_phase<EpiDown, SchedMoe<false>>(F.lds, g, S, E, F.wave);
            if (l == 0) moe_tail_convert(F, ntile, 1);
        } SEAMC(8);
        if (INC(9)) { if (l == 0) p_ln<2, false, false>(F0, nullptr, (bf16_t*)(F0.ws + WS_XSY), l, 2); else p_ln<2, false, true>(F0, nullptr, (bf16_t*)(F0.ws + WS_XSY), l, 2); } SEAMC(9);
    }
#undef IN
#undef SEAM
#undef INC
#undef SEAMC
}

extern "C" void kernel_launch(void* const* d_in, const int* in_sizes, int n_in, void* d_out, int out_size, void* d_ws, size_t ws_size, hipStream_t stream) {
    static int grid = 0;
    if (grid == 0) {
        if (n_in != 24 || out_size != NTOK * DM || ws_size < WS_END) { fprintf(stderr, "kernel_launch: unexpected shapes (n_in %d, out %d, ws %zu, need %zu)\n", n_in, out_size, ws_size, (size_t)WS_END); grid = -1; return; }
        int dev = 0, cus = 0;
        if (hipGetDevice(&dev) != hipSuccess || hipDeviceGetAttribute(&cus, hipDeviceAttributeMultiprocessorCount, dev) != hipSuccess) { grid = -1; return; }
        if (hipFuncSetAttribute((const void*)mk_fwd, hipFuncAttributeMaxDynamicSharedMemorySize, LDS_BYTES) != hipSuccess) { fprintf(stderr, "kernel_launch: hipFuncSetAttribute failed\n"); grid = -1; return; }
        int per_cu = 0;
        if (hipOccupancyMaxActiveBlocksPerMultiprocessor(&per_cu, (const void*)mk_fwd, NTHR, LDS_BYTES) != hipSuccess || per_cu < 1) fprintf(stderr, "kernel_launch: occupancy query reports %d\n", per_cu);
        (void)hipGetLastError();
        grid = cus;
    }
    if (grid < 0) return;
    (void)hipMemsetAsync((char*)d_ws + WS_CTL, 0, CTL_ZERO_BYTES, stream);
    Args a{};
    for (int i = 0; i < 24; ++i) a.in[i] = (const float*)d_in[i];
    a.out = (float*)d_out; a.ws = (unsigned char*)d_ws;
#if ONE_LAUNCH
    a.ph_lo = 0; a.ph_hi = N_PHASES;
    hipLaunchKernelGGL(mk_fwd, dim3(grid), dim3(NTHR), LDS_BYTES, stream, a);
#else
    for (int p = 0; p < N_PHASES; ++p) { a.ph_lo = p; a.ph_hi = p + 1; hipLaunchKernelGGL(mk_fwd, dim3(grid), dim3(NTHR), LDS_BYTES, stream, a); }
#endif
}
```

```cpp
#include <hip/hip_runtime.h>
#include <stdint.h>
#include <stdio.h>

#ifndef ONE_LAUNCH
#define ONE_LAUNCH 1
#endif

#define LAS __attribute__((address_space(3)))
typedef unsigned short bf16_t;
typedef short bf16x8 __attribute__((ext_vector_type(8)));
typedef float f32x4 __attribute__((ext_vector_type(4)));
typedef float f32x2 __attribute__((ext_vector_type(2)));
typedef unsigned u32x4 __attribute__((ext_vector_type(4)));
typedef unsigned u32x2 __attribute__((ext_vector_type(2)));

constexpr int NB = 8, SEQ = 4096, DM = 1024, NTOK = NB * SEQ, MEML = 256;
constexpr float DN_ALPHA = 1.4142135623730951f;
constexpr float LN_EPS = 1e-5f;
constexpr int NTHR = 512;
constexpr int LDS_BYTES = 163840;
constexpr int LDS_MISC = 160 * 1024 - 256;

constexpr size_t KiB = 1024, MiB = 1024 * 1024;
constexpr size_t WS_CTL = 0;
constexpr size_t CTL_ZERO_BYTES = 16 * KiB;
constexpr size_t WS_W1DFT = 64 * KiB, WS_W2DFT = 128 * KiB, WS_TW = 192 * KiB, WS_PQT = 256 * KiB, WS_LB1 = 512 * KiB;
constexpr size_t WS_HIST = 576 * KiB, WS_TILEEXP = 640 * KiB;
constexpr size_t WS_ROWTOK = 2 * MiB + 512 * KiB;
constexpr size_t WS_TOKE = 1 * MiB, WS_TOKG = 1 * MiB + 256 * KiB, WS_POSS = 1 * MiB + 512 * KiB, WS_GPOS = 2 * MiB;
constexpr size_t WS_W1CAT = 4 * MiB, WS_PFWOUT = 6 * MiB, WS_HGWIN = 8 * MiB, WS_HGWOUT = 18 * MiB;
constexpr size_t WS_WQN1 = 20 * MiB, WS_WOT1 = 22 * MiB, WS_KB1 = 24 * MiB, WS_VB1 = 28 * MiB, WS_KM = 32 * MiB, WS_VW = 48 * MiB, WS_XB = 64 * MiB;
constexpr size_t ARENA = 128 * MiB;
constexpr size_t WS_WGU = ARENA, WS_WDN = ARENA + 64 * MiB;
constexpr size_t ACT = ARENA + 96 * MiB;
constexpr size_t WS_WK = ACT, WS_WV = ACT + 4 * MiB, WS_MEMBF = ACT + 8 * MiB, WS_WQN0 = ACT + 12 * MiB, WS_WOT0 = ACT + 14 * MiB, WS_KB0 = ACT + 16 * MiB, WS_VB0 = ACT + 20 * MiB;
constexpr size_t WS_U = ACT, WS_UN = ACT + 64 * MiB, WS_YCAT = ACT + 96 * MiB, WS_ZT = ACT + 160 * MiB, WS_YP = ACT + 224 * MiB, WS_H0 = ACT;
constexpr size_t WS_SC = ACT, WS_HX = ACT + 64 * MiB;
constexpr size_t WS_XSY = ACT, WS_HID = ACT + 144 * MiB;
constexpr size_t WS_PROJ = ARENA, WS_OF = ARENA + 320 * MiB, WS_OB = ARENA + 384 * MiB;
constexpr size_t WS_END = ARENA + 448 * MiB;
constexpr int MPAD_MAX = 73728;

__device__ __forceinline__ float bf2f(bf16_t b) { return __uint_as_float(((unsigned)b) << 16); }
typedef __bf16 bf16x2_t __attribute__((ext_vector_type(2)));
__device__ __forceinline__ unsigned cvt_pk_bf16(float lo, float hi) { const bf16x2_t v = __builtin_convertvector((f32x2){lo, hi}, bf16x2_t); return __builtin_bit_cast(unsigned, v); }
__device__ __forceinline__ bf16_t f2bf(float f) { return (bf16_t)(cvt_pk_bf16(f, 0.f) & 0xffffu); }
__device__ __forceinline__ float lo_bf(unsigned w) { return __uint_as_float(w << 16); }
__device__ __forceinline__ float hi_bf(unsigned w) { return __uint_as_float(w & 0xffff0000u); }
__device__ __forceinline__ float fast_sigmoid(float p) { return __builtin_amdgcn_rcpf(1.0f + __builtin_amdgcn_exp2f(p * -1.4426950408889634f)); }
#define GAS __attribute__((address_space(1)))
template <class V> __device__ __forceinline__ void gstore(void* p, const V v) { *(GAS V*)p = v; }
template <class V> __device__ __forceinline__ V gload(const void* p) { return *(const GAS V*)p; }
__device__ __forceinline__ float wave_sum(float v) {
#pragma unroll
    for (int o = 32; o >= 1; o >>= 1) v += __shfl_xor(v, o);
    return v;
}
__device__ __forceinline__ float wave_max(float v) {
#pragma unroll
    for (int o = 32; o >= 1; o >>= 1) v = fmaxf(v, __shfl_xor(v, o));
    return v;
}

#define XB_TMO      128
#define XB_XCNT(j)  (256  + 64 * (j))
#define XB_XSUB(j)  (1280 + 64 * (j))
#define XB_XGEN(j)  (2304 + 64 * (j))
#define XB_TOP      3328
#define XB_TOPGEN   3392
#define XCD_BAR_WORDS 3456
#define XB_SPIN_CAP (1u << 22)

__device__ __forceinline__ unsigned xb_ld(unsigned* p)              { return __hip_atomic_load(p, __ATOMIC_RELAXED, __HIP_MEMORY_SCOPE_AGENT); }
__device__ __forceinline__ unsigned xb_add(unsigned* p, unsigned v) { return __hip_atomic_fetch_add(p, v, __ATOMIC_RELAXED, __HIP_MEMORY_SCOPE_AGENT); }
__device__ __forceinline__ unsigned xb_xcc_id() { return (unsigned)__builtin_amdgcn_s_getreg((3 << 11) | 20) & 0xFu; }
#define XB_SPIN(cond, bar) do { unsigned _sp = 0; while (cond) { __builtin_amdgcn_s_sleep(1); \
    if ((++_sp & 255u) == 0u) { if (xb_ld(&(bar)[XB_TMO])) break; if (_sp > XB_SPIN_CAP) { atomicAdd(&(bar)[XB_TMO], 1u); break; } } } } while (0)

struct XcdBarrier { unsigned* bar; unsigned x; volatile LAS unsigned* st; int wave; };

__device__ __forceinline__ XcdBarrier xcd_barrier_post(unsigned* bar, volatile LAS unsigned* st, int wave_id) {
    XcdBarrier b; b.bar = bar; b.x = xb_xcc_id(); b.st = st; b.wave = wave_id;
    if (wave_id == 0 && __builtin_amdgcn_mbcnt_hi(~0u, __builtin_amdgcn_mbcnt_lo(~0u, 0u)) == 0u) (void)xb_add(&bar[XB_XCNT(b.x)], 1u);
    return b;
}
__device__ __forceinline__ void xcd_barrier_complete(unsigned* bar, unsigned x, unsigned& nloc, unsigned& nx) {
    const unsigned G = gridDim.x * gridDim.y * gridDim.z;
    unsigned sum, cnt, mine, sp = 0u;
    for (;;) {
        sum = 0u; cnt = 0u; mine = 0u;
#pragma unroll
        for (unsigned j = 0; j < 16; ++j) { const unsigned c = xb_ld(&bar[XB_XCNT(j)]); sum += c; cnt += (c > 0u) ? 1u : 0u; mine = (j == x) ? c : mine; }
        if (sum == G) break;
        __builtin_amdgcn_s_sleep(1);
        if ((++sp & 255u) == 0u) { if (xb_ld(&bar[XB_TMO])) break; if (sp > XB_SPIN_CAP) { atomicAdd(&bar[XB_TMO], 1u); break; } }
    }
    nloc = mine > 0u ? mine : 1u; nx = cnt > 0u ? cnt : 1u;
}
__device__ __forceinline__ void xcd_barrier_core(const XcdBarrier& b) {
    if (b.wave == 0 && __builtin_amdgcn_mbcnt_hi(~0u, __builtin_amdgcn_mbcnt_lo(~0u, 0u)) == 0u) {
        unsigned* bar = b.bar;
        __builtin_amdgcn_s_waitcnt(0);
        unsigned nloc = b.st[0], nx = b.st[1];
        if (nloc == 0u) { xcd_barrier_complete(bar, b.x, nloc, nx); b.st[0] = nloc; b.st[1] = nx; }
        const unsigned old = xb_add(&bar[XB_XSUB(b.x)], 1u);
        const unsigned gen = old / nloc;
        if (old + 1u == (gen + 1u) * nloc) {
            __builtin_amdgcn_fence(__ATOMIC_RELEASE, "agent");
            asm volatile("s_waitcnt vmcnt(0)" ::: "memory");
            const unsigned og = xb_add(&bar[XB_TOP], 1u);
            const unsigned tg = og / nx;
            if (og + 1u == (tg + 1u) * nx) xb_add(&bar[XB_TOPGEN], 1u);
            else XB_SPIN(xb_ld(&bar[XB_TOPGEN]) == tg, bar);
            __builtin_amdgcn_fence(__ATOMIC_ACQUIRE, "agent");
            xb_add(&bar[XB_XGEN(b.x)], 1u);
            asm volatile("s_waitcnt vmcnt(0)" ::: "memory");
        } else {
            XB_SPIN(xb_ld(&bar[XB_XGEN(b.x)]) == gen, bar);
            __builtin_amdgcn_fence(__ATOMIC_ACQUIRE, "agent");
            asm volatile("s_waitcnt vmcnt(0)" ::: "memory");
        }
    }
}
__device__ __forceinline__ void xcd_barrier(const XcdBarrier& b) {
    asm volatile("s_waitcnt vmcnt(0)" ::: "memory");
    __syncthreads();
    xcd_barrier_core(b);
    __syncthreads();
}

constexpr int BM = 256, BK = 64, HALF = 128, HTB = HALF * BK * 2, STAGE_BYTES = 8 * HTB, NXCD = 8, WGM = 8;

__device__ __forceinline__ int lds_byte(int r, int c) { const int st = (r >> 4) * 2 + (c >> 5), rr = r & 15, cc = c & 31, ob = rr * 64 + cc * 2; return st * 1024 + (ob ^ (((ob >> 9) & 1) << 5)); }
__device__ __forceinline__ void stage_rc(int b, int& R, int& C) { const int st = b / 1024, sb = b % 1024, swz = sb ^ (((sb >> 9) & 1) << 5); R = (st >> 1) * 16 + swz / 64; C = (st & 1) * 32 + (swz % 64) / 2; }
__device__ __forceinline__ int perm32(int rho) { const int n = rho >> 4, i = rho & 15; return 8 * (i >> 2) + 4 * n + (i & 3); }

struct GemmD { const bf16_t* A; const bf16_t* B; int lda, ldb; unsigned kstepA, kstepB; int K; };
struct Unit { int pm, pn, b; unsigned offA, offB; };

struct SchedB {
    static constexpr bool GATHER = false;
    int nM, nN, nB, G, c, bdiv; unsigned bsA_hi, bsA_lo, bsB_hi, bsB_lo, tsA, tsB;
    __device__ __forceinline__ bool next(int i, Unit& u) const {
        const int nMt = nB * nM, nwg = nMt * nN;
        const long L = (unsigned)i * G + c; if (L >= nwg) return false;
        int wgid = (int)L; { const int q = nwg / NXCD, r = nwg % NXCD, xcd = wgid % NXCD, off = wgid / NXCD; wgid = (xcd < r ? xcd * (q + 1) : r * (q + 1) + (xcd - r) * q) + off; }
        const int nig = WGM * nN, gid = wgid / nig, fm = gid * WGM, gsz = (nMt - fm) < WGM ? (nMt - fm) : WGM;
        const int pmt = fm + ((wgid % nig) % gsz); u.pn = (wgid % nig) / gsz;
        u.b = pmt / nM; u.pm = pmt - u.b * nM;
        const int hi = u.b / bdiv, lo = u.b - hi * bdiv;
        u.offA = (unsigned)hi * bsA_hi + (unsigned)lo * bsA_lo + (unsigned)u.pm * tsA; u.offB = (unsigned)hi * bsB_hi + (unsigned)lo * bsB_lo + (unsigned)u.pn * tsB;
        return true;
    }
};
template <bool GATHER_>
struct SchedMoe {
    static constexpr bool GATHER = GATHER_;
    int nM, nN, G, c; const int* tile_exp; unsigned tsA, tsB, esB; const int* rowtok;
    __device__ __forceinline__ bool next(int i, Unit& u) const {
        const int nwg = nM * nN;
        const long L = (unsigned)i * G + c; if (L >= nwg) return false;
        int wgid = (int)L; { const int q = nwg / NXCD, r = nwg % NXCD, xcd = wgid % NXCD, off = wgid / NXCD; wgid = (xcd < r ? xcd * (q + 1) : r * (q + 1) + (xcd - r) * q) + off; }
        const int nig = WGM * nN, gid = wgid / nig, fm = gid * WGM, gsz = (nM - fm) < WGM ? (nM - fm) : WGM;
        u.pm = fm + ((wgid % nig) % gsz); u.pn = (wgid % nig) / gsz;
        u.b = __builtin_amdgcn_readfirstlane(tile_exp[u.pm]);
        u.offA = (unsigned)u.pm * tsA; u.offB = (unsigned)u.b * esB + (unsigned)u.pn * tsB;
        return true;
    }
};

struct EpiBf16 {
    static constexpr bool PERM = true;
    bf16_t* O; int ldc; int bdiv; unsigned bs_hi, bs_lo;
    __device__ __forceinline__ void operator()(f32x4 (&acc)[2][2][4][2], const Unit& u, int wr, int wc, int fr_, int fq_) const {
        int fr = fr_, fq = fq_; asm volatile("" : "+v"(fr), "+v"(fq));
        const int hi = u.b / bdiv, lo = u.b - hi * bdiv;
        bf16_t* base = O + (size_t)((unsigned)hi * bs_hi + (unsigned)lo * bs_lo);
        const int row0 = u.pm * BM + wr * 64 + fr, col0 = u.pn * BM + wc * 32 + 8 * fq;
#pragma unroll
        for (int ai = 0; ai < 2; ++ai)
#pragma unroll
            for (int m = 0; m < 4; ++m) { bf16_t* rowp = base + (size_t)(row0 + ai * HALF + m * 16) * ldc + col0;
#pragma unroll
                for (int bj = 0; bj < 2; ++bj) { const f32x4 v0 = acc[ai][bj][m][0], v1 = acc[ai][bj][m][1];
                    u32x4 w; w.x = cvt_pk_bf16(v0[0], v0[1]); w.y = cvt_pk_bf16(v0[2], v0[3]); w.z = cvt_pk_bf16(v1[0], v1[1]); w.w = cvt_pk_bf16(v1[2], v1[3]);
                    gstore<u32x4>(rowp + bj * HALF, w); } }
    }
};
struct EpiSoftmax {
    static constexpr bool PERM = true;
    bf16_t* P; float scale; LAS float* ex;
    __device__ __forceinline__ void operator()(f32x4 (&acc)[2][2][4][2], const Unit& u, int wr, int wc, int fr_, int fq_) const {
        int fr = fr_, fq = fq_; asm volatile("" : "+v"(fr), "+v"(fq));
#pragma unroll
        for (int ai = 0; ai < 2; ++ai)
#pragma unroll
            for (int m = 0; m < 4; ++m) {
                float mx = -3.0e38f;
#pragma unroll
                for (int bj = 0; bj < 2; ++bj)
#pragma unroll
                    for (int n = 0; n < 2; ++n) { acc[ai][bj][m][n] = acc[ai][bj][m][n] * scale; const f32x4 x = acc[ai][bj][m][n]; mx = fmaxf(mx, fmaxf(fmaxf(x[0], x[1]), fmaxf(x[2], x[3]))); }
                mx = fmaxf(mx, __shfl_xor(mx, 16)); mx = fmaxf(mx, __shfl_xor(mx, 32));
                float sm = 0.f;
#pragma unroll
                for (int bj = 0; bj < 2; ++bj)
#pragma unroll
                    for (int n = 0; n < 2; ++n) { f32x4 x = acc[ai][bj][m][n]; x[0] = __expf(x[0] - mx); x[1] = __expf(x[1] - mx); x[2] = __expf(x[2] - mx); x[3] = __expf(x[3] - mx); acc[ai][bj][m][n] = x; sm += (x[0] + x[1]) + (x[2] + x[3]); }
                sm += __shfl_xor(sm, 16); sm += __shfl_xor(sm, 32);
                if (fq == 0) *(LAS f32x2*)(ex + ((ai * HALF + wr * 64 + m * 16 + fr) * 4 + wc) * 2) = (f32x2){mx, sm};
            }
        asm volatile("s_waitcnt lgkmcnt(0)" ::: "memory"); __builtin_amdgcn_s_barrier(); asm volatile("" ::: "memory");
        bf16_t* base = P + ((size_t)(u.b >> 2) * SEQ + (size_t)(u.pm * BM + wr * 64 + fr)) * 1024 + (u.b & 3) * 256 + wc * 32 + 8 * fq;
#pragma unroll
        for (int ai = 0; ai < 2; ++ai)
#pragma unroll
            for (int m = 0; m < 4; ++m) {
                const LAS float* ep = ex + (ai * HALF + wr * 64 + m * 16 + fr) * 8;
                const f32x4 a = *(const LAS f32x4*)ep, b = *(const LAS f32x4*)(ep + 4);
                const float M = fmaxf(fmaxf(a[0], a[2]), fmaxf(b[0], b[2]));
                const float tot = a[1] * __expf(a[0] - M) + a[3] * __expf(a[2] - M) + b[1] * __expf(b[0] - M) + b[3] * __expf(b[2] - M);
                const float f = __expf(ep[2 * wc] - M) / tot;
                bf16_t* rowp = base + (size_t)(ai * HALF + m * 16) * 1024;
#pragma unroll
                for (int bj = 0; bj < 2; ++bj) { const f32x4 v0 = acc[ai][bj][m][0] * f, v1 = acc[ai][bj][m][1] * f;
                    u32x4 w; w.x = cvt_pk_bf16(v0[0], v0[1]); w.y = cvt_pk_bf16(v0[2], v0[3]); w.z = cvt_pk_bf16(v1[0], v1[1]); w.w = cvt_pk_bf16(v1[2], v1[3]);
                    gstore<u32x4>(rowp + bj * HALF, w); }
            }
    }
};
struct EpiFft1 {
    static constexpr bool PERM = true;
    bf16_t* Y; const float* tw;
    __device__ __forceinline__ void operator()(f32x4 (&acc)[2][2][4][2], const Unit& u, int wr, int wc, int fr_, int fq_) const {
        int fr = fr_, fq = fq_; asm volatile("" : "+v"(fr), "+v"(fq));
        bf16_t* base = Y + (size_t)u.b * (64 * 128 * 2 * 64);
#pragma unroll
        for (int bj = 0; bj < 2; ++bj) {
            const int c0 = u.pn * BM + bj * HALF + wc * 32 + 8 * fq, d = c0 >> 6, a0 = c0 & 63;
#pragma unroll
            for (int hf = 0; hf < 2; ++hf) {
                const int e = 32 * wr + 16 * hf + fr;
                const float* twp = tw + ((size_t)e * 64 + a0) * 2;
                const f32x4 t0 = gload<f32x4>(twp), t1 = gload<f32x4>(twp + 4), t2 = gload<f32x4>(twp + 8), t3 = gload<f32x4>(twp + 12);
                const f32x4 re0 = acc[0][bj][hf][0], re1 = acc[0][bj][hf][1], im0 = acc[0][bj][hf + 2][0], im1 = acc[0][bj][hf + 2][1];
                float yr[8], yi[8];
                yr[0] = re0[0] * t0[0] - im0[0] * t0[1]; yi[0] = re0[0] * t0[1] + im0[0] * t0[0];
                yr[1] = re0[1] * t0[2] - im0[1] * t0[3]; yi[1] = re0[1] * t0[3] + im0[1] * t0[2];
                yr[2] = re0[2] * t1[0] - im0[2] * t1[1]; yi[2] = re0[2] * t1[1] + im0[2] * t1[0];
                yr[3] = re0[3] * t1[2] - im0[3] * t1[3]; yi[3] = re0[3] * t1[3] + im0[3] * t1[2];
                yr[4] = re1[0] * t2[0] - im1[0] * t2[1]; yi[4] = re1[0] * t2[1] + im1[0] * t2[0];
                yr[5] = re1[1] * t2[2] - im1[1] * t2[3]; yi[5] = re1[1] * t2[3] + im1[1] * t2[2];
                yr[6] = re1[2] * t3[0] - im1[2] * t3[1]; yi[6] = re1[2] * t3[1] + im1[2] * t3[0];
                yr[7] = re1[3] * t3[2] - im1[3] * t3[3]; yi[7] = re1[3] * t3[3] + im1[3] * t3[2];
                bf16_t* p = base + (((size_t)e * 128 + d) * 2) * 64 + a0;
                u32x4 wr4, wi4;
                wr4.x = cvt_pk_bf16(yr[0], yr[1]); wr4.y = cvt_pk_bf16(yr[2], yr[3]); wr4.z = cvt_pk_bf16(yr[4], yr[5]); wr4.w = cvt_pk_bf16(yr[6], yr[7]);
                wi4.x = cvt_pk_bf16(yi[0], yi[1]); wi4.y = cvt_pk_bf16(yi[2], yi[3]); wi4.z = cvt_pk_bf16(yi[4], yi[5]); wi4.w = cvt_pk_bf16(yi[6], yi[7]);
                gstore<u32x4>(p, wr4); gstore<u32x4>(p + 64, wi4);
            }
        }
    }
};
struct EpiFft2 {
    static constexpr bool PERM = true;
    bf16_t* Yc;
    __device__ __forceinline__ void operator()(f32x4 (&acc)[2][2][4][2], const Unit& u, int wr, int wc, int fr_, int fq_) const {
        int fr = fr_, fq = fq_; asm volatile("" : "+v"(fr), "+v"(fq));
        if (wr != 0) return;
        const int b = u.b >> 2, h = u.b & 3;
#pragma unroll
        for (int bj = 0; bj < 2; ++bj) {
            const int n0 = u.pn * BM + bj * HALF + wc * 32 + 8 * fq, e = n0 >> 7, d0 = n0 & 127;
#pragma unroll
            for (int m = 0; m < 4; ++m) {
                const int c = 16 * m + fr, sp = 64 * c + e;
                bf16_t* p = Yc + ((size_t)(b * SEQ + sp)) * DM + 512 + h * 128 + d0;
                const f32x4 v0 = acc[0][bj][m][0], v1 = acc[0][bj][m][1];
                u32x4 w; w.x = cvt_pk_bf16(v0[0], v0[1]); w.y = cvt_pk_bf16(v0[2], v0[3]); w.z = cvt_pk_bf16(v1[0], v1[1]); w.w = cvt_pk_bf16(v1[2], v1[3]);
                *(u32x4*)p = w;
            }
        }
    }
};
struct EpiGU {
    static constexpr bool PERM = true;
    bf16_t* Hd;
    __device__ __forceinline__ void operator()(f32x4 (&acc)[2][2][4][2], const Unit& u, int wr, int wc, int fr_, int fq_) const {
        int fr = fr_, fq = fq_; asm volatile("" : "+v"(fr), "+v"(fq));
        const int row0 = u.pm * BM + wr * 64 + fr, col0 = u.pn * 128 + wc * 32 + 8 * fq;
#pragma unroll
        for (int ai = 0; ai < 2; ++ai)
#pragma unroll
            for (int m = 0; m < 4; ++m) {
                float o[8];
#pragma unroll
                for (int n = 0; n < 2; ++n)
#pragma unroll
                    for (int j = 0; j < 4; ++j) { const float g = acc[ai][0][m][n][j], up = acc[ai][1][m][n][j]; o[n * 4 + j] = g * fast_sigmoid(g) * up; }
                u32x4 w; w.x = cvt_pk_bf16(o[0], o[1]); w.y = cvt_pk_bf16(o[2], o[3]); w.z = cvt_pk_bf16(o[4], o[5]); w.w = cvt_pk_bf16(o[6], o[7]);
                gstore<u32x4>(Hd + (size_t)(row0 + ai * HALF + m * 16) * 512 + col0, w);
            }
    }
};
struct EpiDown {
    static constexpr bool PERM = true;
    bf16_t* Y; const float* gpos;
    __device__ __forceinline__ void operator()(f32x4 (&acc)[2][2][4][2], const Unit& u, int wr, int wc, int fr_, int fq_) const {
        int fr = fr_, fq = fq_; asm volatile("" : "+v"(fr), "+v"(fq));
        const int row0 = u.pm * BM + wr * 64 + fr, col0 = u.pn * BM + wc * 32 + 8 * fq;
#pragma unroll
        for (int ai = 0; ai < 2; ++ai)
#pragma unroll
            for (int m = 0; m < 4; ++m) { const int row = row0 + ai * HALF + m * 16; const float gt = gpos[row]; bf16_t* rowp = Y + (size_t)row * DM + col0;
#pragma unroll
                for (int bj = 0; bj < 2; ++bj) { const f32x4 v0 = acc[ai][bj][m][0] * gt, v1 = acc[ai][bj][m][1] * gt;
                    u32x4 w; w.x = cvt_pk_bf16(v0[0], v0[1]); w.y = cvt_pk_bf16(v0[2], v0[3]); w.z = cvt_pk_bf16(v1[0], v1[1]); w.w = cvt_pk_bf16(v1[2], v1[3]);
                    gstore<u32x4>(rowp + bj * HALF, w); } }
    }
};
struct EpiProjA {
    static constexpr bool PERM = true;
    bf16_t* P;
    __device__ __forceinline__ void operator()(f32x4 (&acc)[2][2][4][2], const Unit& u, int wr, int wc, int fr_, int fq_) const {
        int fr = fr_, fq = fq_; asm volatile("" : "+v"(fr), "+v"(fq));
        const int sec = u.pn >> 2;
        const int row0 = u.pm * BM + wr * 64 + fr, col0 = (sec == 2 ? 4096 : sec * 1024) + (u.pn & 3) * BM + wc * 32 + 8 * fq;
        if (sec == 1) {
#pragma unroll
            for (int ai = 0; ai < 2; ++ai)
#pragma unroll
                for (int m = 0; m < 4; ++m) { bf16_t* rowp = P + (size_t)(row0 + ai * HALF + m * 16) * 5120 + col0;
#pragma unroll
                    for (int bj = 0; bj < 2; ++bj) { const f32x4 v0 = acc[ai][bj][m][0], v1 = acc[ai][bj][m][1];
                        u32x4 w; w.x = cvt_pk_bf16(v0[0], v0[1]); w.y = cvt_pk_bf16(v0[2], v0[3]); w.z = cvt_pk_bf16(v1[0], v1[1]); w.w = cvt_pk_bf16(v1[2], v1[3]);
                        gstore<u32x4>(rowp + bj * HALF, w); } }
        } else {
#pragma unroll
            for (int ai = 0; ai < 2; ++ai)
#pragma unroll
                for (int m = 0; m < 4; ++m) { bf16_t* rowp = P + (size_t)(row0 + ai * HALF + m * 16) * 5120 + col0;
#pragma unroll
                    for (int bj = 0; bj < 2; ++bj) {
                        float o[8];
#pragma unroll
                        for (int n = 0; n < 2; ++n)
#pragma unroll
                            for (int j = 0; j < 4; ++j) { const float p = acc[ai][bj][m][n][j]; o[n * 4 + j] = p * fast_sigmoid(p); }
                        u32x4 w; w.x = cvt_pk_bf16(o[0], o[1]); w.y = cvt_pk_bf16(o[2], o[3]); w.z = cvt_pk_bf16(o[4], o[5]); w.w = cvt_pk_bf16(o[6], o[7]);
                        gstore<u32x4>(rowp + bj * HALF, w); } }
        }
    }
};
struct EpiProjB {
    static constexpr bool PERM = true;
    bf16_t* P; const float* lb;
    __device__ __forceinline__ void operator()(f32x4 (&acc)[2][2][4][2], const Unit& u, int wr, int wc, int fr_, int fq_) const {
        int fr = fr_, fq = fq_; asm volatile("" : "+v"(fr), "+v"(fq));
        const int row0 = u.pm * BM + wr * 64 + fr, col0 = u.pn * BM + wc * 32 + 8 * fq;
        float lbv[2][8];
#pragma unroll
        for (int bj = 0; bj < 2; ++bj) { const float* lp = lb + col0 + bj * HALF; const f32x4 l0 = *(const f32x4*)lp, l1 = gload<f32x4>(lp + 4);
#pragma unroll
            for (int j = 0; j < 4; ++j) { lbv[bj][j] = l0[j]; lbv[bj][4 + j] = l1[j]; } }
#pragma unroll
        for (int ai = 0; ai < 2; ++ai)
#pragma unroll
            for (int m = 0; m < 4; ++m) { bf16_t* rowp = P + (size_t)(row0 + ai * HALF + m * 16) * 5120 + 2048 + col0;
#pragma unroll
                for (int bj = 0; bj < 2; ++bj) {
                    float o[8];
#pragma unroll
                    for (int n = 0; n < 2; ++n)
#pragma unroll
                        for (int j = 0; j < 4; ++j) { const float sg = fast_sigmoid(acc[ai][bj][m][n][j]); o[n * 4 + j] = __builtin_amdgcn_logf(sg + lbv[bj][n * 4 + j] * (1.0f - sg)); }
                    u32x4 w; w.x = cvt_pk_bf16(o[0], o[1]); w.y = cvt_pk_bf16(o[2], o[3]); w.z = cvt_pk_bf16(o[4], o[5]); w.w = cvt_pk_bf16(o[6], o[7]);
                    gstore<u32x4>(rowp + bj * HALF, w); } }
    }
};

template <class Epi, class Sched>
__device__ __forceinline__ void gemm_phase(LAS unsigned char* lds, const GemmD g, const Sched& S, const Epi& E, const int wave_id) {
    int lane_ = (int)__builtin_amdgcn_mbcnt_hi(~0u, __builtin_amdgcn_mbcnt_lo(~0u, 0u)); asm volatile("" : "+v"(lane_));
    const int lane = lane_, wid = wave_id, tid = wid * 64 + lane, wr = wid >> 2, wc = wid & 3, fr = lane & 15, fq = lane >> 4;
    const int nt = g.K / BK;
    unsigned voffA[2], voffB[2];
#pragma unroll
    for (int i = 0; i < 2; ++i) { int R, C; stage_rc(tid * 16 + i * 8192, R, C); const int Rb = Epi::PERM ? ((R & ~31) + perm32(R & 31)) : R;
        voffA[i] = (unsigned)(R * g.lda + C) * 2u; voffB[i] = (unsigned)(Rb * g.ldb + C) * 2u; }
    const unsigned kstepA = g.kstepA, kstepB = g.kstepB;
    const unsigned hstepA = (unsigned)HALF * g.lda * 2, hstepB = (unsigned)HALF * g.ldb * 2;
    unsigned gcur[2][2], gnxt[2][2]; int gR[2], gC[2];
#pragma unroll
    for (int i = 0; i < 2; ++i) { stage_rc(tid * 16 + i * 8192, gR[i], gC[i]); }
#define PG8_GLOAD(dst, pm_) do { if constexpr (Sched::GATHER) { _Pragma("unroll") for (int h_ = 0; h_ < 2; ++h_) _Pragma("unroll") for (int i_ = 0; i_ < 2; ++i_) \
        dst[h_][i_] = (unsigned)S.rowtok[(pm_) * BM + h_ * HALF + gR[i_]] * (unsigned)(g.lda * 2) + (unsigned)gC[i_] * 2u; } } while (0)
#define PG8_STAGE_A(b, h, pn_, pg_, gv_) do { if constexpr (Sched::GATHER) PG8_STAGE(PG8_SA(b, h), pg_, gv_); else PG8_STAGE(PG8_SA(b, h), pn_, voffA); } while (0)
    const unsigned ldsw = (unsigned)wid * 1024u;
    const int aoff = lds_byte(wr * 64 + fr, fq * 8), boff = lds_byte(wc * 32 + fr, fq * 8);
#define PG8_SA(b, h) (((b) * 2 + (h)) * HTB)
#define PG8_SB(b, h) ((4 + (b) * 2 + (h)) * HTB)
#define PG8_STAGE(bufoff, gbase, voff) do { _Pragma("unroll") for (int _i = 0; _i < 2; ++_i) \
        __builtin_amdgcn_global_load_lds((const unsigned*)((const char*)(gbase) + (voff)[_i]), (LAS unsigned*)(lds + (bufoff) + ldsw + _i * 8192), 16, 0, 0); } while (0)
#define PG8_LDA(dst, b, h) do { _Pragma("unroll") for (int m = 0; m < 4; ++m) _Pragma("unroll") for (int k = 0; k < 2; ++k) dst[m][k] = *(const LAS bf16x8*)(lds + PG8_SA(b, h) + aoff + m * 2048 + k * 1024); } while (0)
#define PG8_LDB(dst, b, h) do { _Pragma("unroll") for (int n = 0; n < 2; ++n) _Pragma("unroll") for (int k = 0; k < 2; ++k) dst[n][k] = *(const LAS bf16x8*)(lds + PG8_SB(b, h) + boff + n * 2048 + k * 1024); } while (0)
#define PG8_MMA(ai, bj, At, Bt) do { __builtin_amdgcn_s_setprio(1); _Pragma("unroll") for (int m = 0; m < 4; ++m) _Pragma("unroll") for (int n = 0; n < 2; ++n) _Pragma("unroll") for (int k = 0; k < 2; ++k) \
        acc[ai][bj][m][n] = __builtin_amdgcn_mfma_f32_16x16x32_bf16(Bt[n][k], At[m][k], acc[ai][bj][m][n], 0, 0, 0); __builtin_amdgcn_s_setprio(0); } while (0)
#define PG8_WAIT_V(n) asm volatile("s_waitcnt vmcnt(" #n ")" ::: "memory")
#define PG8_WAIT_L(n) asm volatile("s_waitcnt lgkmcnt(" #n ")" ::: "memory")
#define PG8_BAR __builtin_amdgcn_s_barrier()
#define PG8_SCHED __builtin_amdgcn_sched_barrier(0)
    Unit cur, nxt; int ui = 0;
    if (!S.next(0, cur)) return;
    f32x4 acc[2][2][4][2];
#pragma unroll
    for (int a = 0; a < 2; ++a)
#pragma unroll
        for (int b = 0; b < 2; ++b)
#pragma unroll
            for (int m = 0; m < 4; ++m)
#pragma unroll
                for (int n = 0; n < 2; ++n) acc[a][b][m][n] = (f32x4){0.f, 0.f, 0.f, 0.f};
    bf16x8 At[4][2], B0[2][2], B1[2][2];
    const char* cA = (const char*)g.A + (Sched::GATHER ? 0u : cur.offA); const char* cB = (const char*)g.B + cur.offB;
    PG8_GLOAD(gcur, cur.pm);
    PG8_STAGE(PG8_SB(0, 0), cB, voffB); PG8_STAGE_A(0, 0, cA, cA, gcur[0]); PG8_STAGE(PG8_SB(0, 1), cB + hstepB, voffB); PG8_STAGE_A(0, 1, cA + hstepA, cA, gcur[1]);
    if (wr == 1) PG8_BAR;
    PG8_WAIT_V(4); PG8_BAR;
    PG8_STAGE(PG8_SB(1, 0), cB + kstepB, voffB); PG8_STAGE_A(1, 0, cA + kstepA, cA + kstepA, gcur[0]); PG8_STAGE(PG8_SB(1, 1), cB + hstepB + kstepB, voffB);
    PG8_WAIT_V(6); PG8_BAR;
    for (;;) {
        const bool has_next = S.next(ui + 1, nxt);
        const char* nA = has_next ? (const char*)g.A + (Sched::GATHER ? 0u : nxt.offA) : cA; const char* nB = has_next ? (const char*)g.B + nxt.offB : cB;
        if constexpr (Sched::GATHER) { if (has_next) PG8_GLOAD(gnxt, nxt.pm); else {
#pragma unroll
            for (int h_ = 0; h_ < 2; ++h_) { gnxt[h_][0] = gcur[h_][0]; gnxt[h_][1] = gcur[h_][1]; } } }
        for (int t = 0; t < nt; t += 2) {
            const bool last = (t == nt - 2);
            const char* a1 = cA + (size_t)(t + 1) * kstepA;
            const char* a2 = last ? nA : cA + (size_t)(t + 2) * kstepA; const char* b2 = last ? nB : cB + (size_t)(t + 2) * kstepB;
            const char* a3 = a2 + kstepA; const char* b3 = b2 + kstepB;
            unsigned gs0[2], gs1[2];
            if constexpr (Sched::GATHER) { gs0[0] = last ? gnxt[0][0] : gcur[0][0]; gs0[1] = last ? gnxt[0][1] : gcur[0][1]; gs1[0] = last ? gnxt[1][0] : gcur[1][0]; gs1[1] = last ? gnxt[1][1] : gcur[1][1]; }
            PG8_LDB(B0, 0, 0); PG8_SCHED; PG8_LDA(At, 0, 0); PG8_STAGE_A(1, 1, a1 + hstepA, a1, gcur[1]);
            PG8_WAIT_L(8); PG8_BAR; PG8_WAIT_L(0); PG8_MMA(0, 0, At, B0); PG8_BAR; PG8_SCHED;
            PG8_LDB(B1, 0, 1); PG8_STAGE(PG8_SB(0, 0), b2, voffB);
            PG8_BAR; PG8_WAIT_L(0); PG8_MMA(0, 1, At, B1); PG8_BAR;
            PG8_LDA(At, 0, 1); PG8_STAGE_A(0, 0, a2, a2, gs0);
            PG8_BAR; PG8_WAIT_L(0); PG8_MMA(1, 0, At, B0); PG8_BAR; PG8_SCHED;
            PG8_STAGE(PG8_SB(0, 1), b2 + hstepB, voffB);
            PG8_WAIT_V(6); PG8_BAR; PG8_MMA(1, 1, At, B1); PG8_BAR;
            PG8_LDB(B0, 1, 0); PG8_SCHED; PG8_LDA(At, 1, 0); PG8_STAGE_A(0, 1, a2 + hstepA, a2, gs1);
            PG8_WAIT_L(8); PG8_BAR; PG8_WAIT_L(0); PG8_MMA(0, 0, At, B0); PG8_BAR; PG8_SCHED;
            PG8_LDB(B1, 1, 1); PG8_STAGE(PG8_SB(1, 0), b3, voffB);
            PG8_BAR; PG8_WAIT_L(0); PG8_MMA(0, 1, At, B1); PG8_BAR;
            PG8_LDA(At, 1, 1); PG8_STAGE_A(1, 0, a3, a3, gs0);
            PG8_BAR; PG8_WAIT_L(0); PG8_MMA(1, 0, At, B0); PG8_BAR; PG8_SCHED;
            PG8_STAGE(PG8_SB(1, 1), b3 + hstepB, voffB);
            PG8_WAIT_V(6); PG8_BAR; PG8_MMA(1, 1, At, B1); PG8_BAR;
        }
        E(acc, cur, wr, wc, fr, fq);
        if (!has_next) break;
#pragma unroll
        for (int a = 0; a < 2; ++a)
#pragma unroll
            for (int b = 0; b < 2; ++b)
#pragma unroll
                for (int m = 0; m < 4; ++m)
#pragma unroll
                    for (int n = 0; n < 2; ++n) acc[a][b][m][n] = (f32x4){0.f, 0.f, 0.f, 0.f};
        cur = nxt; cA = nA; cB = nB; ++ui;
        if constexpr (Sched::GATHER) {
#pragma unroll
            for (int h_ = 0; h_ < 2; ++h_) { gcur[h_][0] = gnxt[h_][0]; gcur[h_][1] = gnxt[h_][1]; } }
    }
    PG8_WAIT_V(0);
    if (wr == 0) PG8_BAR;
    PG8_BAR;
#undef PG8_SA
#undef PG8_SB
#undef PG8_STAGE
#undef PG8_STAGE_A
#undef PG8_GLOAD
#undef PG8_LDA
#undef PG8_LDB
#undef PG8_MMA
#undef PG8_WAIT_V
#undef PG8_WAIT_L
#undef PG8_BAR
#undef PG8_SCHED
}

struct Args { const float* in[24]; float* out; unsigned char* ws; int ph_lo, ph_hi; };
typedef const float* cfp_t;
typedef const __attribute__((address_space(4))) cfp_t* InPtr;
struct Frame {
    InPtr in; float* out; unsigned char* ws; LAS unsigned char* lds; int tid, lane, wave, G, vb;
};
#define WSP(T, off) ((T*)(F.ws + (off)))
template <class T> __device__ __forceinline__ T* launder_ptr(T* p) {
    int z = 0; asm volatile("" : "+s"(z)); return (T*)((char*)p + z);
}
__device__ __forceinline__ Frame relaunder(const Frame& F0) {
    Frame F = F0; int ln = (int)__builtin_amdgcn_mbcnt_hi(~0u, __builtin_amdgcn_mbcnt_lo(~0u, 0u)); asm volatile("" : "+v"(ln));
    F.lane = ln; F.wave = F0.wave; F.tid = F0.wave * 64 + ln;
    F.ws = launder_ptr(F0.ws); F.out = launder_ptr(F0.out);
    { int g = F0.G, v = F0.vb; asm volatile("" : "+v"(g), "+v"(v)); F.G = __builtin_amdgcn_readfirstlane(g); F.vb = __builtin_amdgcn_readfirstlane(v); }
    return F;
}

__device__ __forceinline__ SchedB mk_sched(const Frame& F, int nB, int nM, int nN, int bdiv, unsigned bsA_hi, unsigned bsA_lo, unsigned bsB_hi, unsigned bsB_lo, unsigned tsA, unsigned tsB, int crot = 0) {
    SchedB S; S.nM = nM; S.nN = nN; S.nB = nB; S.G = F.G; S.c = (F.vb + crot) % F.G; S.bdiv = bdiv; S.bsA_hi = bsA_hi; S.bsA_lo = bsA_lo; S.bsB_hi = bsB_hi; S.bsB_lo = bsB_lo; S.tsA = tsA; S.tsB = tsB; return S;
}
__device__ __forceinline__ void gemm_plain(const Frame& F, const bf16_t* A, int lda, const bf16_t* Bw, int M, int N, int K, bf16_t* O, int ldc, int crot = 0) {
    GemmD g{A, Bw, lda, K, 128, 128, K};
    SchedB S = mk_sched(F, 1, M / 256, N / 256, 1, 0, 0, 0, 0, (unsigned)256 * lda * 2, (unsigned)256 * K * 2, crot);
    EpiBf16 E{O, ldc, 1, 0, 0};
    gemm_phase<EpiBf16, SchedB>(F.lds, g, S, E, F.wave);
}

struct TDesc { const float* src; int ldsrc; bf16_t* dst; int ldd; };
struct MatMap {
    const float* src; int ldsrc, nnt; bf16_t* dst; int ldd;
    __device__ __forceinline__ TDesc operator()(int tl) const { const int kt = tl / nnt, ntl = tl - kt * nnt; return TDesc{src + (size_t)kt * 64 * ldsrc + ntl * 64, ldsrc, dst + (size_t)ntl * 64 * ldd + kt * 64, ldd}; }
};
struct MoeMap {
    const float* wg; const float* wu; const float* wd; bf16_t* WGU; bf16_t* WDN;
    __device__ __forceinline__ TDesc operator()(int tl) const {
        const int e = tl / 384, r = tl - e * 384, which = r >> 7, q = r & 127;
        if (which < 2) { const int kt = q >> 3, ntl = q & 7, k0 = kt * 64, n0 = ntl * 64; const int row0 = (n0 >> 7) * 256 + which * 128 + (n0 & 127);
            return TDesc{(which ? wu : wg) + (size_t)e * 524288 + (size_t)k0 * 512 + n0, 512, WGU + (size_t)e * 1048576 + (size_t)row0 * 1024 + k0, 1024}; }
        const int kt = q >> 4, ntl = q & 15, k0 = kt * 64, n0 = ntl * 64;
        return TDesc{wd + (size_t)e * 524288 + (size_t)k0 * 1024 + n0, 1024, WDN + (size_t)e * 524288 + (size_t)n0 * 512 + k0, 512};
    }
};
template <class Map>
__device__ __forceinline__ void tconv_run_sub(const Frame& F, int ntiles, const Map& M, int wgi, int nwg) {
    LAS float* tile = (LAS float*)F.lds;
    const int t = F.tid, r = t >> 3, cg = t & 7;
    for (int base = wgi * 4; base < ntiles; base += nwg * 4) {
        f32x4 v[4][2]; TDesc d[4];
#pragma unroll
        for (int q = 0; q < 4; ++q) { d[q] = M(min(base + q, ntiles - 1));
            v[q][0] = gload<f32x4>(d[q].src + (size_t)r * d[q].ldsrc + cg * 8); v[q][1] = gload<f32x4>(d[q].src + (size_t)r * d[q].ldsrc + cg * 8 + 4); }
#pragma unroll
        for (int q = 0; q < 4; ++q)
#pragma unroll
            for (int j = 0; j < 4; ++j) { tile[q * 4160 + r * 65 + cg * 8 + j] = v[q][0][j]; tile[q * 4160 + r * 65 + cg * 8 + 4 + j] = v[q][1][j]; }
        __syncthreads();
#pragma unroll
        for (int q = 0; q < 4; ++q) {
            float o[8];
#pragma unroll
            for (int j = 0; j < 8; ++j) o[j] = tile[q * 4160 + (cg * 8 + j) * 65 + r];
            u32x4 w; w.x = cvt_pk_bf16(o[0], o[1]); w.y = cvt_pk_bf16(o[2], o[3]); w.z = cvt_pk_bf16(o[4], o[5]); w.w = cvt_pk_bf16(o[6], o[7]);
            if (base + q < ntiles) gstore<u32x4>(d[q].dst + (size_t)r * d[q].ldd + cg * 8, w);
        }
        __syncthreads();
    }
}
template <class Map>
__device__ __forceinline__ void tconv_run(const Frame& F, int ntiles, const Map& M, int rot) { tconv_run_sub(F, ntiles, M, (F.vb + rot) % F.G, F.G); }
__device__ __forceinline__ void tconv_matrix(const Frame& F, const float* src, int ldsrc, int Kd, int Nd, bf16_t* dst, int ldd, int rot) {
    MatMap M{src, ldsrc, Nd / 64, dst, ldd};
    tconv_run(F, (Kd / 64) * (Nd / 64), M, rot);
}
__device__ __forceinline__ void moe_convert(const Frame& F0, int l) {
    const Frame F = relaunder(F0);
    MoeMap M{F.in[19] + (size_t)l * 32 * 524288, F.in[20] + (size_t)l * 32 * 524288, F.in[21] + (size_t)l * 32 * 524288, l ? (bf16_t*)F.out : WSP(bf16_t, WS_WGU), l ? (bf16_t*)F.out + (size_t)33554432 : WSP(bf16_t, WS_WDN)};
    tconv_run(F, 32 * 384, M, 0);
}
constexpr size_t X_PRO_ELEMS = (size_t)NTOK * DM / 2;
__device__ __forceinline__ void conv_f32_bf16_sub(const Frame& F, const float* src, bf16_t* dst, size_t n, int wgi, int nwg) {
    for (size_t i = ((size_t)wgi * NTHR + F.tid) * 8; i < n; i += (size_t)nwg * NTHR * 8) {
        const f32x4 a = gload<f32x4>(src + i), b = gload<f32x4>(src + i + 4);
        u32x4 w; w.x = cvt_pk_bf16(a[0], a[1]); w.y = cvt_pk_bf16(a[2], a[3]); w.z = cvt_pk_bf16(b[0], b[1]); w.w = cvt_pk_bf16(b[2], b[3]);
        gstore<u32x4>(dst + i, w); }
}
__device__ __forceinline__ void conv_f32_bf16(const Frame& F, const float* src, bf16_t* dst, size_t n) {
    for (size_t i = ((size_t)F.vb * NTHR + F.tid) * 8; i < n; i += (size_t)F.G * NTHR * 8) {
        const f32x4 a = gload<f32x4>(src + i), b = gload<f32x4>(src + i + 4);
        u32x4 w; w.x = cvt_pk_bf16(a[0], a[1]); w.y = cvt_pk_bf16(a[2], a[3]); w.z = cvt_pk_bf16(b[0], b[1]); w.w = cvt_pk_bf16(b[2], b[3]);
        gstore<u32x4>(dst + i, w); }
}

__device__ __forceinline__ void p_prologue(const Frame& F0) {
    const Frame F = relaunder(F0);
    tconv_matrix(F, F.in[2] + 512, 1024, 1024, 512, WSP(bf16_t, WS_W1CAT) + (size_t)512 * 1024, 1024, 0);
    tconv_matrix(F, F.in[7], 1024, 1024, 1024, WSP(bf16_t, WS_PFWOUT), 1024, 32);
    { const int dsec[5] = {0, 1, 3, 4, 2};
#pragma unroll
      for (int sc = 0; sc < 5; ++sc) tconv_matrix(F, F.in[8] + sc * 1024, 5120, 1024, 1024, WSP(bf16_t, WS_HGWIN) + (size_t)dsec[sc] * 1048576, 1024, 96 + sc * 64); }
    tconv_matrix(F, F.in[11], 1024, 1024, 1024, WSP(bf16_t, WS_HGWOUT), 1024, 160);
    for (int l = 0; l < 2; ++l) {
        tconv_matrix(F, F.in[13] + (size_t)l * 2097152, 2048, 1024, 1024, WSP(bf16_t, WS_WK) + (size_t)l * 1048576, 1024, 32 + l * 256);
        tconv_matrix(F, F.in[13] + (size_t)l * 2097152 + 1024, 2048, 1024, 1024, WSP(bf16_t, WS_WV) + (size_t)l * 1048576, 1024, 96 + l * 256);
        tconv_matrix(F, F.in[14] + (size_t)l * 1048576, 1024, 1024, 1024, WSP(bf16_t, l ? WS_WOT1 : WS_WOT0), 1024, 160 + l * 256);
        conv_f32_bf16(F, F.in[12] + (size_t)l * 1048576, WSP(bf16_t, l ? WS_WQN1 : WS_WQN0), (size_t)1048576);
    }
    if (F.G != 256) moe_convert(F, 0);
    conv_f32_bf16(F, F.in[0], WSP(bf16_t, WS_XB), F.G == 256 ? X_PRO_ELEMS : (size_t)NTOK * DM);
    conv_f32_bf16(F, F.in[1], WSP(bf16_t, WS_MEMBF), (size_t)NB * MEML * DM);
    const int gt = F.vb * NTHR + F.tid, gn = F.G * NTHR;
    { const float* win = F.in[2]; const float* pw = F.in[3]; const float* ps = F.in[4]; bf16_t* W1 = WSP(bf16_t, WS_W1CAT);
      LAS float* wl = (LAS float*)F.lds;
      for (int kb = F.vb; kb < 256; kb += F.G) {
          __syncthreads();
#pragma unroll
          for (int j = 0; j < 4; ++j) wl[j * 512 + F.tid] = win[(size_t)(kb * 4 + j) * 1024 + F.tid];
          __syncthreads();
          const int gd = F.tid, g = gd >> 7, d = gd & 127; const float* pp = pw + (size_t)g * 16384 + d;
          float a0 = 0.f, a1 = 0.f, a2 = 0.f, a3 = 0.f;
#pragma unroll 8
          for (int c = 0; c < 128; ++c) { const float p = pp[c * 128]; a0 += wl[g * 128 + c] * p; a1 += wl[512 + g * 128 + c] * p; a2 += wl[1024 + g * 128 + c] * p; a3 += wl[1536 + g * 128 + c] * p; }
          const float sc = ps[gd];
          u32x2 w; w.x = cvt_pk_bf16(a0 * sc, a1 * sc); w.y = cvt_pk_bf16(a2 * sc, a3 * sc);
          gstore<u32x2>(W1 + (size_t)gd * 1024 + kb * 4, w); }
      __syncthreads(); }
    { const float* fw = F.in[6]; bf16_t* PQ = WSP(bf16_t, WS_PQT); const float norm = 0.0013810679320049757f;
      LAS float* tb = (LAS float*)F.lds;
      __syncthreads();
      if (F.tid < 128) { const float ang = (float)F.tid * (1.0f / 64.0f); tb[F.tid] = cospif(ang); tb[128 + F.tid] = sinpif(ang); }
      __syncthreads();
      for (int idx = gt; idx < 4 * 256 * 128; idx += gn) { const int h = idx >> 15, r = (idx >> 7) & 255, c = idx & 127, d = r & 127, isq = r >> 7; float a = 0.f;
          const float* fp = fw + (size_t)h * 16384 + d; const LAS float* tp = tb + isq * 128;
#pragma unroll 8
          for (int m = 0; m < 128; ++m) a += tp[(m * c) & 127] * fp[m * 128];
          PQ[idx] = f2bf(a * norm); }
      __syncthreads(); }
    { bf16_t* W1d = WSP(bf16_t, WS_W1DFT); bf16_t* W2d = WSP(bf16_t, WS_W2DFT); float* TW = WSP(float, WS_TW);
      for (int idx = gt; idx < 256 * 128; idx += gn) { const int r = idx >> 7, k = idx & 127, ri = k >> 6, bb = k & 63; float v1 = 0.f, v2 = 0.f;
          if (r < 128) { const int e = 32 * (r >> 6) + (r & 31), ro = (r >> 5) & 1; const float ang = (float)((e * bb) & 63) * (1.0f / 32.0f); const float cs = cospif(ang), sn = sinpif(ang);
              v1 = ro == 0 ? (ri == 0 ? cs : -sn) : (ri == 0 ? sn : cs); }
          if (r < 64) { const float ang = (float)((r * bb) & 63) * (1.0f / 32.0f); v2 = ri == 0 ? cospif(ang) : -sinpif(ang); }
          W1d[idx] = f2bf(v1); W2d[idx] = f2bf(v2); }
      for (int idx = gt; idx < 64 * 64; idx += gn) { const int e = idx >> 6, a = idx & 63; const float ang = (float)((e * a) & 4095) * (1.0f / 2048.0f); TW[idx * 2] = cospif(ang); TW[idx * 2 + 1] = sinpif(ang); } }
    { const float* lbin = F.in[9]; float* LB = WSP(float, WS_LB1);
      for (int idx = gt; idx < 2048; idx += gn) { const float v0 = lbin[idx], v1 = lbin[2048 + idx]; LB[idx] = 1.0f / (1.0f + expf(v0 - v1)); } }
}

__device__ __forceinline__ void p_kv_a(const Frame& F0) {
    const Frame F = relaunder(F0);
    gemm_plain(F, WSP(bf16_t, WS_MEMBF), 1024, WSP(bf16_t, WS_WK), 2048, 1024, 1024, WSP(bf16_t, WS_KB0), 1024, 0);
    gemm_plain(F, WSP(bf16_t, WS_MEMBF), 1024, WSP(bf16_t, WS_WV), 2048, 1024, 1024, WSP(bf16_t, WS_VB0), 1024, 32);
    gemm_plain(F, WSP(bf16_t, WS_MEMBF), 1024, WSP(bf16_t, WS_WK) + 1048576, 2048, 1024, 1024, WSP(bf16_t, WS_KB1), 1024, 64);
    gemm_plain(F, WSP(bf16_t, WS_MEMBF), 1024, WSP(bf16_t, WS_WV) + 1048576, 2048, 1024, 1024, WSP(bf16_t, WS_VB1), 1024, 96);
    if (F.G == 256 && F.vb >= 32 && F.vb < 160) conv_f32_bf16_sub(F, F.in[0] + X_PRO_ELEMS, WSP(bf16_t, WS_XB) + X_PRO_ELEMS, (size_t)NTOK * DM - X_PRO_ELEMS, F.vb - 32, 128);
}
__device__ __forceinline__ void p_kv_b(const Frame& F0, int l) {
    const Frame F = relaunder(F0);
    const bf16_t* KB = WSP(bf16_t, l ? WS_KB1 : WS_KB0); const bf16_t* VB = WSP(bf16_t, l ? WS_VB1 : WS_VB0);
    const bf16_t* WQN = WSP(bf16_t, l ? WS_WQN1 : WS_WQN0); const bf16_t* WOT = WSP(bf16_t, l ? WS_WOT1 : WS_WOT0);
    { GemmD g{KB, WQN, 1024, 1024, 128, 128, 256};
      SchedB S = mk_sched(F, 32, 1, 4, 4, (unsigned)256 * 1024 * 2, (unsigned)256 * 2, 0, (unsigned)256 * 2, 0, (unsigned)256 * 1024 * 2);
      EpiBf16 E{WSP(bf16_t, WS_KM), 1024, 1, (unsigned)256 * 1024, 0};
      gemm_phase<EpiBf16, SchedB>(F.lds, g, S, E, F.wave); }
    { GemmD g{WOT, VB, 1024, 1024, 128, 128, 256};
      SchedB S = mk_sched(F, 32, 4, 1, 4, 0, (unsigned)256 * 2, (unsigned)256 * 1024 * 2, (unsigned)256 * 2, (unsigned)256 * 1024 * 2, 0, 128);
      EpiBf16 E{WSP(bf16_t, WS_VW), 1024, 4, (unsigned)1024 * 1024, 256};
      gemm_phase<EpiBf16, SchedB>(F.lds, g, S, E, F.wave); }
}

__device__ __forceinline__ void p_pool_hln(const Frame& F0) {
    const Frame F = relaunder(F0);
    const bf16_t* U = WSP(bf16_t, WS_U); bf16_t* YC = WSP(bf16_t, WS_YCAT); bf16_t* UN = WSP(bf16_t, WS_UN); const float* lng = F.in[5];
    const int l = F.lane, g = l >> 4, w2 = 1 << g;
    float gam[8];
#pragma unroll
    for (int j = 0; j < 8; ++j) gam[j] = lng[8 * l + j];
#define POOL_LOAD(o_, u_, a_, d_, i_) do { const int s_ = s0 + (i_); o_ = gload<u32x4>(Ub + (size_t)s_ * DM); u_ = gload<u32x4>(Ub + (size_t)s_ * DM + 512); \
        a_ = gload<u32x4>(Ub + (size_t)min(s_ + w2, SEQ - 1) * DM); d_ = gload<u32x4>(Ub + (size_t)max(s_ - w2, 0) * DM); } while (0)
#define POOL_BODY(o_, u_, a_, d_, i_) do { const int s = s0 + (i_), tk = t0 + (i_); \
        const int lo = max(s - w2, 0), hi = min(s + w2, SEQ); \
        const u32x4 own = o_; \
        const float inv = 1.0f / (float)(hi - lo); \
        float o[8]; \
        o[0] = sum[0] * inv - lo_bf(own.x); o[1] = sum[1] * inv - hi_bf(own.x); o[2] = sum[2] * inv - lo_bf(own.y); o[3] = sum[3] * inv - hi_bf(own.y); \
        o[4] = sum[4] * inv - lo_bf(own.z); o[5] = sum[5] * inv - hi_bf(own.z); o[6] = sum[6] * inv - lo_bf(own.w); o[7] = sum[7] * inv - hi_bf(own.w); \
        u32x4 w; w.x = cvt_pk_bf16(o[0], o[1]); w.y = cvt_pk_bf16(o[2], o[3]); w.z = cvt_pk_bf16(o[4], o[5]); w.w = cvt_pk_bf16(o[6], o[7]); \
        gstore<u32x4>(YC + (size_t)tk * DM + 8 * l, w); \
        { const float ka = (s + w2 < SEQ) ? 1.0f : 0.0f, kd = (s - w2 >= 0) ? 1.0f : 0.0f; const u32x4 va = a_, vd = d_;        \
          sum[0] += ka * lo_bf(va.x) - kd * lo_bf(vd.x); sum[1] += ka * hi_bf(va.x) - kd * hi_bf(vd.x); sum[2] += ka * lo_bf(va.y) - kd * lo_bf(vd.y); sum[3] += ka * hi_bf(va.y) - kd * hi_bf(vd.y); \
          sum[4] += ka * lo_bf(va.z) - kd * lo_bf(vd.z); sum[5] += ka * hi_bf(va.z) - kd * hi_bf(vd.z); sum[6] += ka * lo_bf(va.w) - kd * lo_bf(vd.w); sum[7] += ka * hi_bf(va.w) - kd * hi_bf(vd.w); } \
          \
        const u32x4 ub = u_; \
        float x[8] = {lo_bf(ub.x), hi_bf(ub.x), lo_bf(ub.y), hi_bf(ub.y), lo_bf(ub.z), hi_bf(ub.z), lo_bf(ub.w), hi_bf(ub.w)}; \
        float sm = ((x[0] + x[1]) + (x[2] + x[3])) + ((x[4] + x[5]) + (x[6] + x[7])); \
        sm += __shfl_xor(sm, 1); sm += __shfl_xor(sm, 2); sm += __shfl_xor(sm, 4); sm += __shfl_xor(sm, 8); \
        const float mu = sm * (1.0f / 128.0f); \
        float qq = 0.f; \
        _Pragma("unroll") for (int j = 0; j < 8; ++j) { x[j] -= mu; qq += x[j] * x[j]; } \
        qq += __shfl_xor(qq, 1); qq += __shfl_xor(qq, 2); qq += __shfl_xor(qq, 4); qq += __shfl_xor(qq, 8); \
        const float rs = rsqrtf(qq * (1.0f / 128.0f) + LN_EPS); \
        _Pragma("unroll") for (int j = 0; j < 8; ++j) x[j] = x[j] * rs * gam[j]; \
        const int np = 64 * (s & 63) + (s >> 6); \
        u32x4 w2v; w2v.x = cvt_pk_bf16(x[0], x[1]); w2v.y = cvt_pk_bf16(x[2], x[3]); w2v.z = cvt_pk_bf16(x[4], x[5]); w2v.w = cvt_pk_bf16(x[6], x[7]); \
        gstore<u32x4>(UN + ((size_t)(b * SEQ + np)) * 512 + 8 * l, w2v); } while (0)
    for (int run = F.vb * 8 + F.wave; run < NTOK / 16; run += F.G * 8) {
        const int t0 = run * 16, b = t0 >> 12, s0 = t0 & 4095;
        const bf16_t* Ub = U + (size_t)b * SEQ * DM + 8 * l;
        float sum[8];
#pragma unroll
        for (int j = 0; j < 8; ++j) sum[j] = 0.f;
        {
            const int lo = max(s0 - w2, 0), hi = min(s0 + w2, SEQ);
            u32x4 wv[16];
#pragma unroll
            for (int d = 0; d < 16; ++d) { const int r = s0 - 8 + d; const int rc = min(max(r, 0), SEQ - 1); wv[d] = gload<u32x4>(Ub + (size_t)rc * DM); }
#pragma unroll
            for (int d = 0; d < 16; ++d) { const int r = s0 - 8 + d; const float k = (r >= lo && r < hi) ? 1.0f : 0.0f; const u32x4 v = wv[d];
                sum[0] += k * lo_bf(v.x); sum[1] += k * hi_bf(v.x); sum[2] += k * lo_bf(v.y); sum[3] += k * hi_bf(v.y); sum[4] += k * lo_bf(v.z); sum[5] += k * hi_bf(v.z); sum[6] += k * lo_bf(v.w); sum[7] += k * hi_bf(v.w); }
        }
        u32x4 oA, uA, aA, dA, oB, uB, aB, dB;
        POOL_LOAD(oA, uA, aA, dA, 0);
#pragma unroll 1
        for (int i = 0; i < 16; i += 2) {
            POOL_LOAD(oB, uB, aB, dB, i + 1);
            POOL_BODY(oA, uA, aA, dA, i);
            if (i + 2 < 16) POOL_LOAD(oA, uA, aA, dA, i + 2);
            POOL_BODY(oB, uB, aB, dB, i + 1);
        }
    }
#undef POOL_LOAD
#undef POOL_BODY
}

template <int MODE, bool XF32, bool FINAL>
__device__ __forceinline__ void p_ln(const Frame& F0, const float* xin, const bf16_t* hsrc, int l, int j3) {
    const Frame F = relaunder(F0);
    float* X = F.out; bf16_t* XB = WSP(bf16_t, WS_XB);
    const float* gam = F.in[22] + (size_t)(l * 3 + j3) * 1024; const float* bet = F.in[23] + (size_t)(l * 3 + j3) * 1024;
    const int ln = F.lane;
    float gv[16], bv[16];
#pragma unroll
    for (int ii = 0; ii < 2; ++ii)
#pragma unroll
        for (int j = 0; j < 8; ++j) { gv[ii * 8 + j] = gam[ii * 512 + ln * 8 + j]; bv[ii * 8 + j] = bet[ii * 512 + ln * 8 + j]; }
    LAS float* WR = (LAS float*)F.lds;
#define WR_PERM(c_) ((((c_) >> 9) * 2 + (((c_) >> 2) & 1)) * 256 + (((c_) >> 3) & 63) * 4 + ((c_) & 3))
    LAS int* hist = (LAS int*)(F.lds + 36 * 4096);
    float rbias_g = 0.f, rbias_e = 0.f;
    if (MODE == 1) {
        const float* wgp = F.in[15] + (size_t)l * 4096; const float* wep = F.in[17] + (size_t)l * 32768;
        for (int c = F.tid; c < 1024; c += NTHR) { const f32x4 v = gload<f32x4>(wgp + c * 4);
#pragma unroll
            for (int j = 0; j < 4; ++j) WR[j * 1024 + WR_PERM(c)] = v[j]; }
        for (int idx = F.tid; idx < 8192; idx += NTHR) { const int c = idx & 1023, q4 = idx >> 10; const f32x4 v = gload<f32x4>(wep + c * 32 + q4 * 4);
#pragma unroll
            for (int j = 0; j < 4; ++j) WR[(4 + q4 * 4 + j) * 1024 + WR_PERM(c)] = v[j]; }
        rbias_g = F.in[16][l * 4 + (ln & 3)]; rbias_e = F.in[18][l * 32 + (ln & 31)];
        __syncthreads();
    }
    const int2* POSS = WSP(int2, WS_POSS);
    if (MODE == 1) { int* ROWTOK = WSP(int, WS_ROWTOK); for (int i = F.vb * NTHR + F.tid; i < MPAD_MAX; i += F.G * NTHR) ROWTOK[i] = 0; }
    for (int ch = F.vb; ch < NTOK / 128; ch += F.G) {
        if (MODE == 1) { if (F.tid < 32) hist[F.tid] = 0; __syncthreads(); }
        const int t0 = ch * 128 + F.wave * 16;
        int2 myps = make_int2(0, 0);
        if (MODE == 2) myps = POSS[t0 + (ln & 15)];
        f32x4 nxf[4]; u32x4 nxb[2], nh0[2], nh1[2];
#define LN_LOAD(tt, ii_) do { const int t_ = (tt); const bf16_t* h0_ = hsrc + (size_t)t_ * DM; const bf16_t* h1_ = h0_; \
            if (MODE == 2) { const int p0_ = __shfl(myps.x, (ii_)), p1_ = __shfl(myps.y, (ii_)); h0_ = hsrc + (size_t)p0_ * DM; h1_ = hsrc + (size_t)p1_ * DM; } \
            _Pragma("unroll") for (int ii = 0; ii < 2; ++ii) { const int c0 = ii * 512 + ln * 8; \
                if (XF32) { nxf[ii * 2] = gload<f32x4>(xin + (size_t)t_ * DM + c0); nxf[ii * 2 + 1] = gload<f32x4>(xin + (size_t)t_ * DM + c0 + 4); } \
                else nxb[ii] = gload<u32x4>(XB + (size_t)t_ * DM + c0); \
                nh0[ii] = gload<u32x4>(h0_ + c0); if (MODE == 2) nh1[ii] = gload<u32x4>(h1_ + c0); } } while (0)
        LN_LOAD(t0, 0);
        for (int i = 0; i < 16; ++i) {
            const int t = t0 + i;
            float y[16];
#pragma unroll
            for (int ii = 0; ii < 2; ++ii) {
                float xx[8];
                if (XF32) {
#pragma unroll
                    for (int j = 0; j < 4; ++j) { xx[j] = nxf[ii * 2][j]; xx[4 + j] = nxf[ii * 2 + 1][j]; } }
                else { const u32x4 xv = nxb[ii];
                    xx[0] = lo_bf(xv.x); xx[1] = hi_bf(xv.x); xx[2] = lo_bf(xv.y); xx[3] = hi_bf(xv.y); xx[4] = lo_bf(xv.z); xx[5] = hi_bf(xv.z); xx[6] = lo_bf(xv.w); xx[7] = hi_bf(xv.w); }
                const u32x4 hv = nh0[ii];
                float hh[8] = {lo_bf(hv.x), hi_bf(hv.x), lo_bf(hv.y), hi_bf(hv.y), lo_bf(hv.z), hi_bf(hv.z), lo_bf(hv.w), hi_bf(hv.w)};
                if (MODE == 2) { const u32x4 h2 = nh1[ii];
                    hh[0] += lo_bf(h2.x); hh[1] += hi_bf(h2.x); hh[2] += lo_bf(h2.y); hh[3] += hi_bf(h2.y); hh[4] += lo_bf(h2.z); hh[5] += hi_bf(h2.z); hh[6] += lo_bf(h2.w); hh[7] += hi_bf(h2.w); }
#pragma unroll
                for (int j = 0; j < 8; ++j) y[ii * 8 + j] = DN_ALPHA * xx[j] + hh[j];
            }
            if (i + 1 < 16) LN_LOAD(t + 1, i + 1);
            float sm = 0.f;
#pragma unroll
            for (int j = 0; j < 16; ++j) sm += y[j];
            sm = wave_sum(sm);
            const float mu = sm * (1.0f / 1024.0f);
            float q = 0.f;
#pragma unroll
            for (int j = 0; j < 16; ++j) { y[j] -= mu; q += y[j] * y[j]; }
            q = wave_sum(q);
            const float rs = rsqrtf(q * (1.0f / 1024.0f) + LN_EPS);
#pragma unroll
            for (int j = 0; j < 16; ++j) y[j] = y[j] * rs * gv[j] + bv[j];
#pragma unroll
            for (int ii = 0; ii < 2; ++ii) {
                const int c0 = ii * 512 + ln * 8;
                if (FINAL) {
                    gstore<f32x4>(X + (size_t)t * DM + c0, (f32x4){y[ii * 8 + 0], y[ii * 8 + 1], y[ii * 8 + 2], y[ii * 8 + 3]});
                    gstore<f32x4>(X + (size_t)t * DM + c0 + 4, (f32x4){y[ii * 8 + 4], y[ii * 8 + 5], y[ii * 8 + 6], y[ii * 8 + 7]});
                } else {
                    u32x4 w; w.x = cvt_pk_bf16(y[ii * 8 + 0], y[ii * 8 + 1]); w.y = cvt_pk_bf16(y[ii * 8 + 2], y[ii * 8 + 3]); w.z = cvt_pk_bf16(y[ii * 8 + 4], y[ii * 8 + 5]); w.w = cvt_pk_bf16(y[ii * 8 + 6], y[ii * 8 + 7]);
                    gstore<u32x4>(XB + (size_t)t * DM + c0, w);
                }
            }
            if (MODE == 1) {
                const bool b0 = ln & 1, b1 = ln & 2, b2 = ln & 4;
#define ROUTER_DOT(dst, jj_) do { f32x2 a2 = (f32x2){0.f, 0.f}; _Pragma("unroll") for (int ii = 0; ii < 2; ++ii) { \
                    const f32x4 w0 = *(const LAS f32x4*)(WR + (jj_) * 1024 + ii * 512 + ln * 4), w1 = *(const LAS f32x4*)(WR + (jj_) * 1024 + ii * 512 + 256 + ln * 4); \
                    a2 += (f32x2){y[ii * 8 + 0], y[ii * 8 + 1]} * (f32x2){w0[0], w0[1]}; a2 += (f32x2){y[ii * 8 + 2], y[ii * 8 + 3]} * (f32x2){w0[2], w0[3]}; \
                    a2 += (f32x2){y[ii * 8 + 4], y[ii * 8 + 5]} * (f32x2){w1[0], w1[1]}; a2 += (f32x2){y[ii * 8 + 6], y[ii * 8 + 7]} * (f32x2){w1[2], w1[3]}; } \
                    dst = a2[0] + a2[1]; } while (0)
                float gq[4];
#pragma unroll
                for (int j = 0; j < 4; ++j) ROUTER_DOT(gq[j], j);
                float gv1[2];
#pragma unroll
                for (int k = 0; k < 2; ++k) { const float keep = b0 ? gq[2 * k + 1] : gq[2 * k], send = b0 ? gq[2 * k] : gq[2 * k + 1]; gv1[k] = keep + __shfl_xor(send, 1); }
                float gsum; { const float keep = b1 ? gv1[1] : gv1[0], send = b1 ? gv1[0] : gv1[1]; gsum = keep + __shfl_xor(send, 2); }
                gsum += __shfl_xor(gsum, 4); gsum += __shfl_xor(gsum, 8); gsum += __shfl_xor(gsum, 16); gsum += __shfl_xor(gsum, 32);
                gsum += rbias_g;
                float lg[4];
#pragma unroll
                for (int j = 0; j < 4; ++j) lg[j] = __shfl(gsum, j);
                int gi = 0; float gm = lg[0];
#pragma unroll
                for (int j = 1; j < 4; ++j) if (lg[j] > gm) { gm = lg[j]; gi = j; }
                float den = 0.f;
#pragma unroll
                for (int j = 0; j < 4; ++j) den += __expf(lg[j] - gm);
                const float pg = 1.0f / den;
                const int gib = __builtin_amdgcn_readfirstlane(gi) * 8 + 4;
                float eq[8];
#pragma unroll
                for (int j = 0; j < 8; ++j) ROUTER_DOT(eq[j], gib + j);
                float ev1[4], ev2[2];
#pragma unroll
                for (int k = 0; k < 4; ++k) { const float keep = b0 ? eq[2 * k + 1] : eq[2 * k], send = b0 ? eq[2 * k] : eq[2 * k + 1]; ev1[k] = keep + __shfl_xor(send, 1); }
#pragma unroll
                for (int k = 0; k < 2; ++k) { const float keep = b1 ? ev1[2 * k + 1] : ev1[2 * k], send = b1 ? ev1[2 * k] : ev1[2 * k + 1]; ev2[k] = keep + __shfl_xor(send, 2); }
                float esum; { const float keep = b2 ? ev2[1] : ev2[0], send = b2 ? ev2[0] : ev2[1]; esum = keep + __shfl_xor(send, 4); }
                esum += __shfl_xor(esum, 8); esum += __shfl_xor(esum, 16); esum += __shfl_xor(esum, 32);
                esum += __shfl(rbias_e, gi * 8 + (ln & 7));
                float le[8];
#pragma unroll
                for (int j = 0; j < 8; ++j) le[j] = __shfl(esum, j);
#undef ROUTER_DOT
                int i0 = 0; float m0 = le[0];
#pragma unroll
                for (int j = 1; j < 8; ++j) if (le[j] > m0) { m0 = le[j]; i0 = j; }
                int i1 = -1; float m1 = -3.0e38f;
#pragma unroll
                for (int j = 0; j < 8; ++j) if (j != i0 && le[j] > m1) { m1 = le[j]; i1 = j; }
                const float p1 = __expf(m1 - m0), rden = 1.0f / (1.0f + p1);
                if (ln == 0) {
                    const int e0 = gi * 8 + i0, e1 = gi * 8 + i1;
                    WSP(int2, WS_TOKE)[t] = make_int2(e0, e1);
                    WSP(float2, WS_TOKG)[t] = make_float2(pg * rden, pg * p1 * rden);
                    atomicAdd((int*)&hist[e0], 1); atomicAdd((int*)&hist[e1], 1);
                }
            }
        }
#undef LN_LOAD
        if (MODE == 1) { __syncthreads(); if (F.tid < 32) WSP(int, WS_HIST)[ch * 32 + F.tid] = hist[F.tid]; __syncthreads(); }
    }
}

__device__ __forceinline__ void p_dispatch(const Frame& F0) {
    const Frame F = relaunder(F0);
    LAS int* hsum = (LAS int*)F.lds; LAS int* hpre = hsum + 32; LAS int* off = hsum + 64; LAS int* cursor = hsum + 128;
    const int* HIST = WSP(int, WS_HIST); const int2* TOKE = WSP(int2, WS_TOKE); const float2* TOKG = WSP(float2, WS_TOKG);
    int2* POSS = WSP(int2, WS_POSS); float* GPOS = WSP(float, WS_GPOS); int* TEXP = WSP(int, WS_TILEEXP);
    int* ROWTOK = WSP(int, WS_ROWTOK);
    for (int ch = F.vb; ch < NTOK / 128; ch += F.G) {
        if (F.tid < 32) { hsum[F.tid] = 0; hpre[F.tid] = 0; cursor[F.tid] = 0; }
        __syncthreads();
        { const int e = F.tid & 31, part = F.tid >> 5; int tot = 0, pre = 0;
          for (int cc = part * 16; cc < part * 16 + 16; ++cc) { const int v = HIST[cc * 32 + e]; tot += v; if (cc < ch) pre += v; }
          atomicAdd((int*)&hsum[e], tot); atomicAdd((int*)&hpre[e], pre); }
        __syncthreads();
        if (F.tid == 0) { int o = 0; for (int e = 0; e < 32; ++e) { off[e] = o; o += (hsum[e] + 255) & ~255; } off[32] = o; }
        __syncthreads();
        if (ch == 0) { const int ntile = off[32] >> 8;
            if (F.tid < 320) { int e = 0; for (int k = 0; k < 32; ++k) if (F.tid * 256 >= off[k + 1]) e = k + 1; if (F.tid < ntile) TEXP[F.tid] = e < 32 ? e : 31; }
            if (F.tid == 0) TEXP[320] = ntile; }
        {
            const int t0 = ch * 128 + F.wave * 16;
            int p0 = 0, p1 = 0;
            if (F.lane < 16) { const int t = t0 + F.lane; const int2 ee = TOKE[t]; const float2 gg = TOKG[t];
                const int r0 = atomicAdd((int*)&cursor[ee.x], 1); const int r1 = atomicAdd((int*)&cursor[ee.y], 1);
                p0 = off[ee.x] + hpre[ee.x] + r0; p1 = off[ee.y] + hpre[ee.y] + r1;
                POSS[t] = make_int2(p0, p1); GPOS[p0] = gg.x; GPOS[p1] = gg.y; ROWTOK[p0] = t; ROWTOK[p1] = t; }
        }
        __syncthreads();
    }
}

typedef short s16x4 __attribute__((ext_vector_type(4)));
typedef float f32x16 __attribute__((ext_vector_type(16)));
__device__ __forceinline__ s16x4 tr16(const LAS unsigned char* p) { return __builtin_amdgcn_ds_read_tr16_b64_v4i16((LAS s16x4*)p); }
__device__ __forceinline__ bf16x8 cat8(s16x4 a, s16x4 b) { return (bf16x8){a[0], a[1], a[2], a[3], b[0], b[1], b[2], b[3]}; }
constexpr int GQ_S = 288, GV_S = 128, GT_S = 128, GST_S = 288, GA_S = 128;
constexpr int G_QR = 0, G_LR = 64 * GQ_S, G_VR = 2 * 64 * GQ_S, G_VRSZ = 64 * GV_S, G_QTT = G_VR + 2 * G_VRSZ, G_TSZ = 128 * GT_S, G_KTT = G_QTT + 2 * G_TSZ,
              G_ST = G_KTT + 2 * G_TSZ, G_AM = G_ST + 64 * GST_S, G_VEC = G_AM + 64 * GA_S, G_VECSZ = 3 * 512, G_END = G_VEC + 2 * G_VECSZ;
static_assert(G_END <= LDS_MISC, "GLA LDS map");
static_assert((G_VR % 128) == 0 && (G_QTT % 128) == 0 && (G_KTT % 128) == 0 && (G_ST % 128) == 0 && (G_AM % 128) == 0 && (G_TSZ % 128) == 0 && (G_VRSZ % 128) == 0, "GLA LDS alignment");

struct GlaLane { int w, g, c, q, p, hi, c32, blk; };
__device__ __forceinline__ const LAS unsigned char* vbase(const LAS unsigned char* p) { asm volatile("" : "+v"(p)); return p; }
__device__ __forceinline__ LAS unsigned char* vbasew(LAS unsigned char* p) { asm volatile("" : "+v"(p)); return p; }
__device__ __forceinline__ const LAS unsigned char* lxor(const LAS unsigned char* p, unsigned x) { return (const LAS unsigned char*)(uintptr_t)((unsigned)(uintptr_t)p ^ x); }
__device__ __forceinline__ LAS unsigned char* lxorw(LAS unsigned char* p, unsigned x) { return (LAS unsigned char*)(uintptr_t)((unsigned)(uintptr_t)p ^ x); }
__device__ __forceinline__ int s13(int r) { return ((r >> 1) & 1) | (((r >> 3) & 1) << 1); }
__device__ __forceinline__ int s31(int r) { return ((r >> 3) & 1) | (((r >> 1) & 1) << 1); }
__device__ __forceinline__ void gla_secB(const GlaLane& t, const LAS unsigned char* QR, const LAS unsigned char* LR, LAS unsigned char* QTT, LAS unsigned char* KTT, LAS float* vec) {
    const int w = t.w, g = t.g, c = t.c, q = t.q, p = t.p;
    const int k = 16 * w + c;
    const LAS unsigned char* lb8 = vbase(LR + (8 * g + q) * GQ_S + (((16 * w + 4 * p) * 2) ^ ((g & 1) << 7)));
    const LAS unsigned char* lb4 = vbase(LR + (4 * g + q) * GQ_S + (((16 * w + 4 * p) * 2) ^ (((g >> 1) & 1) << 7)));
    const LAS unsigned char* qb4 = vbase(QR + (4 * g + q) * GQ_S + (((16 * w + 4 * p) * 2) ^ (((g >> 1) & 1) << 7)));
    s16x4 b0 = tr16(lb8), b1 = tr16(lb8 + 4 * GQ_S), b2 = tr16(lb8 + 32 * GQ_S), b3 = tr16(lb8 + 36 * GQ_S);
    s16x4 qv[4], lv[4];
#pragma unroll
    for (int lt = 0; lt < 4; ++lt) { qv[lt] = tr16(qb4 + 16 * lt * GQ_S); lv[lt] = tr16(lb4 + 16 * lt * GQ_S); }
    bf16x8 bf[2]; bf[0] = cat8(b0, b1); bf[1] = cat8(b2, b3);
    f32x4 cb[4];
#pragma unroll
    for (int lt = 0; lt < 4; ++lt) {
        cb[lt] = (f32x4){0.f, 0.f, 0.f, 0.f};
#pragma unroll
        for (int ks = 0; ks < 2; ++ks) {
            if (ks == 1 && lt < 2) continue;
            bf16x8 tri;
#pragma unroll
            for (int j = 0; j < 8; ++j) tri[j] = (32 * ks + 8 * g + j <= 16 * lt + c) ? (short)0x3F80 : (short)0;
            cb[lt] = __builtin_amdgcn_mfma_f32_16x16x32_bf16(tri, bf[ks], cb[lt], 0, 0, 0);
        }
    }
    const float bmid = __shfl(cb[2][0], c), blast = __shfl(cb[3][3], 48 + c);
    LAS unsigned char* qw = vbasew(QTT + k * GT_S + 32 * s13(c) + 16 * ((g >> 1) ^ (c & 1)) + 8 * ((g & 1) ^ ((c >> 2) & 1)));
    LAS unsigned char* kw = vbasew(KTT + k * GT_S + 32 * s13(c) + 16 * ((g >> 1) ^ ((c >> 2) & 1)) + 8 * (g & 1));
#pragma unroll
    for (int lt = 0; lt < 4; ++lt) {
        float qt[4], kt[4], fe[4];
#pragma unroll
        for (int e = 0; e < 4; ++e) fe[e] = __builtin_amdgcn_exp2f(bf2f((bf16_t)lv[lt][e]));
        float up[4], dn[4];
        up[0] = __builtin_amdgcn_exp2f(cb[lt][0] - bmid); up[1] = up[0] * fe[1]; up[2] = up[1] * fe[2]; up[3] = up[2] * fe[3];
        dn[3] = __builtin_amdgcn_exp2f(bmid - cb[lt][3]); dn[2] = dn[3] * fe[3]; dn[1] = dn[2] * fe[2]; dn[0] = dn[1] * fe[1];
#pragma unroll
        for (int e = 0; e < 4; ++e) qt[e] = bf2f((bf16_t)qv[lt][e]) * up[e];
        kt[0] = dn[0] - dn[0] * fe[0]; kt[1] = dn[1] - dn[0]; kt[2] = dn[2] - dn[1]; kt[3] = dn[3] - dn[2];
        u32x2 wq, wk; wq.x = cvt_pk_bf16(qt[0], qt[1]); wq.y = cvt_pk_bf16(qt[2], qt[3]); wk.x = cvt_pk_bf16(kt[0], kt[1]); wk.y = cvt_pk_bf16(kt[2], kt[3]);
        *(LAS u32x2*)lxorw(qw, 32 * lt) = wq;
        *(LAS u32x2*)lxorw(kw, 32 * lt) = wk;
    }
    if (g == 0) { vec[k] = __builtin_amdgcn_exp2f(bmid); vec[128 + k] = __builtin_amdgcn_exp2f(blast); vec[256 + k] = __builtin_amdgcn_exp2f(blast - bmid); }
}
__device__ __forceinline__ void gla_secC(const GlaLane& t, const f32x16& S, const LAS float* ebm, LAS unsigned char* ST, const LAS unsigned char* QTT, const LAS unsigned char* KTT, LAS unsigned char* AM) {
    const int w = t.w, g = t.g, c = t.c, q = t.q, p = t.p, hi = t.hi, c32 = t.c32;
    const int kb = w >> 1, vb = w & 1, v = 32 * vb + c32;
    int ti = w;
    int mt = ti < 4 ? 0 : (ti < 7 ? 1 : (ti < 9 ? 2 : 3)), lt = ti - (mt == 0 ? 0 : (mt == 1 ? 3 : (mt == 2 ? 5 : 6)));
    const int sl = s13(8 * g + q);
    const LAS unsigned char* kl0 = vbase(KTT + (8 * g + q) * GT_S + 32 * sl + 16 * (p >> 1) + 8 * (p & 1));
    const LAS unsigned char* kl4 = vbase(KTT + (8 * g + q + 4) * GT_S + 32 * sl + 16 * ((p >> 1) ^ 1) + 8 * (p & 1));
    const LAS unsigned char* ql0 = vbase(QTT + (8 * g + q) * GT_S + 32 * sl + 16 * ((p >> 1) ^ (q & 1)) + 8 * (p & 1));
    const LAS unsigned char* ql4 = vbase(QTT + (8 * g + q + 4) * GT_S + 32 * sl + 16 * ((p >> 1) ^ (q & 1)) + 8 * ((p & 1) ^ 1));
    const LAS unsigned char* ka0 = vbase(lxor(kl0, 32 * mt)); const LAS unsigned char* ka4 = vbase(lxor(kl4, 32 * mt));
    const LAS unsigned char* qa0 = vbase(lxor(ql0, 32 * lt)); const LAS unsigned char* qa4 = vbase(lxor(ql4, 32 * lt));
    s16x4 ka[8], qb[8];
#pragma unroll
    for (int ks = 0; ks < 4; ++ks) { ka[2 * ks] = tr16(ka0 + 32 * ks * GT_S); ka[2 * ks + 1] = tr16(ka4 + 32 * ks * GT_S);
        qb[2 * ks] = tr16(qa0 + 32 * ks * GT_S); qb[2 * ks + 1] = tr16(qa4 + 32 * ks * GT_S); }
    const LAS unsigned char* eb = vbase((const LAS unsigned char*)(ebm + 32 * kb + 4 * hi));
    f32x4 em[4];
#pragma unroll
    for (int gg = 0; gg < 4; ++gg) em[gg] = *(const LAS f32x4*)(eb + 32 * gg);
    const int su = (c32 >> 2) & 1;
    LAS unsigned char* st0 = vbasew(ST + v * GST_S + 64 * kb + 8 * hi + 16 * su);
    LAS unsigned char* st1 = vbasew(ST + v * GST_S + 64 * kb + 8 * hi + 16 * (su ^ 1));
#pragma unroll
    for (int gg = 0; gg < 4; ++gg) {
        u32x2 ws; ws.x = cvt_pk_bf16(S[4 * gg + 0] * em[gg][0], S[4 * gg + 1] * em[gg][1]); ws.y = cvt_pk_bf16(S[4 * gg + 2] * em[gg][2], S[4 * gg + 3] * em[gg][3]);
        *(LAS u32x2*)(((gg & 1) ? st1 : st0) + 32 * (gg >> 1)) = ws;
    }
    LAS unsigned char* aml = vbasew(AM + c * GA_S + 32 * s13(c) + 16 * ((g >> 1) ^ (c & 1)) + 8 * (g & 1));
    for (;;) {
        f32x4 a4 = (f32x4){0.f, 0.f, 0.f, 0.f};
#pragma unroll
        for (int ks = 0; ks < 4; ++ks) a4 = __builtin_amdgcn_mfma_f32_16x16x32_bf16(cat8(ka[2 * ks], ka[2 * ks + 1]), cat8(qb[2 * ks], qb[2 * ks + 1]), a4, 0, 0, 0);
        if (mt == lt) {
#pragma unroll
            for (int r = 0; r < 4; ++r) a4[r] = (4 * g + r <= c) ? a4[r] : 0.f;
        }
        u32x2 wa; wa.x = cvt_pk_bf16(a4[0], a4[1]); wa.y = cvt_pk_bf16(a4[2], a4[3]);
        *(LAS u32x2*)(lxorw(aml, 32 * mt) + 16 * lt * GA_S) = wa;
        ti += 8; if (ti >= 10) break;
        mt = ti < 9 ? 2 : 3; lt = 3;
        const LAS unsigned char* kb0 = vbase(lxor(kl0, 32 * mt)); const LAS unsigned char* kb4 = vbase(lxor(kl4, 32 * mt));
        const LAS unsigned char* qc0 = lxor(ql0, 96); const LAS unsigned char* qc4 = lxor(ql4, 96);
#pragma unroll
        for (int ks = 0; ks < 4; ++ks) { ka[2 * ks] = tr16(kb0 + 32 * ks * GT_S); ka[2 * ks + 1] = tr16(kb4 + 32 * ks * GT_S);
            qb[2 * ks] = tr16(qc0 + 32 * ks * GT_S); qb[2 * ks + 1] = tr16(qc4 + 32 * ks * GT_S); }
    }
}
__device__ __forceinline__ void gla_secD(const GlaLane& t, f32x16& S, const LAS unsigned char* AM, const LAS unsigned char* QTT, const LAS unsigned char* KTT, const LAS unsigned char* VR,
                                         const LAS unsigned char* ST, const LAS float* vec, bf16_t* orow  ) {
    const int w = t.w, g = t.g, c = t.c, q = t.q, p = t.p, hi = t.hi, c32 = t.c32, blk = t.blk;
    const int lt = w & 3, vt0 = 2 * (w >> 2);
    const int nka = lt < 2 ? 1 : 2;
    const int kb = w >> 1, vb = w & 1;
    bf16x8 bA[2], sa[2][4], kaw[4];
    s16x4 bq[8], va[2][4], vw[8];
    const int sl = s13(8 * g + q);
    const LAS unsigned char* amb = vbase(AM + (16 * lt + c) * GA_S + 32 * ((g >> 1) ^ s13(c)) + 16 * ((g & 1) ^ (c & 1)));
    const LAS unsigned char* qt0 = vbase(QTT + (8 * g + q) * GT_S + 32 * (lt ^ sl) + 16 * ((p >> 1) ^ (q & 1)) + 8 * (p & 1));
    const LAS unsigned char* qt4 = vbase(QTT + (8 * g + q + 4) * GT_S + 32 * (lt ^ sl) + 16 * ((p >> 1) ^ (q & 1)) + 8 * ((p & 1) ^ 1));
    const LAS unsigned char* vrb = vbase(VR + (8 * g + q) * GV_S + 32 * (vt0 ^ s31(8 * g + q)) + 8 * p);
    const LAS unsigned char* stb = vbase(ST + (16 * vt0 + c) * GST_S + 32 * (g >> 1) + 16 * ((g & 1) ^ ((c >> 2) & 1)));
#pragma unroll
    for (int ks = 0; ks < 2; ++ks) bA[ks] = *(const LAS bf16x8*)lxor(amb, 64 * ks);
#pragma unroll
    for (int ks = 0; ks < 4; ++ks) { bq[2 * ks] = tr16(qt0 + 32 * ks * GT_S); bq[2 * ks + 1] = tr16(qt4 + 32 * ks * GT_S); }
#pragma unroll
    for (int vi = 0; vi < 2; ++vi) {
        const LAS unsigned char* vv = lxor(vrb, 32 * vi);
#pragma unroll
        for (int ks = 0; ks < 2; ++ks) { va[vi][2 * ks] = tr16(vv + 32 * ks * GV_S); va[vi][2 * ks + 1] = tr16(vv + (32 * ks + 4) * GV_S); }
#pragma unroll
        for (int ks = 0; ks < 4; ++ks) sa[vi][ks] = *(const LAS bf16x8*)(stb + 16 * vi * GST_S + 64 * ks); }
#pragma unroll
    for (int vi = 0; vi < 2; ++vi) {
        const int vt = vt0 + vi;
        f32x4 o4 = (f32x4){0.f, 0.f, 0.f, 0.f};
#pragma unroll
        for (int ks = 0; ks < 2; ++ks) if (ks < nka) o4 = __builtin_amdgcn_mfma_f32_16x16x32_bf16(cat8(va[vi][2 * ks], va[vi][2 * ks + 1]), bA[ks], o4, 0, 0, 0);
#pragma unroll
        for (int ks = 0; ks < 4; ++ks) o4 = __builtin_amdgcn_mfma_f32_16x16x32_bf16(sa[vi][ks], cat8(bq[2 * ks], bq[2 * ks + 1]), o4, 0, 0, 0);
        u32x2 wo; wo.x = cvt_pk_bf16(o4[0], o4[1]); wo.y = cvt_pk_bf16(o4[2], o4[3]);
        gstore<u32x2>(orow + 16 * vt + 4 * g, wo);
    }
    const LAS unsigned char* ktb = vbase(KTT + (32 * kb + c32) * GT_S + 32 * s13(c32) + 16 * (hi ^ ((c32 >> 2) & 1)));
    const LAS unsigned char* vwb = vbase(VR + (8 * hi + q) * GV_S + 32 * ((2 * vb + blk) ^ s31(8 * hi + q)) + 8 * p);
#pragma unroll
    for (int ks = 0; ks < 4; ++ks) { kaw[ks] = *(const LAS bf16x8*)lxor(ktb, 32 * ks);
        vw[2 * ks] = tr16(vwb + 16 * ks * GV_S); vw[2 * ks + 1] = tr16(vwb + (16 * ks + 4) * GV_S); }
    const LAS unsigned char* veb = vbase((const LAS unsigned char*)(vec + 128 + 32 * kb + 4 * hi));
    f32x4 el[4], ed[4];
#pragma unroll
    for (int gg = 0; gg < 4; ++gg) { el[gg] = *(const LAS f32x4*)(veb + 32 * gg); ed[gg] = *(const LAS f32x4*)(veb + 512 + 32 * gg); }
    f32x16 W;
#pragma unroll
    for (int j = 0; j < 16; ++j) W[j] = 0.f;
#pragma unroll
    for (int ks = 0; ks < 4; ++ks) W = __builtin_amdgcn_mfma_f32_32x32x16_bf16(kaw[ks], cat8(vw[2 * ks], vw[2 * ks + 1]), W, 0, 0, 0);
#pragma unroll
    for (int gg = 0; gg < 4; ++gg)
#pragma unroll
        for (int r = 0; r < 4; ++r) S[4 * gg + r] = el[gg][r] * S[4 * gg + r] + ed[gg][r] * W[4 * gg + r];
}

__device__ __forceinline__ void p_gla(const Frame& F0) {
    const Frame F = relaunder(F0);
    const bf16_t* PR = WSP(bf16_t, WS_PROJ);
    LAS unsigned char* L = F.lds;
    const int tid = F.tid, lane = F.lane;
    GlaLane t; t.w = F.wave; t.g = lane >> 4; t.c = lane & 15; t.q = t.c >> 2; t.p = lane & 3; t.hi = lane >> 5; t.c32 = lane & 31; t.blk = (lane >> 4) & 1;
    constexpr int NCH = SEQ / 64;
    for (int un0 = F.vb; un0 < 256; un0 += F.G) {
        const int un = (((un0 >> 5) * 8 + (un0 & 7)) << 2) | ((un0 >> 3) & 3);
        const int b = un >> 5, h = (un >> 2) & 7, dir = (un >> 1) & 1, vh = un & 1;
        bf16_t* O = WSP(bf16_t, dir ? WS_OB : WS_OF);
        const bf16_t* prb = PR + (size_t)b * SEQ * 5120 + h * 128;
        __syncthreads();
        for (int i = tid; i < 64 * GA_S / 4; i += NTHR) ((LAS unsigned*)(L + G_AM))[i] = 0u;
        f32x16 S;
#pragma unroll
        for (int j = 0; j < 16; ++j) S[j] = 0.f;
        u32x4 qreg[2], lreg[2], vreg;
#define GLA_LOAD(n) do { _Pragma("unroll") for (int i_ = 0; i_ < 2; ++i_) { const int idx = tid + 512 * i_, r_ = idx >> 4, c16 = idx & 15; const int tau = (n) * 64 + r_, t_ = dir ? (SEQ - 1 - tau) : tau; \
            const bf16_t* rp = prb + (size_t)t_ * 5120; qreg[i_] = gload<u32x4>(rp + c16 * 8); lreg[i_] = gload<u32x4>(rp + (2 + dir) * 1024 + c16 * 8); } \
          { const int r_ = tid >> 3, c16 = tid & 7; const int tau = (n) * 64 + r_, t_ = dir ? (SEQ - 1 - tau) : tau; vreg = gload<u32x4>(prb + (size_t)t_ * 5120 + 1024 + vh * 64 + c16 * 8); } } while (0)
#define GLA_WRITE(pv) do { _Pragma("unroll") for (int i_ = 0; i_ < 2; ++i_) { const int idx = tid + 512 * i_, r_ = idx >> 4, c16 = idx & 15; \
            const int co_ = (c16 * 16) ^ (((r_ >> 3) & 1) << 7); *(LAS u32x4*)(L + G_QR + r_ * GQ_S + co_) = qreg[i_]; *(LAS u32x4*)(L + G_LR + r_ * GQ_S + co_) = lreg[i_]; } \
          { const int r_ = tid >> 3, c16 = tid & 7; *(LAS u32x4*)(L + G_VR + (pv) * G_VRSZ + r_ * GV_S + 32 * ((c16 >> 1) ^ s31(r_)) + 16 * (c16 & 1)) = vreg; } } while (0)
        GLA_LOAD(0); GLA_WRITE(0); GLA_LOAD(1);
        __syncthreads();
        gla_secB(t, L + G_QR, L + G_LR, L + G_QTT, L + G_KTT, (LAS float*)(L + G_VEC));
        for (int n = 0; n < NCH; ++n) {
            const int pb = n & 1;
            __syncthreads();
            if (n + 1 < NCH) { GLA_WRITE(pb ^ 1); if (n + 2 < NCH) GLA_LOAD(n + 2); }
            gla_secC(t, S, (const LAS float*)(L + G_VEC + pb * G_VECSZ), L + G_ST, L + G_QTT + pb * G_TSZ, L + G_KTT + pb * G_TSZ, L + G_AM);
            __syncthreads();
            { const int tau = n * 64 + 16 * (t.w & 3) + t.c, tt = dir ? (SEQ - 1 - tau) : tau;
              gla_secD(t, S, L + G_AM, L + G_QTT + pb * G_TSZ, L + G_KTT + pb * G_TSZ, L + G_VR + pb * G_VRSZ, L + G_ST, (const LAS float*)(L + G_VEC + pb * G_VECSZ),
                       O + ((size_t)(b * SEQ + tt)) * DM + h * 128 + vh * 64); }
            if (n + 1 < NCH) gla_secB(t, L + G_QR, L + G_LR, L + G_QTT + (pb ^ 1) * G_TSZ, L + G_KTT + (pb ^ 1) * G_TSZ, (LAS float*)(L + G_VEC + (pb ^ 1) * G_VECSZ));
        }
#undef GLA_LOAD
#undef GLA_WRITE
    }
    __syncthreads();
}

__device__ __forceinline__ void p_gate(const Frame& F0) {
    const Frame F = relaunder(F0);
    bf16_t* OFp = WSP(bf16_t, WS_OF); const bf16_t* OBp = WSP(bf16_t, WS_OB); const bf16_t* PR = WSP(bf16_t, WS_PROJ); const float* ng = F.in[10];
    const int ln = F.lane;
    float gv[8];
#pragma unroll
    for (int j = 0; j < 8; ++j) gv[j] = ng[(8 * ln + j) & 127];
    for (int tb = (F.vb * 8 + F.wave) * 2; tb < NTOK; tb += F.G * 8 * 2) {
        u32x4 av[2][2], bv[2][2], gqv[2][2];
#pragma unroll
        for (int u2 = 0; u2 < 2; ++u2)
#pragma unroll
            for (int ii = 0; ii < 2; ++ii) { const int t = tb + u2, c0 = ii * 512 + ln * 8;
                av[u2][ii] = gload<u32x4>(OFp + (size_t)t * DM + c0); bv[u2][ii] = gload<u32x4>(OBp + (size_t)t * DM + c0); gqv[u2][ii] = gload<u32x4>(PR + (size_t)t * 5120 + 4096 + c0); }
#pragma unroll
        for (int u2 = 0; u2 < 2; ++u2)
#pragma unroll
        for (int ii = 0; ii < 2; ++ii) {
            const int t = tb + u2, c0 = ii * 512 + ln * 8;
            const u32x4 a = av[u2][ii], bq = bv[u2][ii], gq = gqv[u2][ii];
            float o[8] = {lo_bf(a.x) + lo_bf(bq.x), hi_bf(a.x) + hi_bf(bq.x), lo_bf(a.y) + lo_bf(bq.y), hi_bf(a.y) + hi_bf(bq.y), lo_bf(a.z) + lo_bf(bq.z), hi_bf(a.z) + hi_bf(bq.z), lo_bf(a.w) + lo_bf(bq.w), hi_bf(a.w) + hi_bf(bq.w)};
            const float gs[8] = {lo_bf(gq.x), hi_bf(gq.x), lo_bf(gq.y), hi_bf(gq.y), lo_bf(gq.z), hi_bf(gq.z), lo_bf(gq.w), hi_bf(gq.w)};
            float q = 0.f;
#pragma unroll
            for (int j = 0; j < 8; ++j) q += o[j] * o[j];
            q += __shfl_xor(q, 1); q += __shfl_xor(q, 2); q += __shfl_xor(q, 4); q += __shfl_xor(q, 8);
            const float rs = rsqrtf(q * (1.0f / 128.0f) + LN_EPS);
#pragma unroll
            for (int j = 0; j < 8; ++j) o[j] = o[j] * rs * gv[j] * gs[j];
            u32x4 w; w.x = cvt_pk_bf16(o[0], o[1]); w.y = cvt_pk_bf16(o[2], o[3]); w.z = cvt_pk_bf16(o[4], o[5]); w.w = cvt_pk_bf16(o[6], o[7]);
            gstore<u32x4>(OFp + (size_t)t * DM + c0, w);
        }
    }
}

constexpr int FILL_TILES = 1, MOE_TILES = 32 * 384;
constexpr int TAIL_GU = 20, TAIL_DN = 16, FILL_L1_FS = 16;
__device__ __forceinline__ int moe_idle_wgs(int ntile, int G) { const int rem = (ntile * 4) % G; return rem > 0 ? G - rem : 0; }
__device__ __forceinline__ int moe_tail_done(int ntile, int G) { const int d = moe_idle_wgs(ntile, G) * (TAIL_GU + TAIL_DN); return d < MOE_TILES ? d : MOE_TILES; }
__device__ __forceinline__ bf16_t* moe_wgu(const Frame& F, int l) { return l ? (bf16_t*)F.out : WSP(bf16_t, WS_WGU); }
__device__ __forceinline__ bf16_t* moe_wdn(const Frame& F, int l) { return l ? (bf16_t*)F.out + (size_t)33554432 : WSP(bf16_t, WS_WDN); }
__device__ __forceinline__ void fill_tile(const Frame& F, int gid) {
    int ln = (int)__builtin_amdgcn_mbcnt_hi(~0u, __builtin_amdgcn_mbcnt_lo(~0u, 0u)); asm volatile("" : "+v"(ln));
    const int l = gid >= MOE_TILES ? 1 : 0, tl = gid - l * MOE_TILES;
    MoeMap M{F.in[19] + (size_t)l * 32 * 524288, F.in[20] + (size_t)l * 32 * 524288, F.in[21] + (size_t)l * 32 * 524288, moe_wgu(F, l), moe_wdn(F, l)};
    const TDesc d = M(tl);
    LAS unsigned char* img = F.lds + (F.wave - 1) * 8192;
    const int kp = ln >> 3, ng = ln & 7;
    f32x4 v[4][2][2];
#pragma unroll
    for (int p = 0; p < 4; ++p)
#pragma unroll
        for (int h = 0; h < 2; ++h) { const float* sp = d.src + (size_t)(16 * p + 2 * kp + h) * d.ldsrc + 8 * ng; v[p][h][0] = gload<f32x4>(sp); v[p][h][1] = gload<f32x4>(sp + 4); }
#pragma unroll
    for (int p = 0; p < 4; ++p)
#pragma unroll
        for (int j = 0; j < 8; ++j) { const int n = 8 * ng + j, kd = (8 * p + kp) ^ (ng << 2);
            *(LAS unsigned*)(img + n * 128 + kd * 4) = cvt_pk_bf16(v[p][0][j >> 2][j & 3], v[p][1][j >> 2][j & 3]); }
    asm volatile("s_waitcnt lgkmcnt(0)" ::: "memory");
#pragma unroll
    for (int r = 0; r < 8; ++r) { const int n = 8 * r + kp, kc = ng;
        const u32x4 w = *(const LAS u32x4*)(img + n * 128 + ((kc ^ r) << 4));
        gstore<u32x4>(d.dst + (size_t)n * d.ldd + 8 * kc, w); }
    asm volatile("s_waitcnt lgkmcnt(0)" ::: "memory");
}
__device__ __forceinline__ void xcd_barrier_fill(const XcdBarrier& b, const Frame& F0, int& fs) {
    asm volatile("s_waitcnt vmcnt(0)" ::: "memory");
    __syncthreads();
    if (b.wave == 0) xcd_barrier_core(b);
    else if (F0.G == 256) {
        const Frame F = relaunder(F0);
#pragma unroll
        for (int i = 0; i < FILL_TILES; ++i) {
            if (fs < 7) { const int q = fs * 7 + (F.wave - 1); const int gid = q * 256 + F.vb; if (gid < MOE_TILES) fill_tile(F, gid); }
            else if (fs >= FILL_L1_FS && fs < FILL_L1_FS + 8) {
                const int ntile = __builtin_amdgcn_readfirstlane(WSP(int, WS_TILEEXP)[320]);
                const int q = (fs - FILL_L1_FS) * 7 + (F.wave - 1); const int tl = moe_tail_done(ntile, F.G) + q * 256 + F.vb; if (tl < MOE_TILES) fill_tile(F, MOE_TILES + tl); }
        }
    }
    ++fs;
    __syncthreads();
}

struct MoeOffMap { MoeMap M; int off; __device__ __forceinline__ TDesc operator()(int tl) const { return M(tl + off); } };
__device__ __forceinline__ void moe_tail_convert(const Frame& F, int ntile, int which) {
    const int idle = moe_idle_wgs(ntile, F.G), rem = F.G - idle, j = F.vb - rem;
    if (F.G != 256 || idle == 0 || j < 0) return;
    const int per = which ? TAIL_DN : TAIL_GU, first = which ? idle * TAIL_GU : 0;
    int cnt = idle * per; if (first + cnt > MOE_TILES) cnt = MOE_TILES - first; if (cnt <= 0) return;
    MoeOffMap T{MoeMap{F.in[19] + (size_t)32 * 524288, F.in[20] + (size_t)32 * 524288, F.in[21] + (size_t)32 * 524288, (bf16_t*)F.out, (bf16_t*)F.out + (size_t)33554432}, first};
    __syncthreads();
    tconv_run_sub(F, cnt, T, j, idle);
}
__device__ __forceinline__ bool phase_in(int lo, int hi, int k) {
#if ONE_LAUNCH
    asm volatile("" : "+s"(lo), "+s"(hi));
#endif
    return lo <= k && k < hi;
}
constexpr int N_PHASES = 34;
__global__ void __launch_bounds__(NTHR, 2) mk_fwd(Args args) {
    extern __shared__ __attribute__((aligned(1024))) unsigned char lds_raw[];
    Frame F0;
    const __attribute__((address_space(4))) Args* kp = (const __attribute__((address_space(4))) Args*)__builtin_amdgcn_kernarg_segment_ptr();
    F0.in = (InPtr)(kp->in); F0.out = kp->out; F0.ws = kp->ws; F0.lds = (LAS unsigned char*)lds_raw;
    F0.tid = threadIdx.x; F0.lane = F0.tid & 63; F0.wave = __builtin_amdgcn_readfirstlane(F0.tid >> 6); F0.G = gridDim.x; F0.vb = blockIdx.x;
    volatile LAS unsigned* misc = (volatile LAS unsigned*)(F0.lds + LDS_MISC);
    if (F0.tid < 4) misc[F0.tid] = 0u;
    __syncthreads();
    XcdBarrier bar; bar.bar = (unsigned*)(F0.ws + WS_CTL); bar.x = 0; bar.st = misc; bar.wave = F0.wave;
#if ONE_LAUNCH
    bar = xcd_barrier_post((unsigned*)(F0.ws + WS_CTL), misc, F0.wave);
#endif
#if ONE_LAUNCH
    int lo = 0, hi = N_PHASES;
#define OPAQUE_RANGE() do { asm volatile("" : "+s"(lo), "+s"(hi)); } while (0)
#else
    const int lo = kp->ph_lo, hi = kp->ph_hi;
#define OPAQUE_RANGE() do { } while (0)
#endif
#ifndef PHASE_MASK
#define PHASE_MASK 0xFFFFFFFFFFull
#endif
#define IN(k) ((((unsigned long long)PHASE_MASK >> (k)) & 1ull) && phase_in(lo, hi, (k)))
#define SEAM(k) do { if (IN(k) && IN((k) + 1)) xcd_barrier_fill(bar, F0, fs); } while (0)
#define INC(k) ((((unsigned long long)PHASE_MASK >> (9 + (k))) & 1ull) && phase_in(lo, hi, pb + (k)))
#define SEAMC(k) do { if (lo <= pb + (k) && pb + (k) + 1 < hi) xcd_barrier_fill(bar, F0, fs); } while (0)

#ifndef REPEAT_MASK
#define REPEAT_MASK 0ull
#endif
#define NREP(k) ((((unsigned long long)REPEAT_MASK >> (k)) & 1ull) ? 2 : 1)
    int fs = 0;
    if (IN(0)) { p_prologue(F0); } SEAM(0);
    if (IN(1)) { p_kv_a(F0); xcd_barrier_fill(bar, F0, fs); p_kv_b(F0, 0); } SEAM(1);
    for (int l = 0; l < 2; ++l) {
        if (l == 0) {
            if (IN(2)) { const Frame F = relaunder(F0); gemm_plain(F, WSP(bf16_t, WS_XB), 1024, WSP(bf16_t, WS_W1CAT), NTOK, 1024, 1024, WSP(bf16_t, WS_U), 1024); } SEAM(2);
            if (IN(3)) { p_pool_hln(F0); } SEAM(3);
            if (IN(4)) { const Frame F = relaunder(F0);
                GemmD g{WSP(bf16_t, WS_PQT), WSP(bf16_t, WS_UN), 128, 512, 128, 128, 128};
                SchedB S = mk_sched(F, 32, 1, 16, 4, 0, (unsigned)256 * 128 * 2, (unsigned)SEQ * 512 * 2, (unsigned)128 * 2, 0, (unsigned)256 * 512 * 2);
                EpiBf16 E{WSP(bf16_t, WS_ZT), 4096, 1, (unsigned)256 * 4096, 0};
                gemm_phase<EpiBf16, SchedB>(F.lds, g, S, E, F.wave);
            } SEAM(4);
            if (IN(5)) { const Frame F = relaunder(F0);
                GemmD g{WSP(bf16_t, WS_W1DFT), WSP(bf16_t, WS_ZT), 128, 64, 128, (unsigned)128 * 4096 * 2, 128};
                SchedB S = mk_sched(F, 32, 1, 32, 1, 0, 0, (unsigned)256 * 4096 * 2, 0, 0, (unsigned)256 * 64 * 2);
                EpiFft1 E{WSP(bf16_t, WS_YP), WSP(float, WS_TW)};
                gemm_phase<EpiFft1, SchedB>(F.lds, g, S, E, F.wave);
            } SEAM(5);
            if (IN(6)) { const Frame F = relaunder(F0);
                GemmD g{WSP(bf16_t, WS_W2DFT), WSP(bf16_t, WS_YP), 128, 128, 128, 128, 128};
                SchedB S = mk_sched(F, 32, 1, 32, 1, 0, 0, (unsigned)8192 * 128 * 2, 0, 0, (unsigned)256 * 128 * 2);
                EpiFft2 E{WSP(bf16_t, WS_YCAT)};
                gemm_phase<EpiFft2, SchedB>(F.lds, g, S, E, F.wave);
            } SEAM(6);
            if (IN(7)) { const Frame F = relaunder(F0); gemm_plain(F, WSP(bf16_t, WS_YCAT), 1024, WSP(bf16_t, WS_PFWOUT), NTOK, 1024, 1024, WSP(bf16_t, WS_H0), 1024); } SEAM(7);
            if (IN(8)) { p_ln<0, false, false>(F0, nullptr, (bf16_t*)(F0.ws + WS_H0), 0, 0); } SEAM(8);
        } else {
            if (IN(19)) { const Frame F = relaunder(F0);
                { GemmD g{WSP(bf16_t, WS_XB), WSP(bf16_t, WS_HGWIN), 1024, 1024, 128, 128, 1024};
                  SchedB S = mk_sched(F, 1, NTOK / 256, 12, 1, 0, 0, 0, 0, (unsigned)256 * 1024 * 2, (unsigned)256 * 1024 * 2);
                  EpiProjA E{WSP(bf16_t, WS_PROJ)};
                  gemm_phase<EpiProjA, SchedB>(F.lds, g, S, E, F.wave); }
                { GemmD g{WSP(bf16_t, WS_XB), WSP(bf16_t, WS_HGWIN) + (size_t)3072 * 1024, 1024, 1024, 128, 128, 1024};
                  SchedB S = mk_sched(F, 1, NTOK / 256, 8, 1, 0, 0, 0, 0, (unsigned)256 * 1024 * 2, (unsigned)256 * 1024 * 2);
                  EpiProjB E{WSP(bf16_t, WS_PROJ), WSP(float, WS_LB1)};
                  gemm_phase<EpiProjB, SchedB>(F.lds, g, S, E, F.wave); }
            } SEAM(19);
            if (IN(20)) { { p_gla(F0); } } SEAM(20);
            if (IN(21)) { p_gate(F0); p_kv_b(F0, 1); } SEAM(21);
            if (IN(22)) { const Frame F = relaunder(F0); gemm_plain(F, WSP(bf16_t, WS_OF), 1024, WSP(bf16_t, WS_HGWOUT), NTOK, 1024, 1024, WSP(bf16_t, WS_OB), 1024); } SEAM(22);
            if (IN(23)) { p_ln<0, false, false>(F0, nullptr, (bf16_t*)(F0.ws + WS_OB), 1, 0); if (F0.G != 256) { __syncthreads(); moe_convert(F0, 1); } } SEAM(23);
        }
        const int pb = l ? 24 : 9;
        if (INC(1)) { const Frame F = relaunder(F0);
            GemmD g{WSP(bf16_t, WS_XB), WSP(bf16_t, WS_KM), 1024, 1024, 128, 128, 1024};
            SchedB S = mk_sched(F, 32, 16, 1, 4, (unsigned)SEQ * 1024 * 2, 0, (unsigned)4 * 256 * 1024 * 2, (unsigned)256 * 1024 * 2, (unsigned)256 * 1024 * 2, 0);
            EpiSoftmax E{WSP(bf16_t, WS_SC), 0.0625f, (LAS float*)(F.lds + STAGE_BYTES)};
            gemm_phase<EpiSoftmax, SchedB>(F.lds, g, S, E, F.wave);
        } SEAMC(1);
        if (INC(3)) { const Frame F = relaunder(F0);
            GemmD g{WSP(bf16_t, WS_SC), WSP(bf16_t, WS_VW), 1024, 1024, 128, 128, 1024};
            SchedB S = mk_sched(F, 8, 16, 4, 1, (unsigned)SEQ * 1024 * 2, 0, (unsigned)1024 * 1024 * 2, 0, (unsigned)256 * 1024 * 2, (unsigned)256 * 1024 * 2);
            EpiBf16 E{WSP(bf16_t, WS_HX), 1024, 1, (unsigned)SEQ * 1024, 0};
            gemm_phase<EpiBf16, SchedB>(F.lds, g, S, E, F.wave);
        } SEAMC(3);
        if (INC(5)) { p_ln<1, false, false>(F0, nullptr, (bf16_t*)(F0.ws + WS_HX), l, 1); } SEAMC(5);
        if (INC(6)) { p_dispatch(F0); } SEAMC(6);
        if (INC(7)) { const Frame F = relaunder(F0);
            const int ntile = __builtin_amdgcn_readfirstlane(WSP(int, WS_TILEEXP)[320]);
            GemmD g{WSP(bf16_t, WS_XB), l ? (bf16_t*)F.out : WSP(bf16_t, WS_WGU), 1024, 1024, 128, 128, 1024};
            SchedMoe<true> S{ntile, 4, F.G, F.vb, WSP(int, WS_TILEEXP), (unsigned)256 * 1024 * 2, (unsigned)256 * 1024 * 2, (unsigned)1048576 * 2, WSP(int, WS_ROWTOK)};
            EpiGU E{WSP(bf16_t, WS_HID)};
            gemm_phase<EpiGU, SchedMoe<true>>(F.lds, g, S, E, F.wave);
            if (l == 0) moe_tail_convert(F, ntile, 0);
        } SEAMC(7);
        if (INC(8)) { const Frame F = relaunder(F0);
            const int ntile = __builtin_amdgcn_readfirstlane(WSP(int, WS_TILEEXP)[320]);
            GemmD g{WSP(bf16_t, WS_HID), l ? (bf16_t*)F.out + (size_t)33554432 : WSP(bf16_t, WS_WDN), 512, 512, 128, 128, 512};
            SchedMoe<false> S{ntile, 4, F.G, F.vb, WSP(int, WS_TILEEXP), (unsigned)256 * 512 * 2, (unsigned)256 * 512 * 2, (unsigned)524288 * 2, nullptr};
            EpiDown E{WSP(bf16_t, WS_XSY), WSP(float, WS_GPOS)};
            gemm_phase<EpiDown, SchedMoe<false>>(F.lds, g, S, E, F.wave);
            if (l == 0) moe_tail_convert(F, ntile, 1);
        } SEAMC(8);
        if (INC(9)) { if (l == 0) p_ln<2, false, false>(F0, nullptr, (bf16_t*)(F0.ws + WS_XSY), l, 2); else p_ln<2, false, true>(F0, nullptr, (bf16_t*)(F0.ws + WS_XSY), l, 2); } SEAMC(9);
    }
#undef IN
#undef SEAM
#undef INC
#undef SEAMC
}

extern "C" void kernel_launch(void* const* d_in, const int* in_sizes, int n_in, void* d_out, int out_size, void* d_ws, size_t ws_size, hipStream_t stream) {
    static int grid = 0;
    if (grid == 0) {
        if (n_in != 24 || out_size != NTOK * DM || ws_size < WS_END) { fprintf(stderr, "kernel_launch: unexpected shapes (n_in %d, out %d, ws %zu, need %zu)\n", n_in, out_size, ws_size, (size_t)WS_END); grid = -1; return; }
        int dev = 0, cus = 0;
        if (hipGetDevice(&dev) != hipSuccess || hipDeviceGetAttribute(&cus, hipDeviceAttributeMultiprocessorCount, dev) != hipSuccess) { grid = -1; return; }
        if (hipFuncSetAttribute((const void*)mk_fwd, hipFuncAttributeMaxDynamicSharedMemorySize, LDS_BYTES) != hipSuccess) { fprintf(stderr, "kernel_launch: hipFuncSetAttribute failed\n"); grid = -1; return; }
        int per_cu = 0;
        if (hipOccupancyMaxActiveBlocksPerMultiprocessor(&per_cu, (const void*)mk_fwd, NTHR, LDS_BYTES) != hipSuccess || per_cu < 1) fprintf(stderr, "kernel_launch: occupancy query reports %d\n", per_cu);
        (void)hipGetLastError();
        grid = cus;
    }
    if (grid < 0) return;
    (void)hipMemsetAsync((char*)d_ws + WS_CTL, 0, CTL_ZERO_BYTES, stream);
    Args a{};
    for (int i = 0; i < 24; ++i) a.in[i] = (const float*)d_in[i];
    a.out = (float*)d_out; a.ws = (unsigned char*)d_ws;
#if ONE_LAUNCH
    a.ph_lo = 0; a.ph_hi = N_PHASES;
    hipLaunchKernelGGL(mk_fwd, dim3(grid), dim3(NTHR), LDS_BYTES, stream, a);
#else
    for (int p = 0; p < N_PHASES; ++p) { a.ph_lo = p; a.ph_hi = p + 1; hipLaunchKernelGGL(mk_fwd, dim3(grid), dim3(NTHR), LDS_BYTES, stream, a); }
#endif
}
```

```cpp
#include <hip/hip_runtime.h>
#include <stdint.h>
#include <stdio.h>

#ifndef ONE_LAUNCH
#define ONE_LAUNCH 1
#endif

#define LAS __attribute__((address_space(3)))
typedef unsigned short bf16_t;
typedef short bf16x8 __attribute__((ext_vector_type(8)));
typedef float f32x4 __attribute__((ext_vector_type(4)));
typedef float f32x2 __attribute__((ext_vector_type(2)));
typedef unsigned u32x4 __attribute__((ext_vector_type(4)));
typedef unsigned u32x2 __attribute__((ext_vector_type(2)));

constexpr int NB = 8, SEQ = 4096, DM = 1024, NTOK = NB * SEQ, MEML = 256;
constexpr float DN_ALPHA = 1.4142135623730951f;
constexpr float LN_EPS = 1e-5f;
constexpr int NTHR = 512;
constexpr int LDS_BYTES = 163840;
constexpr int LDS_MISC = 160 * 1024 - 256;

constexpr size_t KiB = 1024, MiB = 1024 * 1024;
constexpr size_t WS_CTL = 0;
constexpr size_t CTL_ZERO_BYTES = 16 * KiB;
constexpr size_t WS_W1DFT = 64 * KiB, WS_W2DFT = 128 * KiB, WS_TW = 192 * KiB, WS_PQT = 256 * KiB, WS_LB1 = 512 * KiB;
constexpr size_t WS_HIST = 576 * KiB, WS_TILEEXP = 640 * KiB;
constexpr size_t WS_ROWTOK = 2 * MiB + 512 * KiB;
constexpr size_t WS_TOKE = 1 * MiB, WS_TOKG = 1 * MiB + 256 * KiB, WS_POSS = 1 * MiB + 512 * KiB, WS_GPOS = 2 * MiB;
constexpr size_t WS_W1CAT = 4 * MiB, WS_PFWOUT = 6 * MiB, WS_HGWIN = 8 * MiB, WS_HGWOUT = 18 * MiB;
constexpr size_t WS_WQN1 = 20 * MiB, WS_WOT1 = 22 * MiB, WS_KB1 = 24 * MiB, WS_VB1 = 28 * MiB, WS_KM = 32 * MiB, WS_VW = 48 * MiB, WS_XB = 64 * MiB;
constexpr size_t ARENA = 128 * MiB;
constexpr size_t WS_WGU = ARENA, WS_WDN = ARENA + 64 * MiB;
constexpr size_t ACT = ARENA + 96 * MiB;
constexpr size_t WS_WK = ACT, WS_WV = ACT + 4 * MiB, WS_MEMBF = ACT + 8 * MiB, WS_WQN0 = ACT + 12 * MiB, WS_WOT0 = ACT + 14 * MiB, WS_KB0 = ACT + 16 * MiB, WS_VB0 = ACT + 20 * MiB;
constexpr size_t WS_U = ACT, WS_UN = ACT + 64 * MiB, WS_YCAT = ACT + 96 * MiB, WS_ZT = ACT + 160 * MiB, WS_YP = ACT + 224 * MiB, WS_H0 = ACT;
constexpr size_t WS_SC = ACT, WS_HX = ACT + 64 * MiB;
constexpr size_t WS_XSY = ACT, WS_HID = ACT + 144 * MiB;
constexpr size_t WS_PROJ = ARENA, WS_OF = ARENA + 320 * MiB, WS_OB = ARENA + 384 * MiB;
constexpr size_t WS_END = ARENA + 448 * MiB;
constexpr int MPAD_MAX = 73728;

__device__ __forceinline__ float bf2f(bf16_t b) { return __uint_as_float(((unsigned)b) << 16); }
typedef __bf16 bf16x2_t __attribute__((ext_vector_type(2)));
__device__ __forceinline__ unsigned cvt_pk_bf16(float lo, float hi) { const bf16x2_t v = __builtin_convertvector((f32x2){lo, hi}, bf16x2_t); return __builtin_bit_cast(unsigned, v); }
__device__ __forceinline__ bf16_t f2bf(float f) { return (bf16_t)(cvt_pk_bf16(f, 0.f) & 0xffffu); }
__device__ __forceinline__ float lo_bf(unsigned w) { return __uint_as_float(w << 16); }
__device__ __forceinline__ float hi_bf(unsigned w) { return __uint_as_float(w & 0xffff0000u); }
__device__ __forceinline__ float fast_sigmoid(float p) { return __builtin_amdgcn_rcpf(1.0f + __builtin_amdgcn_exp2f(p * -1.4426950408889634f)); }
#define GAS __attribute__((address_space(1)))
template <class V> __device__ __forceinline__ void gstore(void* p, const V v) { *(GAS V*)p = v; }
__device__ __forceinline__ void gstore_wt(void* p, const u32x4 v) { asm volatile("global_store_dwordx4 %0, %1, off sc1\n\ts_nop 1" :: "v"(p), "v"(v) : "memory"); }
template <class V> __device__ __forceinline__ V gload(const void* p) { return *(const GAS V*)p; }
__device__ __forceinline__ float wave_sum(float v) {
#pragma unroll
    for (int o = 32; o >= 1; o >>= 1) v += __shfl_xor(v, o);
    return v;
}
__device__ __forceinline__ float wave_max(float v) {
#pragma unroll
    for (int o = 32; o >= 1; o >>= 1) v = fmaxf(v, __shfl_xor(v, o));
    return v;
}

#define XB_TMO      128
#define XB_XCNT(j)  (256  + 64 * (j))
#define XB_XSUB(j)  (1280 + 64 * (j))
#define XB_XGEN(j)  (2304 + 64 * (j))
#define XB_TOP      3328
#define XB_TOPGEN   3392
#define XCD_BAR_WORDS 3456
#define XB_REDEAL 3456
#define XB_SPIN_CAP (1u << 22)

__device__ __forceinline__ unsigned xb_ld(unsigned* p)              { return __hip_atomic_load(p, __ATOMIC_RELAXED, __HIP_MEMORY_SCOPE_AGENT); }
__device__ __forceinline__ unsigned xb_add(unsigned* p, unsigned v) { return __hip_atomic_fetch_add(p, v, __ATOMIC_RELAXED, __HIP_MEMORY_SCOPE_AGENT); }
__device__ __forceinline__ unsigned xb_xcc_id() { return (unsigned)__builtin_amdgcn_s_getreg((3 << 11) | 20) & 0xFu; }
#define XB_SPIN(cond, bar) do { unsigned _sp = 0; while (cond) { __builtin_amdgcn_s_sleep(1); \
    if ((++_sp & 255u) == 0u) { if (xb_ld(&(bar)[XB_TMO])) break; if (_sp > XB_SPIN_CAP) { atomicAdd(&(bar)[XB_TMO], 1u); break; } } } } while (0)

struct XcdBarrier { unsigned* bar; unsigned x; volatile LAS unsigned* st; int wave; };

__device__ __forceinline__ XcdBarrier xcd_barrier_post(unsigned* bar, volatile LAS unsigned* st, int wave_id) {
    XcdBarrier b; b.bar = bar; b.x = xb_xcc_id(); b.st = st; b.wave = wave_id;
    if (wave_id == 0 && __builtin_amdgcn_mbcnt_hi(~0u, __builtin_amdgcn_mbcnt_lo(~0u, 0u)) == 0u) (void)xb_add(&bar[XB_XCNT(b.x)], 1u);
    return b;
}
__device__ __forceinline__ void xcd_barrier_complete(unsigned* bar, unsigned x, unsigned& nloc, unsigned& nx) {
    const unsigned G = gridDim.x * gridDim.y * gridDim.z;
    unsigned sum, cnt, mine, sp = 0u;
    for (;;) {
        sum = 0u; cnt = 0u; mine = 0u;
#pragma unroll
        for (unsigned j = 0; j < 16; ++j) { const unsigned c = xb_ld(&bar[XB_XCNT(j)]); sum += c; cnt += (c > 0u) ? 1u : 0u; mine = (j == x) ? c : mine; }
        if (sum == G) break;
        __builtin_amdgcn_s_sleep(1);
        if ((++sp & 255u) == 0u) { if (xb_ld(&bar[XB_TMO])) break; if (sp > XB_SPIN_CAP) { atomicAdd(&bar[XB_TMO], 1u); break; } }
    }
    nloc = mine > 0u ? mine : 1u; nx = cnt > 0u ? cnt : 1u;
}
__device__ __forceinline__ void xcd_barrier_core(const XcdBarrier& b) {
    if (b.wave == 0 && __builtin_amdgcn_mbcnt_hi(~0u, __builtin_amdgcn_mbcnt_lo(~0u, 0u)) == 0u) {
        unsigned* bar = b.bar;
        __builtin_amdgcn_s_waitcnt(0);
        unsigned nloc = b.st[0], nx = b.st[1];
        if (nloc == 0u) { xcd_barrier_complete(bar, b.x, nloc, nx); b.st[0] = nloc; b.st[1] = nx; }
        const unsigned old = xb_add(&bar[XB_XSUB(b.x)], 1u);
        const unsigned gen = old / nloc;
        if (old + 1u == (gen + 1u) * nloc) {
            __builtin_amdgcn_fence(__ATOMIC_RELEASE, "agent");
            asm volatile("s_waitcnt vmcnt(0)" ::: "memory");
            const unsigned og = xb_add(&bar[XB_TOP], 1u);
            const unsigned tg = og / nx;
            if (og + 1u == (tg + 1u) * nx) xb_add(&bar[XB_TOPGEN], 1u);
            else XB_SPIN(xb_ld(&bar[XB_TOPGEN]) == tg, bar);
            __builtin_amdgcn_fence(__ATOMIC_ACQUIRE, "agent");
            xb_add(&bar[XB_XGEN(b.x)], 1u);
            asm volatile("s_waitcnt vmcnt(0)" ::: "memory");
        } else {
            XB_SPIN(xb_ld(&bar[XB_XGEN(b.x)]) == gen, bar);
            __builtin_amdgcn_fence(__ATOMIC_ACQUIRE, "agent");
            asm volatile("s_waitcnt vmcnt(0)" ::: "memory");
        }
    }
}
__device__ __forceinline__ void xcd_barrier(const XcdBarrier& b) {
    asm volatile("s_waitcnt vmcnt(0)" ::: "memory");
    __syncthreads();
    xcd_barrier_core(b);
    __syncthreads();
}

constexpr int BM = 256, BK = 64, HALF = 128, HTB = HALF * BK * 2, STAGE_BYTES = 8 * HTB, NXCD = 8, WGM = 8;

__device__ __forceinline__ int lds_byte(int r, int c) { const int st = (r >> 4) * 2 + (c >> 5), rr = r & 15, cc = c & 31, ob = rr * 64 + cc * 2; return st * 1024 + (ob ^ (((ob >> 9) & 1) << 5)); }
__device__ __forceinline__ void stage_rc(int b, int& R, int& C) { const int st = b / 1024, sb = b % 1024, swz = sb ^ (((sb >> 9) & 1) << 5); R = (st >> 1) * 16 + swz / 64; C = (st & 1) * 32 + (swz % 64) / 2; }
__device__ __forceinline__ int perm32(int rho) { const int n = rho >> 4, i = rho & 15; return 8 * (i >> 2) + 4 * n + (i & 3); }

struct GemmD { const bf16_t* A; const bf16_t* B; int lda, ldb; unsigned kstepA, kstepB; int K; };
struct Unit { int pm, pn, b; unsigned offA, offB; };

struct SchedB {
    static constexpr bool GATHER = false;
    int nM, nN, nB, G, c, bdiv; unsigned bsA_hi, bsA_lo, bsB_hi, bsB_lo, tsA, tsB;
    __device__ __forceinline__ bool next(int i, Unit& u) const {
        const int nMt = nB * nM, nwg = nMt * nN;
        const long L = (unsigned)i * G + c; if (L >= nwg) return false;
        int wgid = (int)L; { const int q = nwg / NXCD, r = nwg % NXCD, xcd = wgid % NXCD, off = wgid / NXCD; wgid = (xcd < r ? xcd * (q + 1) : r * (q + 1) + (xcd - r) * q) + off; }
        const int nig = WGM * nN, gid = wgid / nig, fm = gid * WGM, gsz = (nMt - fm) < WGM ? (nMt - fm) : WGM;
        const int pmt = fm + ((wgid % nig) % gsz); u.pn = (wgid % nig) / gsz;
        u.b = pmt / nM; u.pm = pmt - u.b * nM;
        const int hi = u.b / bdiv, lo = u.b - hi * bdiv;
        u.offA = (unsigned)hi * bsA_hi + (unsigned)lo * bsA_lo + (unsigned)u.pm * tsA; u.offB = (unsigned)hi * bsB_hi + (unsigned)lo * bsB_lo + (unsigned)u.pn * tsB;
        return true;
    }
};
template <bool GATHER_>
struct SchedMoe {
    static constexpr bool GATHER = GATHER_;
    int nM, nN, G, c; const int* tile_exp; unsigned tsA, tsB, esB; const int* rowtok;
    __device__ __forceinline__ bool next(int i, Unit& u) const {
        const int nwg = nM * nN;
        const long L = (unsigned)i * G + c; if (L >= nwg) return false;
        int wgid = (int)L; { const int q = nwg / NXCD, r = nwg % NXCD, xcd = wgid % NXCD, off = wgid / NXCD; wgid = (xcd < r ? xcd * (q + 1) : r * (q + 1) + (xcd - r) * q) + off; }
        const int nig = WGM * nN, gid = wgid / nig, fm = gid * WGM, gsz = (nM - fm) < WGM ? (nM - fm) : WGM;
        u.pm = fm + ((wgid % nig) % gsz); u.pn = (wgid % nig) / gsz;
        u.b = __builtin_amdgcn_readfirstlane(tile_exp[u.pm]);
        u.offA = (unsigned)u.pm * tsA; u.offB = (unsigned)u.b * esB + (unsigned)u.pn * tsB;
        return true;
    }
};

template <bool GATHER_>
struct SchedMoeLim {
    static constexpr bool GATHER = GATHER_;
    SchedMoe<GATHER_> S; int lim; const int* rowtok = nullptr;
    __device__ __forceinline__ bool next(int i, Unit& u) const { if ((long)i * S.G + S.c >= lim) return false; return S.next(i, u); }
};
__device__ __forceinline__ bool moe_redeal(int ntile, int G) { const int nun = ntile * 4, R = nun / G, rem = nun - R * G; return G == 256 && rem > 0 && 3 * rem <= G && R >= 2; }
template <bool GATHER_>
struct SchedMoeTwo {
    static constexpr bool GATHER = GATHER_;
    int nM0, nN, code0, code1; const int* tile_exp; unsigned tsA, tsB, esB; const int* rowtok;
    __device__ __forceinline__ bool next(int i, Unit& u) const {
        if (i > 1) return false;
        const int code = i ? code1 : code0; if (code == -1) return false;
        if (code >= 0) {
            const int nwg = nM0 * nN;
            int wgid = code; { const int q = nwg / NXCD, r = nwg % NXCD, xcd = wgid % NXCD, off = wgid / NXCD; wgid = (xcd < r ? xcd * (q + 1) : r * (q + 1) + (xcd - r) * q) + off; }
            const int nig = WGM * nN, gid = wgid / nig, fm = gid * WGM, gsz = (nM0 - fm) < WGM ? (nM0 - fm) : WGM;
            u.pm = fm + ((wgid % nig) % gsz); u.pn = (wgid % nig) / gsz;
        } else { const int k = -2 - code; u.pm = nM0 + k / nN; u.pn = k % nN; }
        u.b = __builtin_amdgcn_readfirstlane(tile_exp[u.pm]);
        u.offA = (unsigned)u.pm * tsA; u.offB = (unsigned)u.b * esB + (unsigned)u.pn * tsB;
        return true;
    }
};
struct EpiBf16 {
    static constexpr bool PERM = true;
    bf16_t* O; int ldc; int bdiv; unsigned bs_hi, bs_lo;
    __device__ __forceinline__ void operator()(f32x4 (&acc)[2][2][4][2], const Unit& u, int wr, int wc, int fr_, int fq_) const {
        int fr = fr_, fq = fq_; asm volatile("" : "+v"(fr), "+v"(fq));
        const int hi = u.b / bdiv, lo = u.b - hi * bdiv;
        bf16_t* base = O + (size_t)((unsigned)hi * bs_hi + (unsigned)lo * bs_lo);
        const int row0 = u.pm * BM + wr * 64 + fr, col0 = u.pn * BM + wc * 32 + 8 * fq;
#pragma unroll
        for (int ai = 0; ai < 2; ++ai)
#pragma unroll
            for (int m = 0; m < 4; ++m) { bf16_t* rowp = base + (size_t)(row0 + ai * HALF + m * 16) * ldc + col0;
#pragma unroll
                for (int bj = 0; bj < 2; ++bj) { const f32x4 v0 = acc[ai][bj][m][0], v1 = acc[ai][bj][m][1];
                    u32x4 w; w.x = cvt_pk_bf16(v0[0], v0[1]); w.y = cvt_pk_bf16(v0[2], v0[3]); w.z = cvt_pk_bf16(v1[0], v1[1]); w.w = cvt_pk_bf16(v1[2], v1[3]);
                    gstore<u32x4>(rowp + bj * HALF, w); } }
    }
};
struct EpiSoftmax {
    static constexpr bool PERM = true;
    bf16_t* P; float scale; LAS float* ex;
    __device__ __forceinline__ void operator()(f32x4 (&acc)[2][2][4][2], const Unit& u, int wr, int wc, int fr_, int fq_) const {
        int fr = fr_, fq = fq_; asm volatile("" : "+v"(fr), "+v"(fq));
#pragma unroll
        for (int ai = 0; ai < 2; ++ai)
#pragma unroll
            for (int m = 0; m < 4; ++m) {
                float mx = -3.0e38f;
#pragma unroll
                for (int bj = 0; bj < 2; ++bj)
#pragma unroll
                    for (int n = 0; n < 2; ++n) { acc[ai][bj][m][n] = acc[ai][bj][m][n] * scale; const f32x4 x = acc[ai][bj][m][n]; mx = fmaxf(mx, fmaxf(fmaxf(x[0], x[1]), fmaxf(x[2], x[3]))); }
                mx = fmaxf(mx, __shfl_xor(mx, 16)); mx = fmaxf(mx, __shfl_xor(mx, 32));
                float sm = 0.f;
#pragma unroll
                for (int bj = 0; bj < 2; ++bj)
#pragma unroll
                    for (int n = 0; n < 2; ++n) { f32x4 x = acc[ai][bj][m][n]; x[0] = __expf(x[0] - mx); x[1] = __expf(x[1] - mx); x[2] = __expf(x[2] - mx); x[3] = __expf(x[3] - mx); acc[ai][bj][m][n] = x; sm += (x[0] + x[1]) + (x[2] + x[3]); }
                sm += __shfl_xor(sm, 16); sm += __shfl_xor(sm, 32);
                if (fq == 0) *(LAS f32x2*)(ex + ((ai * HALF + wr * 64 + m * 16 + fr) * 4 + wc) * 2) = (f32x2){mx, sm};
            }
        asm volatile("s_waitcnt lgkmcnt(0)" ::: "memory"); __builtin_amdgcn_s_barrier(); asm volatile("" ::: "memory");
        bf16_t* base = P + ((size_t)(u.b >> 2) * SEQ + (size_t)(u.pm * BM + wr * 64 + fr)) * 1024 + (u.b & 3) * 256 + wc * 32 + 8 * fq;
#pragma unroll
        for (int ai = 0; ai < 2; ++ai)
#pragma unroll
            for (int m = 0; m < 4; ++m) {
                const LAS float* ep = ex + (ai * HALF + wr * 64 + m * 16 + fr) * 8;
                const f32x4 a = *(const LAS f32x4*)ep, b = *(const LAS f32x4*)(ep + 4);
                const float M = fmaxf(fmaxf(a[0], a[2]), fmaxf(b[0], b[2]));
                const float tot = a[1] * __expf(a[0] - M) + a[3] * __expf(a[2] - M) + b[1] * __expf(b[0] - M) + b[3] * __expf(b[2] - M);
                const float f = __expf(ep[2 * wc] - M) / tot;
                bf16_t* rowp = base + (size_t)(ai * HALF + m * 16) * 1024;
#pragma unroll
                for (int bj = 0; bj < 2; ++bj) { const f32x4 v0 = acc[ai][bj][m][0] * f, v1 = acc[ai][bj][m][1] * f;
                    u32x4 w; w.x = cvt_pk_bf16(v0[0], v0[1]); w.y = cvt_pk_bf16(v0[2], v0[3]); w.z = cvt_pk_bf16(v1[0], v1[1]); w.w = cvt_pk_bf16(v1[2], v1[3]);
                    gstore<u32x4>(rowp + bj * HALF, w); }
            }
    }
};
struct EpiFft1 {
    static constexpr bool PERM = true;
    bf16_t* Y; const float* tw;
    __device__ __forceinline__ void operator()(f32x4 (&acc)[2][2][4][2], const Unit& u, int wr, int wc, int fr_, int fq_) const {
        int fr = fr_, fq = fq_; asm volatile("" : "+v"(fr), "+v"(fq));
        bf16_t* base = Y + (size_t)u.b * (64 * 128 * 2 * 64);
#pragma unroll
        for (int bj = 0; bj < 2; ++bj) {
            const int c0 = u.pn * BM + bj * HALF + wc * 32 + 8 * fq, d = c0 >> 6, a0 = c0 & 63;
#pragma unroll
            for (int hf = 0; hf < 2; ++hf) {
                const int e = 32 * wr + 16 * hf + fr;
                const float* twp = tw + ((size_t)e * 64 + a0) * 2;
                const f32x4 t0 = gload<f32x4>(twp), t1 = gload<f32x4>(twp + 4), t2 = gload<f32x4>(twp + 8), t3 = gload<f32x4>(twp + 12);
                const f32x4 re0 = acc[0][bj][hf][0], re1 = acc[0][bj][hf][1], im0 = acc[0][bj][hf + 2][0], im1 = acc[0][bj][hf + 2][1];
                float yr[8], yi[8];
                yr[0] = re0[0] * t0[0] - im0[0] * t0[1]; yi[0] = re0[0] * t0[1] + im0[0] * t0[0];
                yr[1] = re0[1] * t0[2] - im0[1] * t0[3]; yi[1] = re0[1] * t0[3] + im0[1] * t0[2];
                yr[2] = re0[2] * t1[0] - im0[2] * t1[1]; yi[2] = re0[2] * t1[1] + im0[2] * t1[0];
                yr[3] = re0[3] * t1[2] - im0[3] * t1[3]; yi[3] = re0[3] * t1[3] + im0[3] * t1[2];
                yr[4] = re1[0] * t2[0] - im1[0] * t2[1]; yi[4] = re1[0] * t2[1] + im1[0] * t2[0];
                yr[5] = re1[1] * t2[2] - im1[1] * t2[3]; yi[5] = re1[1] * t2[3] + im1[1] * t2[2];
                yr[6] = re1[2] * t3[0] - im1[2] * t3[1]; yi[6] = re1[2] * t3[1] + im1[2] * t3[0];
                yr[7] = re1[3] * t3[2] - im1[3] * t3[3]; yi[7] = re1[3] * t3[3] + im1[3] * t3[2];
                bf16_t* p = base + (((size_t)e * 128 + d) * 2) * 64 + a0;
                u32x4 wr4, wi4;
                wr4.x = cvt_pk_bf16(yr[0], yr[1]); wr4.y = cvt_pk_bf16(yr[2], yr[3]); wr4.z = cvt_pk_bf16(yr[4], yr[5]); wr4.w = cvt_pk_bf16(yr[6], yr[7]);
                wi4.x = cvt_pk_bf16(yi[0], yi[1]); wi4.y = cvt_pk_bf16(yi[2], yi[3]); wi4.z = cvt_pk_bf16(yi[4], yi[5]); wi4.w = cvt_pk_bf16(yi[6], yi[7]);
                gstore<u32x4>(p, wr4); gstore<u32x4>(p + 64, wi4);
            }
        }
    }
};
struct EpiFft2 {
    static constexpr bool PERM = true;
    bf16_t* Yc;
    __device__ __forceinline__ void operator()(f32x4 (&acc)[2][2][4][2], const Unit& u, int wr, int wc, int fr_, int fq_) const {
        int fr = fr_, fq = fq_; asm volatile("" : "+v"(fr), "+v"(fq));
        if (wr != 0) return;
        const int b = u.b >> 2, h = u.b & 3;
#pragma unroll
        for (int bj = 0; bj < 2; ++bj) {
            const int n0 = u.pn * BM + bj * HALF + wc * 32 + 8 * fq, e = n0 >> 7, d0 = n0 & 127;
#pragma unroll
            for (int m = 0; m < 4; ++m) {
                const int c = 16 * m + fr, sp = 64 * c + e;
                bf16_t* p = Yc + ((size_t)(b * SEQ + sp)) * DM + 512 + h * 128 + d0;
                const f32x4 v0 = acc[0][bj][m][0], v1 = acc[0][bj][m][1];
                u32x4 w; w.x = cvt_pk_bf16(v0[0], v0[1]); w.y = cvt_pk_bf16(v0[2], v0[3]); w.z = cvt_pk_bf16(v1[0], v1[1]); w.w = cvt_pk_bf16(v1[2], v1[3]);
                *(u32x4*)p = w;
            }
        }
    }
};
template <bool WT>
struct EpiGU {
    static constexpr bool PERM = true;
    bf16_t* Hd;
    unsigned* cnt;
    __device__ __forceinline__ void operator()(f32x4 (&acc)[2][2][4][2], const Unit& u, int wr, int wc, int fr_, int fq_) const {
        int fr = fr_, fq = fq_; asm volatile("" : "+v"(fr), "+v"(fq));
        const int row0 = u.pm * BM + wr * 64 + fr, col0 = u.pn * 128 + wc * 32 + 8 * fq;
#pragma unroll
        for (int ai = 0; ai < 2; ++ai)
#pragma unroll
            for (int m = 0; m < 4; ++m) {
                float o[8];
#pragma unroll
                for (int n = 0; n < 2; ++n)
#pragma unroll
                    for (int j = 0; j < 4; ++j) { const float g = acc[ai][0][m][n][j], up = acc[ai][1][m][n][j]; o[n * 4 + j] = g * fast_sigmoid(g) * up; }
                u32x4 w; w.x = cvt_pk_bf16(o[0], o[1]); w.y = cvt_pk_bf16(o[2], o[3]); w.z = cvt_pk_bf16(o[4], o[5]); w.w = cvt_pk_bf16(o[6], o[7]);
                if constexpr (WT) gstore_wt(Hd + (size_t)(row0 + ai * HALF + m * 16) * 512 + col0, w); else gstore<u32x4>(Hd + (size_t)(row0 + ai * HALF + m * 16) * 512 + col0, w);
            }
        if constexpr (WT) { asm volatile("s_waitcnt vmcnt(0)" ::: "memory"); if ((fr | fq) == 0) (void)xb_add(cnt, 1u); }
    }
};
struct EpiDown {
    static constexpr bool PERM = true;
    bf16_t* Y; const float* gpos;
    __device__ __forceinline__ void operator()(f32x4 (&acc)[2][2][4][2], const Unit& u, int wr, int wc, int fr_, int fq_) const {
        int fr = fr_, fq = fq_; asm volatile("" : "+v"(fr), "+v"(fq));
        const int row0 = u.pm * BM + wr * 64 + fr, col0 = u.pn * BM + wc * 32 + 8 * fq;
#pragma unroll
        for (int ai = 0; ai < 2; ++ai)
#pragma unroll
            for (int m = 0; m < 4; ++m) { const int row = row0 + ai * HALF + m * 16; const float gt = gpos[row]; bf16_t* rowp = Y + (size_t)row * DM + col0;
#pragma unroll
                for (int bj = 0; bj < 2; ++bj) { const f32x4 v0 = acc[ai][bj][m][0] * gt, v1 = acc[ai][bj][m][1] * gt;
                    u32x4 w; w.x = cvt_pk_bf16(v0[0], v0[1]); w.y = cvt_pk_bf16(v0[2], v0[3]); w.z = cvt_pk_bf16(v1[0], v1[1]); w.w = cvt_pk_bf16(v1[2], v1[3]);
                    gstore<u32x4>(rowp + bj * HALF, w); } }
    }
};
struct EpiProjA {
    static constexpr bool PERM = true;
    bf16_t* P;
    __device__ __forceinline__ void operator()(f32x4 (&acc)[2][2][4][2], const Unit& u, int wr, int wc, int fr_, int fq_) const {
        int fr = fr_, fq = fq_; asm volatile("" : "+v"(fr), "+v"(fq));
        const int sec = u.pn >> 2;
        const int row0 = u.pm * BM + wr * 64 + fr, col0 = (sec == 2 ? 4096 : sec * 1024) + (u.pn & 3) * BM + wc * 32 + 8 * fq;
        if (sec == 1) {
#pragma unroll
            for (int ai = 0; ai < 2; ++ai)
#pragma unroll
                for (int m = 0; m < 4; ++m) { bf16_t* rowp = P + (size_t)(row0 + ai * HALF + m * 16) * 5120 + col0;
#pragma unroll
                    for (int bj = 0; bj < 2; ++bj) { const f32x4 v0 = acc[ai][bj][m][0], v1 = acc[ai][bj][m][1];
                        u32x4 w; w.x = cvt_pk_bf16(v0[0], v0[1]); w.y = cvt_pk_bf16(v0[2], v0[3]); w.z = cvt_pk_bf16(v1[0], v1[1]); w.w = cvt_pk_bf16(v1[2], v1[3]);
                        gstore<u32x4>(rowp + bj * HALF, w); } }
        } else {
#pragma unroll
            for (int ai = 0; ai < 2; ++ai)
#pragma unroll
                for (int m = 0; m < 4; ++m) { bf16_t* rowp = P + (size_t)(row0 + ai * HALF + m * 16) * 5120 + col0;
#pragma unroll
                    for (int bj = 0; bj < 2; ++bj) {
                        float o[8];
#pragma unroll
                        for (int n = 0; n < 2; ++n)
#pragma unroll
                            for (int j = 0; j < 4; ++j) { const float p = acc[ai][bj][m][n][j]; o[n * 4 + j] = p * fast_sigmoid(p); }
                        u32x4 w; w.x = cvt_pk_bf16(o[0], o[1]); w.y = cvt_pk_bf16(o[2], o[3]); w.z = cvt_pk_bf16(o[4], o[5]); w.w = cvt_pk_bf16(o[6], o[7]);
                        gstore<u32x4>(rowp + bj * HALF, w); } }
        }
    }
};
struct EpiProjB {
    static constexpr bool PERM = true;
    bf16_t* P; const float* lb;
    __device__ __forceinline__ void operator()(f32x4 (&acc)[2][2][4][2], const Unit& u, int wr, int wc, int fr_, int fq_) const {
        int fr = fr_, fq = fq_; asm volatile("" : "+v"(fr), "+v"(fq));
        const int row0 = u.pm * BM + wr * 64 + fr, col0 = u.pn * BM + wc * 32 + 8 * fq;
        float lbv[2][8];
#pragma unroll
        for (int bj = 0; bj < 2; ++bj) { const float* lp = lb + col0 + bj * HALF; const f32x4 l0 = *(const f32x4*)lp, l1 = gload<f32x4>(lp + 4);
#pragma unroll
            for (int j = 0; j < 4; ++j) { lbv[bj][j] = l0[j]; lbv[bj][4 + j] = l1[j]; } }
#pragma unroll
        for (int ai = 0; ai < 2; ++ai)
#pragma unroll
            for (int m = 0; m < 4; ++m) { bf16_t* rowp = P + (size_t)(row0 + ai * HALF + m * 16) * 5120 + 2048 + col0;
#pragma unroll
                for (int bj = 0; bj < 2; ++bj) {
                    float o[8];
#pragma unroll
                    for (int n = 0; n < 2; ++n)
#pragma unroll
                        for (int j = 0; j < 4; ++j) { const float sg = fast_sigmoid(acc[ai][bj][m][n][j]); o[n * 4 + j] = __builtin_amdgcn_logf(sg + lbv[bj][n * 4 + j] * (1.0f - sg)); }
                    u32x4 w; w.x = cvt_pk_bf16(o[0], o[1]); w.y = cvt_pk_bf16(o[2], o[3]); w.z = cvt_pk_bf16(o[4], o[5]); w.w = cvt_pk_bf16(o[6], o[7]);
                    gstore<u32x4>(rowp + bj * HALF, w); } }
    }
};

template <class Epi, class Sched>
__device__ __forceinline__ void gemm_phase(LAS unsigned char* lds, const GemmD g, const Sched& S, const Epi& E, const int wave_id) {
    int lane_ = (int)__builtin_amdgcn_mbcnt_hi(~0u, __builtin_amdgcn_mbcnt_lo(~0u, 0u)); asm volatile("" : "+v"(lane_));
    const int lane = lane_, wid = wave_id, tid = wid * 64 + lane, wr = wid >> 2, wc = wid & 3, fr = lane & 15, fq = lane >> 4;
    const int nt = g.K / BK;
    unsigned voffA[2], voffB[2];
#pragma unroll
    for (int i = 0; i < 2; ++i) { int R, C; stage_rc(tid * 16 + i * 8192, R, C); const int Rb = Epi::PERM ? ((R & ~31) + perm32(R & 31)) : R;
        voffA[i] = (unsigned)(R * g.lda + C) * 2u; voffB[i] = (unsigned)(Rb * g.ldb + C) * 2u; }
    const unsigned kstepA = g.kstepA, kstepB = g.kstepB;
    const unsigned hstepA = (unsigned)HALF * g.lda * 2, hstepB = (unsigned)HALF * g.ldb * 2;
    unsigned gcur[2][2], gnxt[2][2]; int gR[2], gC[2];
#pragma unroll
    for (int i = 0; i < 2; ++i) { stage_rc(tid * 16 + i * 8192, gR[i], gC[i]); }
#define PG8_GLOAD(dst, pm_) do { if constexpr (Sched::GATHER) { _Pragma("unroll") for (int h_ = 0; h_ < 2; ++h_) _Pragma("unroll") for (int i_ = 0; i_ < 2; ++i_) \
        dst[h_][i_] = (unsigned)S.rowtok[(pm_) * BM + h_ * HALF + gR[i_]] * (unsigned)(g.lda * 2) + (unsigned)gC[i_] * 2u; } } while (0)
#define PG8_STAGE_A(b, h, pn_, pg_, gv_) do { if constexpr (Sched::GATHER) PG8_STAGE(PG8_SA(b, h), pg_, gv_); else PG8_STAGE(PG8_SA(b, h), pn_, voffA); } while (0)
    const unsigned ldsw = (unsigned)wid * 1024u;
    const int aoff = lds_byte(wr * 64 + fr, fq * 8), boff = lds_byte(wc * 32 + fr, fq * 8);
#define PG8_SA(b, h) (((b) * 2 + (h)) * HTB)
#define PG8_SB(b, h) ((4 + (b) * 2 + (h)) * HTB)
#define PG8_STAGE(bufoff, gbase, voff) do { _Pragma("unroll") for (int _i = 0; _i < 2; ++_i) \
        __builtin_amdgcn_global_load_lds((const unsigned*)((const char*)(gbase) + (voff)[_i]), (LAS unsigned*)(lds + (bufoff) + ldsw + _i * 8192), 16, 0, 0); } while (0)
#define PG8_LDA(dst, b, h) do { _Pragma("unroll") for (int m = 0; m < 4; ++m) _Pragma("unroll") for (int k = 0; k < 2; ++k) dst[m][k] = *(const LAS bf16x8*)(lds + PG8_SA(b, h) + aoff + m * 2048 + k * 1024); } while (0)
#define PG8_LDB(dst, b, h) do { _Pragma("unroll") for (int n = 0; n < 2; ++n) _Pragma("unroll") for (int k = 0; k < 2; ++k) dst[n][k] = *(const LAS bf16x8*)(lds + PG8_SB(b, h) + boff + n * 2048 + k * 1024); } while (0)
#define PG8_MMA(ai, bj, At, Bt) do { __builtin_amdgcn_s_setprio(1); _Pragma("unroll") for (int m = 0; m < 4; ++m) _Pragma("unroll") for (int n = 0; n < 2; ++n) _Pragma("unroll") for (int k = 0; k < 2; ++k) \
        acc[ai][bj][m][n] = __builtin_amdgcn_mfma_f32_16x16x32_bf16(Bt[n][k], At[m][k], acc[ai][bj][m][n], 0, 0, 0); __builtin_amdgcn_s_setprio(0); } while (0)
#define PG8_WAIT_V(n) asm volatile("s_waitcnt vmcnt(" #n ")" ::: "memory")
#define PG8_WAIT_L(n) asm volatile("s_waitcnt lgkmcnt(" #n ")" ::: "memory")
#define PG8_BAR __builtin_amdgcn_s_barrier()
#define PG8_SCHED __builtin_amdgcn_sched_barrier(0)
    Unit cur, nxt; int ui = 0;
    if (!S.next(0, cur)) return;
    f32x4 acc[2][2][4][2];
#pragma unroll
    for (int a = 0; a < 2; ++a)
#pragma unroll
        for (int b = 0; b < 2; ++b)
#pragma unroll
            for (int m = 0; m < 4; ++m)
#pragma unroll
                for (int n = 0; n < 2; ++n) acc[a][b][m][n] = (f32x4){0.f, 0.f, 0.f, 0.f};
    bf16x8 At[4][2], B0[2][2], B1[2][2];
    const char* cA = (const char*)g.A + (Sched::GATHER ? 0u : cur.offA); const char* cB = (const char*)g.B + cur.offB;
    PG8_GLOAD(gcur, cur.pm);
    PG8_STAGE(PG8_SB(0, 0), cB, voffB); PG8_STAGE_A(0, 0, cA, cA, gcur[0]); PG8_STAGE(PG8_SB(0, 1), cB + hstepB, voffB); PG8_STAGE_A(0, 1, cA + hstepA, cA, gcur[1]);
    if (wr == 1) PG8_BAR;
    PG8_WAIT_V(4); PG8_BAR;
    PG8_STAGE(PG8_SB(1, 0), cB + kstepB, voffB); PG8_STAGE_A(1, 0, cA + kstepA, cA + kstepA, gcur[0]); PG8_STAGE(PG8_SB(1, 1), cB + hstepB + kstepB, voffB);
    PG8_WAIT_V(6); PG8_BAR;
    for (;;) {
        const bool has_next = S.next(ui + 1, nxt);
        const char* nA = has_next ? (const char*)g.A + (Sched::GATHER ? 0u : nxt.offA) : cA; const char* nB = has_next ? (const char*)g.B + nxt.offB : cB;
        if constexpr (Sched::GATHER) { if (has_next) PG8_GLOAD(gnxt, nxt.pm); else {
#pragma unroll
            for (int h_ = 0; h_ < 2; ++h_) { gnxt[h_][0] = gcur[h_][0]; gnxt[h_][1] = gcur[h_][1]; } } }
        for (int t = 0; t < nt; t += 2) {
            const bool last = (t == nt - 2);
            const char* a1 = cA + (size_t)(t + 1) * kstepA;
            const char* a2 = last ? nA : cA + (size_t)(t + 2) * kstepA; const char* b2 = last ? nB : cB + (size_t)(t + 2) * kstepB;
            const char* a3 = a2 + kstepA; const char* b3 = b2 + kstepB;
            unsigned gs0[2], gs1[2];
            if constexpr (Sched::GATHER) { gs0[0] = last ? gnxt[0][0] : gcur[0][0]; gs0[1] = last ? gnxt[0][1] : gcur[0][1]; gs1[0] = last ? gnxt[1][0] : gcur[1][0]; gs1[1] = last ? gnxt[1][1] : gcur[1][1]; }
            PG8_LDB(B0, 0, 0); PG8_SCHED; PG8_LDA(At, 0, 0); PG8_STAGE_A(1, 1, a1 + hstepA, a1, gcur[1]);
            PG8_WAIT_L(8); PG8_BAR; PG8_WAIT_L(0); PG8_MMA(0, 0, At, B0); PG8_BAR; PG8_SCHED;
            PG8_LDB(B1, 0, 1); PG8_STAGE(PG8_SB(0, 0), b2, voffB);
            PG8_BAR; PG8_WAIT_L(0); PG8_MMA(0, 1, At, B1); PG8_BAR;
            PG8_LDA(At, 0, 1); PG8_STAGE_A(0, 0, a2, a2, gs0);
            PG8_BAR; PG8_WAIT_L(0); PG8_MMA(1, 0, At, B0); PG8_BAR; PG8_SCHED;
            PG8_STAGE(PG8_SB(0, 1), b2 + hstepB, voffB);
            PG8_WAIT_V(6); PG8_BAR; PG8_MMA(1, 1, At, B1); PG8_BAR;
            PG8_LDB(B0, 1, 0); PG8_SCHED; PG8_LDA(At, 1, 0); PG8_STAGE_A(0, 1, a2 + hstepA, a2, gs1);
            PG8_WAIT_L(8); PG8_BAR; PG8_WAIT_L(0); PG8_MMA(0, 0, At, B0); PG8_BAR; PG8_SCHED;
            PG8_LDB(B1, 1, 1); PG8_STAGE(PG8_SB(1, 0), b3, voffB);
            PG8_BAR; PG8_WAIT_L(0); PG8_MMA(0, 1, At, B1); PG8_BAR;
            PG8_LDA(At, 1, 1); PG8_STAGE_A(1, 0, a3, a3, gs0);
            PG8_BAR; PG8_WAIT_L(0); PG8_MMA(1, 0, At, B0); PG8_BAR; PG8_SCHED;
            PG8_STAGE(PG8_SB(1, 1), b3 + hstepB, voffB);
            PG8_WAIT_V(6); PG8_BAR; PG8_MMA(1, 1, At, B1); PG8_BAR;
        }
        E(acc, cur, wr, wc, fr, fq);
        if (!has_next) break;
#pragma unroll
        for (int a = 0; a < 2; ++a)
#pragma unroll
            for (int b = 0; b < 2; ++b)
#pragma unroll
                for (int m = 0; m < 4; ++m)
#pragma unroll
                    for (int n = 0; n < 2; ++n) acc[a][b][m][n] = (f32x4){0.f, 0.f, 0.f, 0.f};
        cur = nxt; cA = nA; cB = nB; ++ui;
        if constexpr (Sched::GATHER) {
#pragma unroll
            for (int h_ = 0; h_ < 2; ++h_) { gcur[h_][0] = gnxt[h_][0]; gcur[h_][1] = gnxt[h_][1]; } }
    }
    PG8_WAIT_V(0);
    if (wr == 0) PG8_BAR;
    PG8_BAR;
#undef PG8_SA
#undef PG8_SB
#undef PG8_STAGE
#undef PG8_STAGE_A
#undef PG8_GLOAD
#undef PG8_LDA
#undef PG8_LDB
#undef PG8_MMA
#undef PG8_WAIT_V
#undef PG8_WAIT_L
#undef PG8_BAR
#undef PG8_SCHED
}

struct Args { const float* in[24]; float* out; unsigned char* ws; int ph_lo, ph_hi; };
typedef const float* cfp_t;
typedef const __attribute__((address_space(4))) cfp_t* InPtr;
struct Frame {
    InPtr in; float* out; unsigned char* ws; LAS unsigned char* lds; int tid, lane, wave, G, vb;
};
#define WSP(T, off) ((T*)(F.ws + (off)))
template <class T> __device__ __forceinline__ T* launder_ptr(T* p) {
    int z = 0; asm volatile("" : "+s"(z)); return (T*)((char*)p + z);
}
__device__ __forceinline__ Frame relaunder(const Frame& F0) {
    Frame F = F0; int ln = (int)__builtin_amdgcn_mbcnt_hi(~0u, __builtin_amdgcn_mbcnt_lo(~0u, 0u)); asm volatile("" : "+v"(ln));
    F.lane = ln; F.wave = F0.wave; F.tid = F0.wave * 64 + ln;
    F.ws = launder_ptr(F0.ws); F.out = launder_ptr(F0.out);
    { int g = F0.G, v = F0.vb; asm volatile("" : "+v"(g), "+v"(v)); F.G = __builtin_amdgcn_readfirstlane(g); F.vb = __builtin_amdgcn_readfirstlane(v); }
    return F;
}

__device__ __forceinline__ SchedB mk_sched(const Frame& F, int nB, int nM, int nN, int bdiv, unsigned bsA_hi, unsigned bsA_lo, unsigned bsB_hi, unsigned bsB_lo, unsigned tsA, unsigned tsB, int crot = 0) {
    SchedB S; S.nM = nM; S.nN = nN; S.nB = nB; S.G = F.G; S.c = (F.vb + crot) % F.G; S.bdiv = bdiv; S.bsA_hi = bsA_hi; S.bsA_lo = bsA_lo; S.bsB_hi = bsB_hi; S.bsB_lo = bsB_lo; S.tsA = tsA; S.tsB = tsB; return S;
}
__device__ __forceinline__ void gemm_plain(const Frame& F, const bf16_t* A, int lda, const bf16_t* Bw, int M, int N, int K, bf16_t* O, int ldc, int crot = 0) {
    GemmD g{A, Bw, lda, K, 128, 128, K};
    SchedB S = mk_sched(F, 1, M / 256, N / 256, 1, 0, 0, 0, 0, (unsigned)256 * lda * 2, (unsigned)256 * K * 2, crot);
    EpiBf16 E{O, ldc, 1, 0, 0};
    gemm_phase<EpiBf16, SchedB>(F.lds, g, S, E, F.wave);
}

struct TDesc { const float* src; int ldsrc; bf16_t* dst; int ldd; };
struct MatMap {
    const float* src; int ldsrc, nnt; bf16_t* dst; int ldd;
    __device__ __forceinline__ TDesc operator()(int tl) const { const int kt = tl / nnt, ntl = tl - kt * nnt; return TDesc{src + (size_t)kt * 64 * ldsrc + ntl * 64, ldsrc, dst + (size_t)ntl * 64 * ldd + kt * 64, ldd}; }
};
struct MoeMap {
    const float* wg; const float* wu; const float* wd; bf16_t* WGU; bf16_t* WDN;
    __device__ __forceinline__ TDesc operator()(int tl) const {
        const int e = tl / 384, r = tl - e * 384, which = r >> 7, q = r & 127;
        if (which < 2) { const int kt = q >> 3, ntl = q & 7, k0 = kt * 64, n0 = ntl * 64; const int row0 = (n0 >> 7) * 256 + which * 128 + (n0 & 127);
            return TDesc{(which ? wu : wg) + (size_t)e * 524288 + (size_t)k0 * 512 + n0, 512, WGU + (size_t)e * 1048576 + (size_t)row0 * 1024 + k0, 1024}; }
        const int kt = q >> 4, ntl = q & 15, k0 = kt * 64, n0 = ntl * 64;
        return TDesc{wd + (size_t)e * 524288 + (size_t)k0 * 1024 + n0, 1024, WDN + (size_t)e * 524288 + (size_t)n0 * 512 + k0, 512};
    }
};
template <class Map>
__device__ __forceinline__ void tconv_run_sub(const Frame& F, int ntiles, const Map& M, int wgi, int nwg) {
    LAS float* tile = (LAS float*)F.lds;
    const int t = F.tid, r = t >> 3, cg = t & 7;
    for (int base = wgi * 4; base < ntiles; base += nwg * 4) {
        f32x4 v[4][2]; TDesc d[4];
#pragma unroll
        for (int q = 0; q < 4; ++q) { d[q] = M(min(base + q, ntiles - 1));
            v[q][0] = gload<f32x4>(d[q].src + (size_t)r * d[q].ldsrc + cg * 8); v[q][1] = gload<f32x4>(d[q].src + (size_t)r * d[q].ldsrc + cg * 8 + 4); }
#pragma unroll
        for (int q = 0; q < 4; ++q)
#pragma unroll
            for (int j = 0; j < 4; ++j) { tile[q * 4160 + r * 65 + cg * 8 + j] = v[q][0][j]; tile[q * 4160 + r * 65 + cg * 8 + 4 + j] = v[q][1][j]; }
        __syncthreads();
#pragma unroll
        for (int q = 0; q < 4; ++q) {
            float o[8];
#pragma unroll
            for (int j = 0; j < 8; ++j) o[j] = tile[q * 4160 + (cg * 8 + j) * 65 + r];
            u32x4 w; w.x = cvt_pk_bf16(o[0], o[1]); w.y = cvt_pk_bf16(o[2], o[3]); w.z = cvt_pk_bf16(o[4], o[5]); w.w = cvt_pk_bf16(o[6], o[7]);
            if (base + q < ntiles) gstore<u32x4>(d[q].dst + (size_t)r * d[q].ldd + cg * 8, w);
        }
        __syncthreads();
    }
}
template <class Map>
__device__ __forceinline__ void tconv_run(const Frame& F, int ntiles, const Map& M, int rot) { tconv_run_sub(F, ntiles, M, (F.vb + rot) % F.G, F.G); }
__device__ __forceinline__ void tconv_matrix(const Frame& F, const float* src, int ldsrc, int Kd, int Nd, bf16_t* dst, int ldd, int rot) {
    MatMap M{src, ldsrc, Nd / 64, dst, ldd};
    tconv_run(F, (Kd / 64) * (Nd / 64), M, rot);
}
__device__ __forceinline__ void moe_convert(const Frame& F0, int l) {
    const Frame F = relaunder(F0);
    MoeMap M{F.in[19] + (size_t)l * 32 * 524288, F.in[20] + (size_t)l * 32 * 524288, F.in[21] + (size_t)l * 32 * 524288, l ? (bf16_t*)F.out : WSP(bf16_t, WS_WGU), l ? (bf16_t*)F.out + (size_t)33554432 : WSP(bf16_t, WS_WDN)};
    tconv_run(F, 32 * 384, M, 0);
}
constexpr size_t X_PRO_ELEMS = (size_t)NTOK * DM / 2;
__device__ __forceinline__ void conv_f32_bf16_sub(const Frame& F, const float* src, bf16_t* dst, size_t n, int wgi, int nwg) {
    for (size_t i = ((size_t)wgi * NTHR + F.tid) * 8; i < n; i += (size_t)nwg * NTHR * 8) {
        const f32x4 a = gload<f32x4>(src + i), b = gload<f32x4>(src + i + 4);
        u32x4 w; w.x = cvt_pk_bf16(a[0], a[1]); w.y = cvt_pk_bf16(a[2], a[3]); w.z = cvt_pk_bf16(b[0], b[1]); w.w = cvt_pk_bf16(b[2], b[3]);
        gstore<u32x4>(dst + i, w); }
}
__device__ __forceinline__ void conv_f32_bf16(const Frame& F, const float* src, bf16_t* dst, size_t n) {
    for (size_t i = ((size_t)F.vb * NTHR + F.tid) * 8; i < n; i += (size_t)F.G * NTHR * 8) {
        const f32x4 a = gload<f32x4>(src + i), b = gload<f32x4>(src + i + 4);
        u32x4 w; w.x = cvt_pk_bf16(a[0], a[1]); w.y = cvt_pk_bf16(a[2], a[3]); w.z = cvt_pk_bf16(b[0], b[1]); w.w = cvt_pk_bf16(b[2], b[3]);
        gstore<u32x4>(dst + i, w); }
}

__device__ __forceinline__ void p_prologue(const Frame& F0) {
    const Frame F = relaunder(F0);
    tconv_matrix(F, F.in[2] + 512, 1024, 1024, 512, WSP(bf16_t, WS_W1CAT) + (size_t)512 * 1024, 1024, 0);
    tconv_matrix(F, F.in[7], 1024, 1024, 1024, WSP(bf16_t, WS_PFWOUT), 1024, 32);
    { const int dsec[5] = {0, 1, 3, 4, 2};
#pragma unroll
      for (int sc = 0; sc < 5; ++sc) tconv_matrix(F, F.in[8] + sc * 1024, 5120, 1024, 1024, WSP(bf16_t, WS_HGWIN) + (size_t)dsec[sc] * 1048576, 1024, 96 + sc * 64); }
    tconv_matrix(F, F.in[11], 1024, 1024, 1024, WSP(bf16_t, WS_HGWOUT), 1024, 160);
    for (int l = 0; l < 2; ++l) {
        tconv_matrix(F, F.in[13] + (size_t)l * 2097152, 2048, 1024, 1024, WSP(bf16_t, WS_WK) + (size_t)l * 1048576, 1024, 32 + l * 256);
        tconv_matrix(F, F.in[13] + (size_t)l * 2097152 + 1024, 2048, 1024, 1024, WSP(bf16_t, WS_WV) + (size_t)l * 1048576, 1024, 96 + l * 256);
        tconv_matrix(F, F.in[14] + (size_t)l * 1048576, 1024, 1024, 1024, WSP(bf16_t, l ? WS_WOT1 : WS_WOT0), 1024, 160 + l * 256);
        conv_f32_bf16(F, F.in[12] + (size_t)l * 1048576, WSP(bf16_t, l ? WS_WQN1 : WS_WQN0), (size_t)1048576);
    }
    if (F.G != 256) moe_convert(F, 0);
    conv_f32_bf16(F, F.in[0], WSP(bf16_t, WS_XB), F.G == 256 ? X_PRO_ELEMS : (size_t)NTOK * DM);
    conv_f32_bf16(F, F.in[1], WSP(bf16_t, WS_MEMBF), (size_t)NB * MEML * DM);
    const int gt = F.vb * NTHR + F.tid, gn = F.G * NTHR;
    { const float* win = F.in[2]; const float* pw = F.in[3]; const float* ps = F.in[4]; bf16_t* W1 = WSP(bf16_t, WS_W1CAT);
      LAS float* wl = (LAS float*)F.lds;
      for (int kb = F.vb; kb < 256; kb += F.G) {
          __syncthreads();
#pragma unroll
          for (int j = 0; j < 4; ++j) wl[j * 512 + F.tid] = win[(size_t)(kb * 4 + j) * 1024 + F.tid];
          __syncthreads();
          const int gd = F.tid, g = gd >> 7, d = gd & 127; const float* pp = pw + (size_t)g * 16384 + d;
          float a0 = 0.f, a1 = 0.f, a2 = 0.f, a3 = 0.f;
#pragma unroll 8
          for (int c = 0; c < 128; ++c) { const float p = pp[c * 128]; a0 += wl[g * 128 + c] * p; a1 += wl[512 + g * 128 + c] * p; a2 += wl[1024 + g * 128 + c] * p; a3 += wl[1536 + g * 128 + c] * p; }
          const float sc = ps[gd];
          u32x2 w; w.x = cvt_pk_bf16(a0 * sc, a1 * sc); w.y = cvt_pk_bf16(a2 * sc, a3 * sc);
          gstore<u32x2>(W1 + (size_t)gd * 1024 + kb * 4, w); }
      __syncthreads(); }
    { const float* fw = F.in[6]; bf16_t* PQ = WSP(bf16_t, WS_PQT); const float norm = 0.0013810679320049757f;
      LAS float* tb = (LAS float*)F.lds;
      __syncthreads();
      if (F.tid < 128) { const float ang = (float)F.tid * (1.0f / 64.0f); tb[F.tid] = cospif(ang); tb[128 + F.tid] = sinpif(ang); }
      __syncthreads();
      for (int idx = gt; idx < 4 * 256 * 128; idx += gn) { const int h = idx >> 15, r = (idx >> 7) & 255, c = idx & 127, d = r & 127, isq = r >> 7; float a = 0.f;
          const float* fp = fw + (size_t)h * 16384 + d; const LAS float* tp = tb + isq * 128;
#pragma unroll 8
          for (int m = 0; m < 128; ++m) a += tp[(m * c) & 127] * fp[m * 128];
          PQ[idx] = f2bf(a * norm); }
      __syncthreads(); }
    { bf16_t* W1d = WSP(bf16_t, WS_W1DFT); bf16_t* W2d = WSP(bf16_t, WS_W2DFT); float* TW = WSP(float, WS_TW);
      for (int idx = gt; idx < 256 * 128; idx += gn) { const int r = idx >> 7, k = idx & 127, ri = k >> 6, bb = k & 63; float v1 = 0.f, v2 = 0.f;
          if (r < 128) { const int e = 32 * (r >> 6) + (r & 31), ro = (r >> 5) & 1; const float ang = (float)((e * bb) & 63) * (1.0f / 32.0f); const float cs = cospif(ang), sn = sinpif(ang);
              v1 = ro == 0 ? (ri == 0 ? cs : -sn) : (ri == 0 ? sn : cs); }
          if (r < 64) { const float ang = (float)((r * bb) & 63) * (1.0f / 32.0f); v2 = ri == 0 ? cospif(ang) : -sinpif(ang); }
          W1d[idx] = f2bf(v1); W2d[idx] = f2bf(v2); }
      for (int idx = gt; idx < 64 * 64; idx += gn) { const int e = idx >> 6, a = idx & 63; const float ang = (float)((e * a) & 4095) * (1.0f / 2048.0f); TW[idx * 2] = cospif(ang); TW[idx * 2 + 1] = sinpif(ang); } }
    { const float* lbin = F.in[9]; float* LB = WSP(float, WS_LB1);
      for (int idx = gt; idx < 2048; idx += gn) { const float v0 = lbin[idx], v1 = lbin[2048 + idx]; LB[idx] = 1.0f / (1.0f + expf(v0 - v1)); } }
}

__device__ __forceinline__ void p_kv_a(const Frame& F0) {
    const Frame F = relaunder(F0);
    gemm_plain(F, WSP(bf16_t, WS_MEMBF), 1024, WSP(bf16_t, WS_WK), 2048, 1024, 1024, WSP(bf16_t, WS_KB0), 1024, 0);
    gemm_plain(F, WSP(bf16_t, WS_MEMBF), 1024, WSP(bf16_t, WS_WV), 2048, 1024, 1024, WSP(bf16_t, WS_VB0), 1024, 32);
    gemm_plain(F, WSP(bf16_t, WS_MEMBF), 1024, WSP(bf16_t, WS_WK) + 1048576, 2048, 1024, 1024, WSP(bf16_t, WS_KB1), 1024, 64);
    gemm_plain(F, WSP(bf16_t, WS_MEMBF), 1024, WSP(bf16_t, WS_WV) + 1048576, 2048, 1024, 1024, WSP(bf16_t, WS_VB1), 1024, 96);
    if (F.G == 256 && F.vb >= 32 && F.vb < 160) conv_f32_bf16_sub(F, F.in[0] + X_PRO_ELEMS, WSP(bf16_t, WS_XB) + X_PRO_ELEMS, (size_t)NTOK * DM - X_PRO_ELEMS, F.vb - 32, 128);
}
__device__ __forceinline__ void p_kv_b(const Frame& F0, int l) {
    const Frame F = relaunder(F0);
    const bf16_t* KB = WSP(bf16_t, l ? WS_KB1 : WS_KB0); const bf16_t* VB = WSP(bf16_t, l ? WS_VB1 : WS_VB0);
    const bf16_t* WQN = WSP(bf16_t, l ? WS_WQN1 : WS_WQN0); const bf16_t* WOT = WSP(bf16_t, l ? WS_WOT1 : WS_WOT0);
    { GemmD g{KB, WQN, 1024, 1024, 128, 128, 256};
      SchedB S = mk_sched(F, 32, 1, 4, 4, (unsigned)256 * 1024 * 2, (unsigned)256 * 2, 0, (unsigned)256 * 2, 0, (unsigned)256 * 1024 * 2);
      EpiBf16 E{WSP(bf16_t, WS_KM), 1024, 1, (unsigned)256 * 1024, 0};
      gemm_phase<EpiBf16, SchedB>(F.lds, g, S, E, F.wave); }
    { GemmD g{WOT, VB, 1024, 1024, 128, 128, 256};
      SchedB S = mk_sched(F, 32, 4, 1, 4, 0, (unsigned)256 * 2, (unsigned)256 * 1024 * 2, (unsigned)256 * 2, (unsigned)256 * 1024 * 2, 0, 128);
      EpiBf16 E{WSP(bf16_t, WS_VW), 1024, 4, (unsigned)1024 * 1024, 256};
      gemm_phase<EpiBf16, SchedB>(F.lds, g, S, E, F.wave); }
}

__device__ __forceinline__ void p_pool_hln(const Frame& F0) {
    const Frame F = relaunder(F0);
    const bf16_t* U = WSP(bf16_t, WS_U); bf16_t* YC = WSP(bf16_t, WS_YCAT); bf16_t* UN = WSP(bf16_t, WS_UN); const float* lng = F.in[5];
    const int l = F.lane, g = l >> 4, w2 = 1 << g;
    float gam[8];
#pragma unroll
    for (int j = 0; j < 8; ++j) gam[j] = lng[8 * l + j];
#define POOL_LOAD(o_, u_, a_, d_, i_) do { const int s_ = s0 + (i_); o_ = gload<u32x4>(Ub + (size_t)s_ * DM); u_ = gload<u32x4>(Ub + (size_t)s_ * DM + 512); \
        a_ = gload<u32x4>(Ub + (size_t)min(s_ + w2, SEQ - 1) * DM); d_ = gload<u32x4>(Ub + (size_t)max(s_ - w2, 0) * DM); } while (0)
#define POOL_BODY(o_, u_, a_, d_, i_) do { const int s = s0 + (i_), tk = t0 + (i_); \
        const int lo = max(s - w2, 0), hi = min(s + w2, SEQ); \
        const u32x4 own = o_; \
        const float inv = 1.0f / (float)(hi - lo); \
        float o[8]; \
        o[0] = sum[0] * inv - lo_bf(own.x); o[1] = sum[1] * inv - hi_bf(own.x); o[2] = sum[2] * inv - lo_bf(own.y); o[3] = sum[3] * inv - hi_bf(own.y); \
        o[4] = sum[4] * inv - lo_bf(own.z); o[5] = sum[5] * inv - hi_bf(own.z); o[6] = sum[6] * inv - lo_bf(own.w); o[7] = sum[7] * inv - hi_bf(own.w); \
        u32x4 w; w.x = cvt_pk_bf16(o[0], o[1]); w.y = cvt_pk_bf16(o[2], o[3]); w.z = cvt_pk_bf16(o[4], o[5]); w.w = cvt_pk_bf16(o[6], o[7]); \
        gstore<u32x4>(YC + (size_t)tk * DM + 8 * l, w); \
        { const float ka = (s + w2 < SEQ) ? 1.0f : 0.0f, kd = (s - w2 >= 0) ? 1.0f : 0.0f; const u32x4 va = a_, vd = d_;        \
          sum[0] += ka * lo_bf(va.x) - kd * lo_bf(vd.x); sum[1] += ka * hi_bf(va.x) - kd * hi_bf(vd.x); sum[2] += ka * lo_bf(va.y) - kd * lo_bf(vd.y); sum[3] += ka * hi_bf(va.y) - kd * hi_bf(vd.y); \
          sum[4] += ka * lo_bf(va.z) - kd * lo_bf(vd.z); sum[5] += ka * hi_bf(va.z) - kd * hi_bf(vd.z); sum[6] += ka * lo_bf(va.w) - kd * lo_bf(vd.w); sum[7] += ka * hi_bf(va.w) - kd * hi_bf(vd.w); } \
          \
        const u32x4 ub = u_; \
        float x[8] = {lo_bf(ub.x), hi_bf(ub.x), lo_bf(ub.y), hi_bf(ub.y), lo_bf(ub.z), hi_bf(ub.z), lo_bf(ub.w), hi_bf(ub.w)}; \
        float sm = ((x[0] + x[1]) + (x[2] + x[3])) + ((x[4] + x[5]) + (x[6] + x[7])); \
        sm += __shfl_xor(sm, 1); sm += __shfl_xor(sm, 2); sm += __shfl_xor(sm, 4); sm += __shfl_xor(sm, 8); \
        const float mu = sm * (1.0f / 128.0f); \
        float qq = 0.f; \
        _Pragma("unroll") for (int j = 0; j < 8; ++j) { x[j] -= mu; qq += x[j] * x[j]; } \
        qq += __shfl_xor(qq, 1); qq += __shfl_xor(qq, 2); qq += __shfl_xor(qq, 4); qq += __shfl_xor(qq, 8); \
        const float rs = rsqrtf(qq * (1.0f / 128.0f) + LN_EPS); \
        _Pragma("unroll") for (int j = 0; j < 8; ++j) x[j] = x[j] * rs * gam[j]; \
        const int np = 64 * (s & 63) + (s >> 6); \
        u32x4 w2v; w2v.x = cvt_pk_bf16(x[0], x[1]); w2v.y = cvt_pk_bf16(x[2], x[3]); w2v.z = cvt_pk_bf16(x[4], x[5]); w2v.w = cvt_pk_bf16(x[6], x[7]); \
        gstore<u32x4>(UN + ((size_t)(b * SEQ + np)) * 512 + 8 * l, w2v); } while (0)
    for (int run = F.vb * 8 + F.wave; run < NTOK / 16; run += F.G * 8) {
        const int t0 = run * 16, b = t0 >> 12, s0 = t0 & 4095;
        const bf16_t* Ub = U + (size_t)b * SEQ * DM + 8 * l;
        float sum[8];
#pragma unroll
        for (int j = 0; j < 8; ++j) sum[j] = 0.f;
        {
            const int lo = max(s0 - w2, 0), hi = min(s0 + w2, SEQ);
            u32x4 wv[16];
#pragma unroll
            for (int d = 0; d < 16; ++d) { const int r = s0 - 8 + d; const int rc = min(max(r, 0), SEQ - 1); wv[d] = gload<u32x4>(Ub + (size_t)rc * DM); }
#pragma unroll
            for (int d = 0; d < 16; ++d) { const int r = s0 - 8 + d; const float k = (r >= lo && r < hi) ? 1.0f : 0.0f; const u32x4 v = wv[d];
                sum[0] += k * lo_bf(v.x); sum[1] += k * hi_bf(v.x); sum[2] += k * lo_bf(v.y); sum[3] += k * hi_bf(v.y); sum[4] += k * lo_bf(v.z); sum[5] += k * hi_bf(v.z); sum[6] += k * lo_bf(v.w); sum[7] += k * hi_bf(v.w); }
        }
        u32x4 oA, uA, aA, dA, oB, uB, aB, dB;
        POOL_LOAD(oA, uA, aA, dA, 0);
#pragma unroll 1
        for (int i = 0; i < 16; i += 2) {
            POOL_LOAD(oB, uB, aB, dB, i + 1);
            POOL_BODY(oA, uA, aA, dA, i);
            if (i + 2 < 16) POOL_LOAD(oA, uA, aA, dA, i + 2);
            POOL_BODY(oB, uB, aB, dB, i + 1);
        }
    }
#undef POOL_LOAD
#undef POOL_BODY
}

template <int MODE, bool XF32, bool FINAL>
__device__ __forceinline__ void p_ln(const Frame& F0, const float* xin, const bf16_t* hsrc, int l, int j3) {
    const Frame F = relaunder(F0);
    float* X = F.out; bf16_t* XB = WSP(bf16_t, WS_XB);
    const float* gam = F.in[22] + (size_t)(l * 3 + j3) * 1024; const float* bet = F.in[23] + (size_t)(l * 3 + j3) * 1024;
    const int ln = F.lane;
    float gv[16], bv[16];
#pragma unroll
    for (int ii = 0; ii < 2; ++ii)
#pragma unroll
        for (int j = 0; j < 8; ++j) { gv[ii * 8 + j] = gam[ii * 512 + ln * 8 + j]; bv[ii * 8 + j] = bet[ii * 512 + ln * 8 + j]; }
    LAS float* WR = (LAS float*)F.lds;
#define WR_PERM(c_) ((((c_) >> 9) * 2 + (((c_) >> 2) & 1)) * 256 + (((c_) >> 3) & 63) * 4 + ((c_) & 3))
    LAS int* hist = (LAS int*)(F.lds + 36 * 4096);
    float rbias_g = 0.f, rbias_e = 0.f;
    if (MODE == 1) {
        const float* wgp = F.in[15] + (size_t)l * 4096; const float* wep = F.in[17] + (size_t)l * 32768;
        for (int c = F.tid; c < 1024; c += NTHR) { const f32x4 v = gload<f32x4>(wgp + c * 4);
#pragma unroll
            for (int j = 0; j < 4; ++j) WR[j * 1024 + WR_PERM(c)] = v[j]; }
        for (int idx = F.tid; idx < 8192; idx += NTHR) { const int c = idx & 1023, q4 = idx >> 10; const f32x4 v = gload<f32x4>(wep + c * 32 + q4 * 4);
#pragma unroll
            for (int j = 0; j < 4; ++j) WR[(4 + q4 * 4 + j) * 1024 + WR_PERM(c)] = v[j]; }
        rbias_g = F.in[16][l * 4 + (ln & 3)]; rbias_e = F.in[18][l * 32 + (ln & 31)];
        __syncthreads();
    }
    const int2* POSS = WSP(int2, WS_POSS);
    if (MODE == 1) { int* ROWTOK = WSP(int, WS_ROWTOK); for (int i = F.vb * NTHR + F.tid; i < MPAD_MAX; i += F.G * NTHR) ROWTOK[i] = 0; }
    for (int ch = F.vb; ch < NTOK / 128; ch += F.G) {
        if (MODE == 1) { if (F.tid < 32) hist[F.tid] = 0; __syncthreads(); }
        const int t0 = ch * 128 + F.wave * 16;
        int2 myps = make_int2(0, 0);
        if (MODE == 2) myps = POSS[t0 + (ln & 15)];
        f32x4 nxf[4]; u32x4 nxb[2], nh0[2], nh1[2];
#define LN_LOAD(tt, ii_) do { const int t_ = (tt); const bf16_t* h0_ = hsrc + (size_t)t_ * DM; const bf16_t* h1_ = h0_; \
            if (MODE == 2) { const int p0_ = __shfl(myps.x, (ii_)), p1_ = __shfl(myps.y, (ii_)); h0_ = hsrc + (size_t)p0_ * DM; h1_ = hsrc + (size_t)p1_ * DM; } \
            _Pragma("unroll") for (int ii = 0; ii < 2; ++ii) { const int c0 = ii * 512 + ln * 8; \
                if (XF32) { nxf[ii * 2] = gload<f32x4>(xin + (size_t)t_ * DM + c0); nxf[ii * 2 + 1] = gload<f32x4>(xin + (size_t)t_ * DM + c0 + 4); } \
                else nxb[ii] = gload<u32x4>(XB + (size_t)t_ * DM + c0); \
                nh0[ii] = gload<u32x4>(h0_ + c0); if (MODE == 2) nh1[ii] = gload<u32x4>(h1_ + c0); } } while (0)
        LN_LOAD(t0, 0);
        for (int i = 0; i < 16; ++i) {
            const int t = t0 + i;
            float y[16];
#pragma unroll
            for (int ii = 0; ii < 2; ++ii) {
                float xx[8];
                if (XF32) {
#pragma unroll
                    for (int j = 0; j < 4; ++j) { xx[j] = nxf[ii * 2][j]; xx[4 + j] = nxf[ii * 2 + 1][j]; } }
                else { const u32x4 xv = nxb[ii];
                    xx[0] = lo_bf(xv.x); xx[1] = hi_bf(xv.x); xx[2] = lo_bf(xv.y); xx[3] = hi_bf(xv.y); xx[4] = lo_bf(xv.z); xx[5] = hi_bf(xv.z); xx[6] = lo_bf(xv.w); xx[7] = hi_bf(xv.w); }
                const u32x4 hv = nh0[ii];
                float hh[8] = {lo_bf(hv.x), hi_bf(hv.x), lo_bf(hv.y), hi_bf(hv.y), lo_bf(hv.z), hi_bf(hv.z), lo_bf(hv.w), hi_bf(hv.w)};
                if (MODE == 2) { const u32x4 h2 = nh1[ii];
                    hh[0] += lo_bf(h2.x); hh[1] += hi_bf(h2.x); hh[2] += lo_bf(h2.y); hh[3] += hi_bf(h2.y); hh[4] += lo_bf(h2.z); hh[5] += hi_bf(h2.z); hh[6] += lo_bf(h2.w); hh[7] += hi_bf(h2.w); }
#pragma unroll
                for (int j = 0; j < 8; ++j) y[ii * 8 + j] = DN_ALPHA * xx[j] + hh[j];
            }
            if (i + 1 < 16) LN_LOAD(t + 1, i + 1);
            float sm = 0.f;
#pragma unroll
            for (int j = 0; j < 16; ++j) sm += y[j];
            sm = wave_sum(sm);
            const float mu = sm * (1.0f / 1024.0f);
            float q = 0.f;
#pragma unroll
            for (int j = 0; j < 16; ++j) { y[j] -= mu; q += y[j] * y[j]; }
            q = wave_sum(q);
            const float rs = rsqrtf(q * (1.0f / 1024.0f) + LN_EPS);
#pragma unroll
            for (int j = 0; j < 16; ++j) y[j] = y[j] * rs * gv[j] + bv[j];
#pragma unroll
            for (int ii = 0; ii < 2; ++ii) {
                const int c0 = ii * 512 + ln * 8;
                if (FINAL) {
                    gstore<f32x4>(X + (size_t)t * DM + c0, (f32x4){y[ii * 8 + 0], y[ii * 8 + 1], y[ii * 8 + 2], y[ii * 8 + 3]});
                    gstore<f32x4>(X + (size_t)t * DM + c0 + 4, (f32x4){y[ii * 8 + 4], y[ii * 8 + 5], y[ii * 8 + 6], y[ii * 8 + 7]});
                } else {
                    u32x4 w; w.x = cvt_pk_bf16(y[ii * 8 + 0], y[ii * 8 + 1]); w.y = cvt_pk_bf16(y[ii * 8 + 2], y[ii * 8 + 3]); w.z = cvt_pk_bf16(y[ii * 8 + 4], y[ii * 8 + 5]); w.w = cvt_pk_bf16(y[ii * 8 + 6], y[ii * 8 + 7]);
                    gstore<u32x4>(XB + (size_t)t * DM + c0, w);
                }
            }
            if (MODE == 1) {
                const bool b0 = ln & 1, b1 = ln & 2, b2 = ln & 4;
#define ROUTER_DOT(dst, jj_) do { f32x2 a2 = (f32x2){0.f, 0.f}; _Pragma("unroll") for (int ii = 0; ii < 2; ++ii) { \
                    const f32x4 w0 = *(const LAS f32x4*)(WR + (jj_) * 1024 + ii * 512 + ln * 4), w1 = *(const LAS f32x4*)(WR + (jj_) * 1024 + ii * 512 + 256 + ln * 4); \
                    a2 += (f32x2){y[ii * 8 + 0], y[ii * 8 + 1]} * (f32x2){w0[0], w0[1]}; a2 += (f32x2){y[ii * 8 + 2], y[ii * 8 + 3]} * (f32x2){w0[2], w0[3]}; \
                    a2 += (f32x2){y[ii * 8 + 4], y[ii * 8 + 5]} * (f32x2){w1[0], w1[1]}; a2 += (f32x2){y[ii * 8 + 6], y[ii * 8 + 7]} * (f32x2){w1[2], w1[3]}; } \
                    dst = a2[0] + a2[1]; } while (0)
                float gq[4];
#pragma unroll
                for (int j = 0; j < 4; ++j) ROUTER_DOT(gq[j], j);
                float gv1[2];
#pragma unroll
                for (int k = 0; k < 2; ++k) { const float keep = b0 ? gq[2 * k + 1] : gq[2 * k], send = b0 ? gq[2 * k] : gq[2 * k + 1]; gv1[k] = keep + __shfl_xor(send, 1); }
                float gsum; { const float keep = b1 ? gv1[1] : gv1[0], send = b1 ? gv1[0] : gv1[1]; gsum = keep + __shfl_xor(send, 2); }
                gsum += __shfl_xor(gsum, 4); gsum += __shfl_xor(gsum, 8); gsum += __shfl_xor(gsum, 16); gsum += __shfl_xor(gsum, 32);
                gsum += rbias_g;
                float lg[4];
#pragma unroll
                for (int j = 0; j < 4; ++j) lg[j] = __shfl(gsum, j);
                int gi = 0; float gm = lg[0];
#pragma unroll
                for (int j = 1; j < 4; ++j) if (lg[j] > gm) { gm = lg[j]; gi = j; }
                float den = 0.f;
#pragma unroll
                for (int j = 0; j < 4; ++j) den += __expf(lg[j] - gm);
                const float pg = 1.0f / den;
                const int gib = __builtin_amdgcn_readfirstlane(gi) * 8 + 4;
                float eq[8];
#pragma unroll
                for (int j = 0; j < 8; ++j) ROUTER_DOT(eq[j], gib + j);
                float ev1[4], ev2[2];
#pragma unroll
                for (int k = 0; k < 4; ++k) { const float keep = b0 ? eq[2 * k + 1] : eq[2 * k], send = b0 ? eq[2 * k] : eq[2 * k + 1]; ev1[k] = keep + __shfl_xor(send, 1); }
#pragma unroll
                for (int k = 0; k < 2; ++k) { const float keep = b1 ? ev1[2 * k + 1] : ev1[2 * k], send = b1 ? ev1[2 * k] : ev1[2 * k + 1]; ev2[k] = keep + __shfl_xor(send, 2); }
                float esum; { const float keep = b2 ? ev2[1] : ev2[0], send = b2 ? ev2[0] : ev2[1]; esum = keep + __shfl_xor(send, 4); }
                esum += __shfl_xor(esum, 8); esum += __shfl_xor(esum, 16); esum += __shfl_xor(esum, 32);
                esum += __shfl(rbias_e, gi * 8 + (ln & 7));
                float le[8];
#pragma unroll
                for (int j = 0; j < 8; ++j) le[j] = __shfl(esum, j);
#undef ROUTER_DOT
                int i0 = 0; float m0 = le[0];
#pragma unroll
                for (int j = 1; j < 8; ++j) if (le[j] > m0) { m0 = le[j]; i0 = j; }
                int i1 = -1; float m1 = -3.0e38f;
#pragma unroll
                for (int j = 0; j < 8; ++j) if (j != i0 && le[j] > m1) { m1 = le[j]; i1 = j; }
                const float p1 = __expf(m1 - m0), rden = 1.0f / (1.0f + p1);
                if (ln == 0) {
                    const int e0 = gi * 8 + i0, e1 = gi * 8 + i1;
                    WSP(int2, WS_TOKE)[t] = make_int2(e0, e1);
                    WSP(float2, WS_TOKG)[t] = make_float2(pg * rden, pg * p1 * rden);
                    atomicAdd((int*)&hist[e0], 1); atomicAdd((int*)&hist[e1], 1);
                }
            }
        }
#undef LN_LOAD
        if (MODE == 1) { __syncthreads(); if (F.tid < 32) WSP(int, WS_HIST)[ch * 32 + F.tid] = hist[F.tid]; __syncthreads(); }
    }
}

__device__ __forceinline__ void p_dispatch(const Frame& F0) {
    const Frame F = relaunder(F0);
    LAS int* hsum = (LAS int*)F.lds; LAS int* hpre = hsum + 32; LAS int* off = hsum + 64; LAS int* cursor = hsum + 128;
    const int* HIST = WSP(int, WS_HIST); const int2* TOKE = WSP(int2, WS_TOKE); const float2* TOKG = WSP(float2, WS_TOKG);
    int2* POSS = WSP(int2, WS_POSS); float* GPOS = WSP(float, WS_GPOS); int* TEXP = WSP(int, WS_TILEEXP);
    int* ROWTOK = WSP(int, WS_ROWTOK);
    for (int ch = F.vb; ch < NTOK / 128; ch += F.G) {
        if (F.tid < 32) { hsum[F.tid] = 0; hpre[F.tid] = 0; cursor[F.tid] = 0; }
        __syncthreads();
        { const int e = F.tid & 31, part = F.tid >> 5; int tot = 0, pre = 0;
          for (int cc = part * 16; cc < part * 16 + 16; ++cc) { const int v = HIST[cc * 32 + e]; tot += v; if (cc < ch) pre += v; }
          atomicAdd((int*)&hsum[e], tot); atomicAdd((int*)&hpre[e], pre); }
        __syncthreads();
        if (F.tid == 0) { int o = 0; for (int e = 0; e < 32; ++e) { off[e] = o; o += (hsum[e] + 255) & ~255; } off[32] = o; }
        __syncthreads();
        if (ch == 0) { const int ntile = off[32] >> 8;
            if (F.tid < 320) { int e = 0; for (int k = 0; k < 32; ++k) if (F.tid * 256 >= off[k + 1]) e = k + 1; if (F.tid < ntile) TEXP[F.tid] = e < 32 ? e : 31; }
            if (F.tid == 0) TEXP[320] = ntile; }
        {
            const int t0 = ch * 128 + F.wave * 16;
            int p0 = 0, p1 = 0;
            if (F.lane < 16) { const int t = t0 + F.lane; const int2 ee = TOKE[t]; const float2 gg = TOKG[t];
                const int r0 = atomicAdd((int*)&cursor[ee.x], 1); const int r1 = atomicAdd((int*)&cursor[ee.y], 1);
                p0 = off[ee.x] + hpre[ee.x] + r0; p1 = off[ee.y] + hpre[ee.y] + r1;
                POSS[t] = make_int2(p0, p1); GPOS[p0] = gg.x; GPOS[p1] = gg.y; ROWTOK[p0] = t; ROWTOK[p1] = t; }
        }
        __syncthreads();
    }
}

typedef short s16x4 __attribute__((ext_vector_type(4)));
typedef float f32x16 __attribute__((ext_vector_type(16)));
__device__ __forceinline__ s16x4 tr16(const LAS unsigned char* p) { return __builtin_amdgcn_ds_read_tr16_b64_v4i16((LAS s16x4*)p); }
__device__ __forceinline__ bf16x8 cat8(s16x4 a, s16x4 b) { return (bf16x8){a[0], a[1], a[2], a[3], b[0], b[1], b[2], b[3]}; }
constexpr int GQ_S = 288, GV_S = 128, GT_S = 128, GST_S = 288, GA_S = 128;
constexpr int G_QR = 0, G_LR = 64 * GQ_S, G_VR = 2 * 64 * GQ_S, G_VRSZ = 64 * GV_S, G_QTT = G_VR + 2 * G_VRSZ, G_TSZ = 128 * GT_S, G_KTT = G_QTT + 2 * G_TSZ,
              G_ST = G_KTT + 2 * G_TSZ, G_AM = G_ST + 64 * GST_S, G_VEC = G_AM + 64 * GA_S, G_VECSZ = 3 * 512, G_END = G_VEC + 2 * G_VECSZ;
static_assert(G_END <= LDS_MISC, "GLA LDS map");
static_assert((G_VR % 128) == 0 && (G_QTT % 128) == 0 && (G_KTT % 128) == 0 && (G_ST % 128) == 0 && (G_AM % 128) == 0 && (G_TSZ % 128) == 0 && (G_VRSZ % 128) == 0, "GLA LDS alignment");

struct GlaLane { int w, g, c, q, p, hi, c32, blk; };
__device__ __forceinline__ const LAS unsigned char* vbase(const LAS unsigned char* p) { asm volatile("" : "+v"(p)); return p; }
__device__ __forceinline__ LAS unsigned char* vbasew(LAS unsigned char* p) { asm volatile("" : "+v"(p)); return p; }
__device__ __forceinline__ const LAS unsigned char* lxor(const LAS unsigned char* p, unsigned x) { return (const LAS unsigned char*)(uintptr_t)((unsigned)(uintptr_t)p ^ x); }
__device__ __forceinline__ LAS unsigned char* lxorw(LAS unsigned char* p, unsigned x) { return (LAS unsigned char*)(uintptr_t)((unsigned)(uintptr_t)p ^ x); }
__device__ __forceinline__ int s13(int r) { return ((r >> 1) & 1) | (((r >> 3) & 1) << 1); }
__device__ __forceinline__ int s31(int r) { return ((r >> 3) & 1) | (((r >> 1) & 1) << 1); }
__device__ __forceinline__ void gla_secB(const GlaLane& t, const LAS unsigned char* QR, const LAS unsigned char* LR, LAS unsigned char* QTT, LAS unsigned char* KTT, LAS float* vec) {
    const int w = t.w, g = t.g, c = t.c, q = t.q, p = t.p;
    const int k = 16 * w + c;
    const LAS unsigned char* lb8 = vbase(LR + (8 * g + q) * GQ_S + (((16 * w + 4 * p) * 2) ^ ((g & 1) << 7)));
    const LAS unsigned char* lb4 = vbase(LR + (4 * g + q) * GQ_S + (((16 * w + 4 * p) * 2) ^ (((g >> 1) & 1) << 7)));
    const LAS unsigned char* qb4 = vbase(QR + (4 * g + q) * GQ_S + (((16 * w + 4 * p) * 2) ^ (((g >> 1) & 1) << 7)));
    s16x4 b0 = tr16(lb8), b1 = tr16(lb8 + 4 * GQ_S), b2 = tr16(lb8 + 32 * GQ_S), b3 = tr16(lb8 + 36 * GQ_S);
    s16x4 qv[4], lv[4];
#pragma unroll
    for (int lt = 0; lt < 4; ++lt) { qv[lt] = tr16(qb4 + 16 * lt * GQ_S); lv[lt] = tr16(lb4 + 16 * lt * GQ_S); }
    bf16x8 bf[2]; bf[0] = cat8(b0, b1); bf[1] = cat8(b2, b3);
    f32x4 cb[4];
#pragma unroll
    for (int lt = 0; lt < 4; ++lt) {
        cb[lt] = (f32x4){0.f, 0.f, 0.f, 0.f};
#pragma unroll
        for (int ks = 0; ks < 2; ++ks) {
            if (ks == 1 && lt < 2) continue;
            bf16x8 tri;
#pragma unroll
            for (int j = 0; j < 8; ++j) tri[j] = (32 * ks + 8 * g + j <= 16 * lt + c) ? (short)0x3F80 : (short)0;
            cb[lt] = __builtin_amdgcn_mfma_f32_16x16x32_bf16(tri, bf[ks], cb[lt], 0, 0, 0);
        }
    }
    const float bmid = __shfl(cb[2][0], c), blast = __shfl(cb[3][3], 48 + c);
    LAS unsigned char* qw = vbasew(QTT + k * GT_S + 32 * s13(c) + 16 * ((g >> 1) ^ (c & 1)) + 8 * ((g & 1) ^ ((c >> 2) & 1)));
    LAS unsigned char* kw = vbasew(KTT + k * GT_S + 32 * s13(c) + 16 * ((g >> 1) ^ ((c >> 2) & 1)) + 8 * (g & 1));
#pragma unroll
    for (int lt = 0; lt < 4; ++lt) {
        float qt[4], kt[4], fe[4];
#pragma unroll
        for (int e = 0; e < 4; ++e) fe[e] = __builtin_amdgcn_exp2f(bf2f((bf16_t)lv[lt][e]));
        float up[4], dn[4];
        up[0] = __builtin_amdgcn_exp2f(cb[lt][0] - bmid); up[1] = up[0] * fe[1]; up[2] = up[1] * fe[2]; up[3] = up[2] * fe[3];
        dn[3] = __builtin_amdgcn_exp2f(bmid - cb[lt][3]); dn[2] = dn[3] * fe[3]; dn[1] = dn[2] * fe[2]; dn[0] = dn[1] * fe[1];
#pragma unroll
        for (int e = 0; e < 4; ++e) qt[e] = bf2f((bf16_t)qv[lt][e]) * up[e];
        kt[0] = dn[0] - dn[0] * fe[0]; kt[1] = dn[1] - dn[0]; kt[2] = dn[2] - dn[1]; kt[3] = dn[3] - dn[2];
        u32x2 wq, wk; wq.x = cvt_pk_bf16(qt[0], qt[1]); wq.y = cvt_pk_bf16(qt[2], qt[3]); wk.x = cvt_pk_bf16(kt[0], kt[1]); wk.y = cvt_pk_bf16(kt[2], kt[3]);
        *(LAS u32x2*)lxorw(qw, 32 * lt) = wq;
        *(LAS u32x2*)lxorw(kw, 32 * lt) = wk;
    }
    if (g == 0) { vec[k] = __builtin_amdgcn_exp2f(bmid); vec[128 + k] = __builtin_amdgcn_exp2f(blast); vec[256 + k] = __builtin_amdgcn_exp2f(blast - bmid); }
}
__device__ __forceinline__ void gla_secC(const GlaLane& t, const f32x16& S, const LAS float* ebm, LAS unsigned char* ST, const LAS unsigned char* QTT, const LAS unsigned char* KTT, LAS unsigned char* AM) {
    const int w = t.w, g = t.g, c = t.c, q = t.q, p = t.p, hi = t.hi, c32 = t.c32;
    const int kb = w >> 1, vb = w & 1, v = 32 * vb + c32;
    int ti = w;
    int mt = ti < 4 ? 0 : (ti < 7 ? 1 : (ti < 9 ? 2 : 3)), lt = ti - (mt == 0 ? 0 : (mt == 1 ? 3 : (mt == 2 ? 5 : 6)));
    const int sl = s13(8 * g + q);
    const LAS unsigned char* kl0 = vbase(KTT + (8 * g + q) * GT_S + 32 * sl + 16 * (p >> 1) + 8 * (p & 1));
    const LAS unsigned char* kl4 = vbase(KTT + (8 * g + q + 4) * GT_S + 32 * sl + 16 * ((p >> 1) ^ 1) + 8 * (p & 1));
    const LAS unsigned char* ql0 = vbase(QTT + (8 * g + q) * GT_S + 32 * sl + 16 * ((p >> 1) ^ (q & 1)) + 8 * (p & 1));
    const LAS unsigned char* ql4 = vbase(QTT + (8 * g + q + 4) * GT_S + 32 * sl + 16 * ((p >> 1) ^ (q & 1)) + 8 * ((p & 1) ^ 1));
    const LAS unsigned char* ka0 = vbase(lxor(kl0, 32 * mt)); const LAS unsigned char* ka4 = vbase(lxor(kl4, 32 * mt));
    const LAS unsigned char* qa0 = vbase(lxor(ql0, 32 * lt)); const LAS unsigned char* qa4 = vbase(lxor(ql4, 32 * lt));
    s16x4 ka[8], qb[8];
#pragma unroll
    for (int ks = 0; ks < 4; ++ks) { ka[2 * ks] = tr16(ka0 + 32 * ks * GT_S); ka[2 * ks + 1] = tr16(ka4 + 32 * ks * GT_S);
        qb[2 * ks] = tr16(qa0 + 32 * ks * GT_S); qb[2 * ks + 1] = tr16(qa4 + 32 * ks * GT_S); }
    const LAS unsigned char* eb = vbase((const LAS unsigned char*)(ebm + 32 * kb + 4 * hi));
    f32x4 em[4];
#pragma unroll
    for (int gg = 0; gg < 4; ++gg) em[gg] = *(const LAS f32x4*)(eb + 32 * gg);
    const int su = (c32 >> 2) & 1;
    LAS unsigned char* st0 = vbasew(ST + v * GST_S + 64 * kb + 8 * hi + 16 * su);
    LAS unsigned char* st1 = vbasew(ST + v * GST_S + 64 * kb + 8 * hi + 16 * (su ^ 1));
#pragma unroll
    for (int gg = 0; gg < 4; ++gg) {
        u32x2 ws; ws.x = cvt_pk_bf16(S[4 * gg + 0] * em[gg][0], S[4 * gg + 1] * em[gg][1]); ws.y = cvt_pk_bf16(S[4 * gg + 2] * em[gg][2], S[4 * gg + 3] * em[gg][3]);
        *(LAS u32x2*)(((gg & 1) ? st1 : st0) + 32 * (gg >> 1)) = ws;
    }
    LAS unsigned char* aml = vbasew(AM + c * GA_S + 32 * s13(c) + 16 * ((g >> 1) ^ (c & 1)) + 8 * (g & 1));
    for (;;) {
        f32x4 a4 = (f32x4){0.f, 0.f, 0.f, 0.f};
#pragma unroll
        for (int ks = 0; ks < 4; ++ks) a4 = __builtin_amdgcn_mfma_f32_16x16x32_bf16(cat8(ka[2 * ks], ka[2 * ks + 1]), cat8(qb[2 * ks], qb[2 * ks + 1]), a4, 0, 0, 0);
        if (mt == lt) {
#pragma unroll
            for (int r = 0; r < 4; ++r) a4[r] = (4 * g + r <= c) ? a4[r] : 0.f;
        }
        u32x2 wa; wa.x = cvt_pk_bf16(a4[0], a4[1]); wa.y = cvt_pk_bf16(a4[2], a4[3]);
        *(LAS u32x2*)(lxorw(aml, 32 * mt) + 16 * lt * GA_S) = wa;
        ti += 8; if (ti >= 10) break;
        mt = ti < 9 ? 2 : 3; lt = 3;
        const LAS unsigned char* kb0 = vbase(lxor(kl0, 32 * mt)); const LAS unsigned char* kb4 = vbase(lxor(kl4, 32 * mt));
        const LAS unsigned char* qc0 = lxor(ql0, 96); const LAS unsigned char* qc4 = lxor(ql4, 96);
#pragma unroll
        for (int ks = 0; ks < 4; ++ks) { ka[2 * ks] = tr16(kb0 + 32 * ks * GT_S); ka[2 * ks + 1] = tr16(kb4 + 32 * ks * GT_S);
            qb[2 * ks] = tr16(qc0 + 32 * ks * GT_S); qb[2 * ks + 1] = tr16(qc4 + 32 * ks * GT_S); }
    }
}
__device__ __forceinline__ void gla_secD(const GlaLane& t, f32x16& S, const LAS unsigned char* AM, const LAS unsigned char* QTT, const LAS unsigned char* KTT, const LAS unsigned char* VR,
                                         const LAS unsigned char* ST, const LAS float* vec, bf16_t* orow  ) {
    const int w = t.w, g = t.g, c = t.c, q = t.q, p = t.p, hi = t.hi, c32 = t.c32, blk = t.blk;
    const int lt = w & 3, vt0 = 2 * (w >> 2);
    const int nka = lt < 2 ? 1 : 2;
    const int kb = w >> 1, vb = w & 1;
    bf16x8 bA[2], sa[2][4], kaw[4];
    s16x4 bq[8], va[2][4], vw[8];
    const int sl = s13(8 * g + q);
    const LAS unsigned char* amb = vbase(AM + (16 * lt + c) * GA_S + 32 * ((g >> 1) ^ s13(c)) + 16 * ((g & 1) ^ (c & 1)));
    const LAS unsigned char* qt0 = vbase(QTT + (8 * g + q) * GT_S + 32 * (lt ^ sl) + 16 * ((p >> 1) ^ (q & 1)) + 8 * (p & 1));
    const LAS unsigned char* qt4 = vbase(QTT + (8 * g + q + 4) * GT_S + 32 * (lt ^ sl) + 16 * ((p >> 1) ^ (q & 1)) + 8 * ((p & 1) ^ 1));
    const LAS unsigned char* vrb = vbase(VR + (8 * g + q) * GV_S + 32 * (vt0 ^ s31(8 * g + q)) + 8 * p);
    const LAS unsigned char* stb = vbase(ST + (16 * vt0 + c) * GST_S + 32 * (g >> 1) + 16 * ((g & 1) ^ ((c >> 2) & 1)));
#pragma unroll
    for (int ks = 0; ks < 2; ++ks) bA[ks] = *(const LAS bf16x8*)lxor(amb, 64 * ks);
#pragma unroll
    for (int ks = 0; ks < 4; ++ks) { bq[2 * ks] = tr16(qt0 + 32 * ks * GT_S); bq[2 * ks + 1] = tr16(qt4 + 32 * ks * GT_S); }
#pragma unroll
    for (int vi = 0; vi < 2; ++vi) {
        const LAS unsigned char* vv = lxor(vrb, 32 * vi);
#pragma unroll
        for (int ks = 0; ks < 2; ++ks) { va[vi][2 * ks] = tr16(vv + 32 * ks * GV_S); va[vi][2 * ks + 1] = tr16(vv + (32 * ks + 4) * GV_S); }
#pragma unroll
        for (int ks = 0; ks < 4; ++ks) sa[vi][ks] = *(const LAS bf16x8*)(stb + 16 * vi * GST_S + 64 * ks); }
#pragma unroll
    for (int vi = 0; vi < 2; ++vi) {
        const int vt = vt0 + vi;
        f32x4 o4 = (f32x4){0.f, 0.f, 0.f, 0.f};
#pragma unroll
        for (int ks = 0; ks < 2; ++ks) if (ks < nka) o4 = __builtin_amdgcn_mfma_f32_16x16x32_bf16(cat8(va[vi][2 * ks], va[vi][2 * ks + 1]), bA[ks], o4, 0, 0, 0);
#pragma unroll
        for (int ks = 0; ks < 4; ++ks) o4 = __builtin_amdgcn_mfma_f32_16x16x32_bf16(sa[vi][ks], cat8(bq[2 * ks], bq[2 * ks + 1]), o4, 0, 0, 0);
        u32x2 wo; wo.x = cvt_pk_bf16(o4[0], o4[1]); wo.y = cvt_pk_bf16(o4[2], o4[3]);
        gstore<u32x2>(orow + 16 * vt + 4 * g, wo);
    }
    const LAS unsigned char* ktb = vbase(KTT + (32 * kb + c32) * GT_S + 32 * s13(c32) + 16 * (hi ^ ((c32 >> 2) & 1)));
    const LAS unsigned char* vwb = vbase(VR + (8 * hi + q) * GV_S + 32 * ((2 * vb + blk) ^ s31(8 * hi + q)) + 8 * p);
#pragma unroll
    for (int ks = 0; ks < 4; ++ks) { kaw[ks] = *(const LAS bf16x8*)lxor(ktb, 32 * ks);
        vw[2 * ks] = tr16(vwb + 16 * ks * GV_S); vw[2 * ks + 1] = tr16(vwb + (16 * ks + 4) * GV_S); }
    const LAS unsigned char* veb = vbase((const LAS unsigned char*)(vec + 128 + 32 * kb + 4 * hi));
    f32x4 el[4], ed[4];
#pragma unroll
    for (int gg = 0; gg < 4; ++gg) { el[gg] = *(const LAS f32x4*)(veb + 32 * gg); ed[gg] = *(const LAS f32x4*)(veb + 512 + 32 * gg); }
    f32x16 W;
#pragma unroll
    for (int j = 0; j < 16; ++j) W[j] = 0.f;
#pragma unroll
    for (int ks = 0; ks < 4; ++ks) W = __builtin_amdgcn_mfma_f32_32x32x16_bf16(kaw[ks], cat8(vw[2 * ks], vw[2 * ks + 1]), W, 0, 0, 0);
#pragma unroll
    for (int gg = 0; gg < 4; ++gg)
#pragma unroll
        for (int r = 0; r < 4; ++r) S[4 * gg + r] = el[gg][r] * S[4 * gg + r] + ed[gg][r] * W[4 * gg + r];
}

__device__ __forceinline__ void p_gla(const Frame& F0) {
    const Frame F = relaunder(F0);
    const bf16_t* PR = WSP(bf16_t, WS_PROJ);
    LAS unsigned char* L = F.lds;
    const int tid = F.tid, lane = F.lane;
    GlaLane t; t.w = F.wave; t.g = lane >> 4; t.c = lane & 15; t.q = t.c >> 2; t.p = lane & 3; t.hi = lane >> 5; t.c32 = lane & 31; t.blk = (lane >> 4) & 1;
    constexpr int NCH = SEQ / 64;
    for (int un0 = F.vb; un0 < 256; un0 += F.G) {
        const int un = (((un0 >> 5) * 8 + (un0 & 7)) << 2) | ((un0 >> 3) & 3);
        const int b = un >> 5, h = (un >> 2) & 7, dir = (un >> 1) & 1, vh = un & 1;
        bf16_t* O = WSP(bf16_t, dir ? WS_OB : WS_OF);
        const bf16_t* prb = PR + (size_t)b * SEQ * 5120 + h * 128;
        __syncthreads();
        for (int i = tid; i < 64 * GA_S / 4; i += NTHR) ((LAS unsigned*)(L + G_AM))[i] = 0u;
        f32x16 S;
#pragma unroll
        for (int j = 0; j < 16; ++j) S[j] = 0.f;
        u32x4 qreg[2], lreg[2], vreg;
#define GLA_LOAD(n) do { _Pragma("unroll") for (int i_ = 0; i_ < 2; ++i_) { const int idx = tid + 512 * i_, r_ = idx >> 4, c16 = idx & 15; const int tau = (n) * 64 + r_, t_ = dir ? (SEQ - 1 - tau) : tau; \
            const bf16_t* rp = prb + (size_t)t_ * 5120; qreg[i_] = gload<u32x4>(rp + c16 * 8); lreg[i_] = gload<u32x4>(rp + (2 + dir) * 1024 + c16 * 8); } \
          { const int r_ = tid >> 3, c16 = tid & 7; const int tau = (n) * 64 + r_, t_ = dir ? (SEQ - 1 - tau) : tau; vreg = gload<u32x4>(prb + (size_t)t_ * 5120 + 1024 + vh * 64 + c16 * 8); } } while (0)
#define GLA_WRITE(pv) do { _Pragma("unroll") for (int i_ = 0; i_ < 2; ++i_) { const int idx = tid + 512 * i_, r_ = idx >> 4, c16 = idx & 15; \
            const int co_ = (c16 * 16) ^ (((r_ >> 3) & 1) << 7); *(LAS u32x4*)(L + G_QR + r_ * GQ_S + co_) = qreg[i_]; *(LAS u32x4*)(L + G_LR + r_ * GQ_S + co_) = lreg[i_]; } \
          { const int r_ = tid >> 3, c16 = tid & 7; *(LAS u32x4*)(L + G_VR + (pv) * G_VRSZ + r_ * GV_S + 32 * ((c16 >> 1) ^ s31(r_)) + 16 * (c16 & 1)) = vreg; } } while (0)
        GLA_LOAD(0); GLA_WRITE(0); GLA_LOAD(1);
        __syncthreads();
        gla_secB(t, L + G_QR, L + G_LR, L + G_QTT, L + G_KTT, (LAS float*)(L + G_VEC));
        for (int n = 0; n < NCH; ++n) {
            const int pb = n & 1;
            __syncthreads();
            if (n + 1 < NCH) { GLA_WRITE(pb ^ 1); if (n + 2 < NCH) GLA_LOAD(n + 2); }
            gla_secC(t, S, (const LAS float*)(L + G_VEC + pb * G_VECSZ), L + G_ST, L + G_QTT + pb * G_TSZ, L + G_KTT + pb * G_TSZ, L + G_AM);
            __syncthreads();
            { const int tau = n * 64 + 16 * (t.w & 3) + t.c, tt = dir ? (SEQ - 1 - tau) : tau;
              gla_secD(t, S, L + G_AM, L + G_QTT + pb * G_TSZ, L + G_KTT + pb * G_TSZ, L + G_VR + pb * G_VRSZ, L + G_ST, (const LAS float*)(L + G_VEC + pb * G_VECSZ),
                       O + ((size_t)(b * SEQ + tt)) * DM + h * 128 + vh * 64); }
            if (n + 1 < NCH) gla_secB(t, L + G_QR, L + G_LR, L + G_QTT + (pb ^ 1) * G_TSZ, L + G_KTT + (pb ^ 1) * G_TSZ, (LAS float*)(L + G_VEC + (pb ^ 1) * G_VECSZ));
        }
#undef GLA_LOAD
#undef GLA_WRITE
    }
    __syncthreads();
}

__device__ __forceinline__ void p_gate(const Frame& F0) {
    const Frame F = relaunder(F0);
    bf16_t* OFp = WSP(bf16_t, WS_OF); const bf16_t* OBp = WSP(bf16_t, WS_OB); const bf16_t* PR = WSP(bf16_t, WS_PROJ); const float* ng = F.in[10];
    const int ln = F.lane;
    float gv[8];
#pragma unroll
    for (int j = 0; j < 8; ++j) gv[j] = ng[(8 * ln + j) & 127];
    for (int tb = (F.vb * 8 + F.wave) * 2; tb < NTOK; tb += F.G * 8 * 2) {
        u32x4 av[2][2], bv[2][2], gqv[2][2];
#pragma unroll
        for (int u2 = 0; u2 < 2; ++u2)
#pragma unroll
            for (int ii = 0; ii < 2; ++ii) { const int t = tb + u2, c0 = ii * 512 + ln * 8;
                av[u2][ii] = gload<u32x4>(OFp + (size_t)t * DM + c0); bv[u2][ii] = gload<u32x4>(OBp + (size_t)t * DM + c0); gqv[u2][ii] = gload<u32x4>(PR + (size_t)t * 5120 + 4096 + c0); }
#pragma unroll
        for (int u2 = 0; u2 < 2; ++u2)
#pragma unroll
        for (int ii = 0; ii < 2; ++ii) {
            const int t = tb + u2, c0 = ii * 512 + ln * 8;
            const u32x4 a = av[u2][ii], bq = bv[u2][ii], gq = gqv[u2][ii];
            float o[8] = {lo_bf(a.x) + lo_bf(bq.x), hi_bf(a.x) + hi_bf(bq.x), lo_bf(a.y) + lo_bf(bq.y), hi_bf(a.y) + hi_bf(bq.y), lo_bf(a.z) + lo_bf(bq.z), hi_bf(a.z) + hi_bf(bq.z), lo_bf(a.w) + lo_bf(bq.w), hi_bf(a.w) + hi_bf(bq.w)};
            const float gs[8] = {lo_bf(gq.x), hi_bf(gq.x), lo_bf(gq.y), hi_bf(gq.y), lo_bf(gq.z), hi_bf(gq.z), lo_bf(gq.w), hi_bf(gq.w)};
            float q = 0.f;
#pragma unroll
            for (int j = 0; j < 8; ++j) q += o[j] * o[j];
            q += __shfl_xor(q, 1); q += __shfl_xor(q, 2); q += __shfl_xor(q, 4); q += __shfl_xor(q, 8);
            const float rs = rsqrtf(q * (1.0f / 128.0f) + LN_EPS);
#pragma unroll
            for (int j = 0; j < 8; ++j) o[j] = o[j] * rs * gv[j] * gs[j];
            u32x4 w; w.x = cvt_pk_bf16(o[0], o[1]); w.y = cvt_pk_bf16(o[2], o[3]); w.z = cvt_pk_bf16(o[4], o[5]); w.w = cvt_pk_bf16(o[6], o[7]);
            gstore<u32x4>(OFp + (size_t)t * DM + c0, w);
        }
    }
}

constexpr int FILL_TILES = 1, MOE_TILES = 32 * 384;
constexpr int TAIL_GU = 20, TAIL_DN = 16, FILL_L1_FS = 16;
__device__ __forceinline__ int moe_idle_wgs(int ntile, int G) { const int rem = (ntile * 4) % G; return rem > 0 ? G - rem : 0; }
__device__ __forceinline__ int moe_tail_done(int ntile, int G) { const int d = moe_idle_wgs(ntile, G) * (TAIL_GU + TAIL_DN); return d < MOE_TILES ? d : MOE_TILES; }
__device__ __forceinline__ bf16_t* moe_wgu(const Frame& F, int l) { return l ? (bf16_t*)F.out : WSP(bf16_t, WS_WGU); }
__device__ __forceinline__ bf16_t* moe_wdn(const Frame& F, int l) { return l ? (bf16_t*)F.out + (size_t)33554432 : WSP(bf16_t, WS_WDN); }
__device__ __forceinline__ void fill_tile(const Frame& F, int gid) {
    int ln = (int)__builtin_amdgcn_mbcnt_hi(~0u, __builtin_amdgcn_mbcnt_lo(~0u, 0u)); asm volatile("" : "+v"(ln));
    const int l = gid >= MOE_TILES ? 1 : 0, tl = gid - l * MOE_TILES;
    MoeMap M{F.in[19] + (size_t)l * 32 * 524288, F.in[20] + (size_t)l * 32 * 524288, F.in[21] + (size_t)l * 32 * 524288, moe_wgu(F, l), moe_wdn(F, l)};
    const TDesc d = M(tl);
    LAS unsigned char* img = F.lds + (F.wave - 1) * 8192;
    const int kp = ln >> 3, ng = ln & 7;
    f32x4 v[4][2][2];
#pragma unroll
    for (int p = 0; p < 4; ++p)
#pragma unroll
        for (int h = 0; h < 2; ++h) { const float* sp = d.src + (size_t)(16 * p + 2 * kp + h) * d.ldsrc + 8 * ng; v[p][h][0] = gload<f32x4>(sp); v[p][h][1] = gload<f32x4>(sp + 4); }
#pragma unroll
    for (int p = 0; p < 4; ++p)
#pragma unroll
        for (int j = 0; j < 8; ++j) { const int n = 8 * ng + j, kd = (8 * p + kp) ^ (ng << 2);
            *(LAS unsigned*)(img + n * 128 + kd * 4) = cvt_pk_bf16(v[p][0][j >> 2][j & 3], v[p][1][j >> 2][j & 3]); }
    asm volatile("s_waitcnt lgkmcnt(0)" ::: "memory");
#pragma unroll
    for (int r = 0; r < 8; ++r) { const int n = 8 * r + kp, kc = ng;
        const u32x4 w = *(const LAS u32x4*)(img + n * 128 + ((kc ^ r) << 4));
        gstore<u32x4>(d.dst + (size_t)n * d.ldd + 8 * kc, w); }
    asm volatile("s_waitcnt lgkmcnt(0)" ::: "memory");
}
__device__ __forceinline__ void xcd_barrier_fill(const XcdBarrier& b, const Frame& F0, int& fs) {
    asm volatile("s_waitcnt vmcnt(0)" ::: "memory");
    __syncthreads();
    if (b.wave == 0) xcd_barrier_core(b);
    else if (F0.G == 256) {
        const Frame F = relaunder(F0);
#pragma unroll
        for (int i = 0; i < FILL_TILES; ++i) {
            if (fs < 7) { const int q = fs * 7 + (F.wave - 1); const int gid = q * 256 + F.vb; if (gid < MOE_TILES) fill_tile(F, gid); }
            else if (fs >= FILL_L1_FS && fs < FILL_L1_FS + 8) {
                const int ntile = __builtin_amdgcn_readfirstlane(WSP(int, WS_TILEEXP)[320]);
                const int q = (fs - FILL_L1_FS) * 7 + (F.wave - 1); const int tl = moe_tail_done(ntile, F.G) + q * 256 + F.vb; if (tl < MOE_TILES) fill_tile(F, MOE_TILES + tl); }
        }
    }
    ++fs;
    __syncthreads();
}

struct MoeOffMap { MoeMap M; int off; __device__ __forceinline__ TDesc operator()(int tl) const { return M(tl + off); } };
__device__ __forceinline__ void moe_tail_convert(const Frame& F, int ntile, int which) {
    const int idle = moe_idle_wgs(ntile, F.G), rem = F.G - idle, j = F.vb - rem;
    if (F.G != 256 || idle == 0 || j < 0) return;
    const int per = which ? TAIL_DN : TAIL_GU, first = which ? idle * TAIL_GU : 0;
    int cnt = idle * per; if (first + cnt > MOE_TILES) cnt = MOE_TILES - first; if (cnt <= 0) return;
    MoeOffMap T{MoeMap{F.in[19] + (size_t)32 * 524288, F.in[20] + (size_t)32 * 524288, F.in[21] + (size_t)32 * 524288, (bf16_t*)F.out, (bf16_t*)F.out + (size_t)33554432}, first};
    __syncthreads();
    tconv_run_sub(F, cnt, T, j, idle);
}
__device__ __forceinline__ bool phase_in(int lo, int hi, int k) {
#if ONE_LAUNCH
    asm volatile("" : "+s"(lo), "+s"(hi));
#endif
    return lo <= k && k < hi;
}
constexpr int N_PHASES = 34;
__global__ void __launch_bounds__(NTHR, 2) mk_fwd(Args args) {
    extern __shared__ __attribute__((aligned(1024))) unsigned char lds_raw[];
    Frame F0;
    const __attribute__((address_space(4))) Args* kp = (const __attribute__((address_space(4))) Args*)__builtin_amdgcn_kernarg_segment_ptr();
    F0.in = (InPtr)(kp->in); F0.out = kp->out; F0.ws = kp->ws; F0.lds = (LAS unsigned char*)lds_raw;
    F0.tid = threadIdx.x; F0.lane = F0.tid & 63; F0.wave = __builtin_amdgcn_readfirstlane(F0.tid >> 6); F0.G = gridDim.x; F0.vb = blockIdx.x;
    volatile LAS unsigned* misc = (volatile LAS unsigned*)(F0.lds + LDS_MISC);
    if (F0.tid < 4) misc[F0.tid] = 0u;
    __syncthreads();
    XcdBarrier bar; bar.bar = (unsigned*)(F0.ws + WS_CTL); bar.x = 0; bar.st = misc; bar.wave = F0.wave;
#if ONE_LAUNCH
    bar = xcd_barrier_post((unsigned*)(F0.ws + WS_CTL), misc, F0.wave);
#endif
#if ONE_LAUNCH
    int lo = 0, hi = N_PHASES;
#define OPAQUE_RANGE() do { asm volatile("" : "+s"(lo), "+s"(hi)); } while (0)
#else
    const int lo = kp->ph_lo, hi = kp->ph_hi;
#define OPAQUE_RANGE() do { } while (0)
#endif
#ifndef PHASE_MASK
#define PHASE_MASK 0xFFFFFFFFFFull
#endif
#define IN(k) ((((unsigned long long)PHASE_MASK >> (k)) & 1ull) && phase_in(lo, hi, (k)))
#define SEAM(k) do { if (IN(k) && IN((k) + 1)) xcd_barrier_fill(bar, F0, fs); } while (0)
#define INC(k) ((((unsigned long long)PHASE_MASK >> (9 + (k))) & 1ull) && phase_in(lo, hi, pb + (k)))
#define SEAMC(k) do { if (lo <= pb + (k) && pb + (k) + 1 < hi) xcd_barrier_fill(bar, F0, fs); } while (0)

#ifndef REPEAT_MASK
#define REPEAT_MASK 0ull
#endif
#define NREP(k) ((((unsigned long long)REPEAT_MASK >> (k)) & 1ull) ? 2 : 1)
    int fs = 0;
    if (IN(0)) { p_prologue(F0); } SEAM(0);
    if (IN(1)) { p_kv_a(F0); xcd_barrier_fill(bar, F0, fs); p_kv_b(F0, 0); } SEAM(1);
    for (int l = 0; l < 2; ++l) {
        if (l == 0) {
            if (IN(2)) { const Frame F = relaunder(F0); gemm_plain(F, WSP(bf16_t, WS_XB), 1024, WSP(bf16_t, WS_W1CAT), NTOK, 1024, 1024, WSP(bf16_t, WS_U), 1024); } SEAM(2);
            if (IN(3)) { p_pool_hln(F0); } SEAM(3);
            if (IN(4)) { const Frame F = relaunder(F0);
                GemmD g{WSP(bf16_t, WS_PQT), WSP(bf16_t, WS_UN), 128, 512, 128, 128, 128};
                SchedB S = mk_sched(F, 32, 1, 16, 4, 0, (unsigned)256 * 128 * 2, (unsigned)SEQ * 512 * 2, (unsigned)128 * 2, 0, (unsigned)256 * 512 * 2);
                EpiBf16 E{WSP(bf16_t, WS_ZT), 4096, 1, (unsigned)256 * 4096, 0};
                gemm_phase<EpiBf16, SchedB>(F.lds, g, S, E, F.wave);
            } SEAM(4);
            if (IN(5)) { const Frame F = relaunder(F0);
                GemmD g{WSP(bf16_t, WS_W1DFT), WSP(bf16_t, WS_ZT), 128, 64, 128, (unsigned)128 * 4096 * 2, 128};
                SchedB S = mk_sched(F, 32, 1, 32, 1, 0, 0, (unsigned)256 * 4096 * 2, 0, 0, (unsigned)256 * 64 * 2);
                EpiFft1 E{WSP(bf16_t, WS_YP), WSP(float, WS_TW)};
                gemm_phase<EpiFft1, SchedB>(F.lds, g, S, E, F.wave);
            } SEAM(5);
            if (IN(6)) { const Frame F = relaunder(F0);
                GemmD g{WSP(bf16_t, WS_W2DFT), WSP(bf16_t, WS_YP), 128, 128, 128, 128, 128};
                SchedB S = mk_sched(F, 32, 1, 32, 1, 0, 0, (unsigned)8192 * 128 * 2, 0, 0, (unsigned)256 * 128 * 2);
                EpiFft2 E{WSP(bf16_t, WS_YCAT)};
                gemm_phase<EpiFft2, SchedB>(F.lds, g, S, E, F.wave);
            } SEAM(6);
            if (IN(7)) { const Frame F = relaunder(F0); gemm_plain(F, WSP(bf16_t, WS_YCAT), 1024, WSP(bf16_t, WS_PFWOUT), NTOK, 1024, 1024, WSP(bf16_t, WS_H0), 1024); } SEAM(7);
            if (IN(8)) { p_ln<0, false, false>(F0, nullptr, (bf16_t*)(F0.ws + WS_H0), 0, 0); } SEAM(8);
        } else {
            if (IN(19)) { const Frame F = relaunder(F0);
                { GemmD g{WSP(bf16_t, WS_XB), WSP(bf16_t, WS_HGWIN), 1024, 1024, 128, 128, 1024};
                  SchedB S = mk_sched(F, 1, NTOK / 256, 12, 1, 0, 0, 0, 0, (unsigned)256 * 1024 * 2, (unsigned)256 * 1024 * 2);
                  EpiProjA E{WSP(bf16_t, WS_PROJ)};
                  gemm_phase<EpiProjA, SchedB>(F.lds, g, S, E, F.wave); }
                { GemmD g{WSP(bf16_t, WS_XB), WSP(bf16_t, WS_HGWIN) + (size_t)3072 * 1024, 1024, 1024, 128, 128, 1024};
                  SchedB S = mk_sched(F, 1, NTOK / 256, 8, 1, 0, 0, 0, 0, (unsigned)256 * 1024 * 2, (unsigned)256 * 1024 * 2);
                  EpiProjB E{WSP(bf16_t, WS_PROJ), WSP(float, WS_LB1)};
                  gemm_phase<EpiProjB, SchedB>(F.lds, g, S, E, F.wave); }
            } SEAM(19);
            if (IN(20)) { { p_gla(F0); } } SEAM(20);
            if (IN(21)) { p_gate(F0); p_kv_b(F0, 1); } SEAM(21);
            if (IN(22)) { const Frame F = relaunder(F0); gemm_plain(F, WSP(bf16_t, WS_OF), 1024, WSP(bf16_t, WS_HGWOUT), NTOK, 1024, 1024, WSP(bf16_t, WS_OB), 1024); } SEAM(22);
            if (IN(23)) { p_ln<0, false, false>(F0, nullptr, (bf16_t*)(F0.ws + WS_OB), 1, 0); if (F0.G != 256) { __syncthreads(); moe_convert(F0, 1); } } SEAM(23);
        }
        const int pb = l ? 24 : 9;
        if (INC(1)) { const Frame F = relaunder(F0);
            GemmD g{WSP(bf16_t, WS_XB), WSP(bf16_t, WS_KM), 1024, 1024, 128, 128, 1024};
            SchedB S = mk_sched(F, 32, 16, 1, 4, (unsigned)SEQ * 1024 * 2, 0, (unsigned)4 * 256 * 1024 * 2, (unsigned)256 * 1024 * 2, (unsigned)256 * 1024 * 2, 0);
            EpiSoftmax E{WSP(bf16_t, WS_SC), 0.0625f, (LAS float*)(F.lds + STAGE_BYTES)};
            gemm_phase<EpiSoftmax, SchedB>(F.lds, g, S, E, F.wave);
        } SEAMC(1);
        if (INC(3)) { const Frame F = relaunder(F0);
            GemmD g{WSP(bf16_t, WS_SC), WSP(bf16_t, WS_VW), 1024, 1024, 128, 128, 1024};
            SchedB S = mk_sched(F, 8, 16, 4, 1, (unsigned)SEQ * 1024 * 2, 0, (unsigned)1024 * 1024 * 2, 0, (unsigned)256 * 1024 * 2, (unsigned)256 * 1024 * 2);
            EpiBf16 E{WSP(bf16_t, WS_HX), 1024, 1, (unsigned)SEQ * 1024, 0};
            gemm_phase<EpiBf16, SchedB>(F.lds, g, S, E, F.wave);
        } SEAMC(3);
        if (INC(5)) { p_ln<1, false, false>(F0, nullptr, (bf16_t*)(F0.ws + WS_HX), l, 1); } SEAMC(5);
        if (INC(6)) { p_dispatch(F0); } SEAMC(6);
        if (INC(7)) { const Frame F = relaunder(F0);
            const int ntile = __builtin_amdgcn_readfirstlane(WSP(int, WS_TILEEXP)[320]);
            GemmD g{WSP(bf16_t, WS_XB), l ? (bf16_t*)F.out : WSP(bf16_t, WS_WGU), 1024, 1024, 128, 128, 1024};
            const int nmain = (l == 1 && moe_redeal(ntile, F.G)) ? (ntile * 4 / F.G) * (F.G / 4) : ntile;
            SchedMoe<true> S{nmain, 4, F.G, F.vb, WSP(int, WS_TILEEXP), (unsigned)256 * 1024 * 2, (unsigned)256 * 1024 * 2, (unsigned)1048576 * 2, WSP(int, WS_ROWTOK)};
            EpiGU<false> E{WSP(bf16_t, WS_HID), nullptr};
            gemm_phase<EpiGU<false>, SchedMoe<true>>(F.lds, g, S, E, F.wave);
            if (l == 0) moe_tail_convert(F, ntile, 0);
        } SEAMC(7);
        if (INC(8)) { const Frame F = relaunder(F0);
            const int ntile = __builtin_amdgcn_readfirstlane(WSP(int, WS_TILEEXP)[320]);
            GemmD g{WSP(bf16_t, WS_HID), l ? (bf16_t*)F.out + (size_t)33554432 : WSP(bf16_t, WS_WDN), 512, 512, 128, 128, 512};
            EpiDown E{WSP(bf16_t, WS_XSY), WSP(float, WS_GPOS)};
            if (l == 1 && moe_redeal(ntile, F.G)) {
                const int R = ntile * 4 / F.G, rem = ntile * 4 - R * F.G, T0 = R * (F.G / 4), c = F.vb;
                unsigned* cnt = (unsigned*)(F.ws + WS_CTL) + XB_REDEAL;
                if (c < rem) {
                    GemmD gg{WSP(bf16_t, WS_XB), (bf16_t*)F.out, 1024, 1024, 128, 128, 1024};
                    SchedMoeTwo<true> SG{T0, 4, -2 - c, -1, WSP(int, WS_TILEEXP), (unsigned)256 * 1024 * 2, (unsigned)256 * 1024 * 2, (unsigned)1048576 * 2, WSP(int, WS_ROWTOK)};
                    EpiGU<true> EG{WSP(bf16_t, WS_HID), cnt};
                    gemm_phase<EpiGU<true>, SchedMoeTwo<true>>(F.lds, gg, SG, EG, F.wave);
                }
                { SchedMoe<false> SA{T0, 4, F.G, c, WSP(int, WS_TILEEXP), (unsigned)256 * 512 * 2, (unsigned)256 * 512 * 2, (unsigned)524288 * 2, nullptr};
                  SchedMoeLim<false> SL{SA, (R - 1) * F.G};
                  gemm_phase<EpiDown, SchedMoeLim<false>>(F.lds, g, SL, E, F.wave); }
                if (F.wave == 0 && F.lane == 0) { unsigned* bw = (unsigned*)(F.ws + WS_CTL); XB_SPIN(xb_ld(cnt) < (unsigned)(rem * 8), bw); __builtin_amdgcn_fence(__ATOMIC_ACQUIRE, "agent"); }
                __syncthreads();
                { const int j = c - rem;
                  const int code0 = c >= rem ? (R - 1) * F.G + c : -1;
                  const int code1 = (c >= rem && j < 2 * rem) ? (j < rem ? (R - 1) * F.G + j : -2 - (j - rem)) : -1;
                  SchedMoeTwo<false> SB{T0, 4, code0, code1, WSP(int, WS_TILEEXP), (unsigned)256 * 512 * 2, (unsigned)256 * 512 * 2, (unsigned)524288 * 2, nullptr};
                  gemm_phase<EpiDown, SchedMoeTwo<false>>(F.lds, g, SB, E, F.wave); }
            } else {
                SchedMoe<false> S{ntile, 4, F.G, F.vb, WSP(int, WS_TILEEXP), (unsigned)256 * 512 * 2, (unsigned)256 * 512 * 2, (unsigned)524288 * 2, nullptr};
                gemm_phase<EpiDown, SchedMoe<false>>(F.lds, g, S, E, F.wave);
                if (l == 0) moe_tail_convert(F, ntile, 1);
            }
        } SEAMC(8);
        if (INC(9)) { if (l == 0) p_ln<2, false, false>(F0, nullptr, (bf16_t*)(F0.ws + WS_XSY), l, 2); else p_ln<2, false, true>(F0, nullptr, (bf16_t*)(F0.ws + WS_XSY), l, 2); } SEAMC(9);
    }
#undef IN
#undef SEAM
#undef INC
#undef SEAMC
}

extern "C" void kernel_launch(void* const* d_in, const int* in_sizes, int n_in, void* d_out, int out_size, void* d_ws, size_t ws_size, hipStream_t stream) {
    static int grid = 0;
    if (grid == 0) {
        if (n_in != 24 || out_size != NTOK * DM || ws_size < WS_END) { fprintf(stderr, "kernel_launch: unexpected shapes (n_in %d, out %d, ws %zu, need %zu)\n", n_in, out_size, ws_size, (size_t)WS_END); grid = -1; return; }
        int dev = 0, cus = 0;
        if (hipGetDevice(&dev) != hipSuccess || hipDeviceGetAttribute(&cus, hipDeviceAttributeMultiprocessorCount, dev) != hipSuccess) { grid = -1; return; }
        if (hipFuncSetAttribute((const void*)mk_fwd, hipFuncAttributeMaxDynamicSharedMemorySize, LDS_BYTES) != hipSuccess) { fprintf(stderr, "kernel_launch: hipFuncSetAttribute failed\n"); grid = -1; return; }
        int per_cu = 0;
        if (hipOccupancyMaxActiveBlocksPerMultiprocessor(&per_cu, (const void*)mk_fwd, NTHR, LDS_BYTES) != hipSuccess || per_cu < 1) fprintf(stderr, "kernel_launch: occupancy query reports %d\n", per_cu);
        (void)hipGetLastError();
        grid = cus;
    }
    if (grid < 0) return;
    (void)hipMemsetAsync((char*)d_ws + WS_CTL, 0, CTL_ZERO_BYTES, stream);
    Args a{};
    for (int i = 0; i < 24; ++i) a.in[i] = (const float*)d_in[i];
    a.out = (float*)d_out; a.ws = (unsigned char*)d_ws;
#if ONE_LAUNCH
    a.ph_lo = 0; a.ph_hi = N_PHASES;
    hipLaunchKernelGGL(mk_fwd, dim3(grid), dim3(NTHR), LDS_BYTES, stream, a);
#else
    for (int p = 0; p < N_PHASES; ++p) { a.ph_lo = p; a.ph_hi = p + 1; hipLaunchKernelGGL(mk_fwd, dim3(grid), dim3(NTHR), LDS_BYTES, stream, a); }
#endif
}
```

```cpp
#include <hip/hip_runtime.h>
#include <stdint.h>
#include <stdio.h>

#ifndef ONE_LAUNCH
#define ONE_LAUNCH 1
#endif

#define LAS __attribute__((address_space(3)))
typedef unsigned short bf16_t;
typedef short bf16x8 __attribute__((ext_vector_type(8)));
typedef float f32x4 __attribute__((ext_vector_type(4)));
typedef float f32x2 __attribute__((ext_vector_type(2)));
typedef unsigned u32x4 __attribute__((ext_vector_type(4)));
typedef unsigned u32x2 __attribute__((ext_vector_type(2)));

constexpr int NB = 8, SEQ = 4096, DM = 1024, NTOK = NB * SEQ, MEML = 256;
constexpr float DN_ALPHA = 1.4142135623730951f;
constexpr float LN_EPS = 1e-5f;
constexpr int NTHR = 512;
constexpr int LDS_BYTES = 163840;
constexpr int LDS_MISC = 160 * 1024 - 256;

constexpr size_t KiB = 1024, MiB = 1024 * 1024;
constexpr size_t WS_CTL = 0;
constexpr size_t CTL_ZERO_BYTES = 16 * KiB;
constexpr size_t WS_W1DFT = 64 * KiB, WS_W2DFT = 128 * KiB, WS_TW = 192 * KiB, WS_PQT = 256 * KiB, WS_LB1 = 512 * KiB;
constexpr size_t WS_HIST = 576 * KiB, WS_TILEEXP = 640 * KiB;
constexpr size_t WS_ROWTOK = 2 * MiB + 512 * KiB;
constexpr size_t WS_TOKE = 1 * MiB, WS_TOKG = 1 * MiB + 256 * KiB, WS_POSS = 1 * MiB + 512 * KiB, WS_GPOS = 2 * MiB;
constexpr size_t WS_W1CAT = 4 * MiB, WS_PFWOUT = 6 * MiB, WS_HGWIN = 8 * MiB, WS_HGWOUT = 18 * MiB;
constexpr size_t WS_WQN1 = 20 * MiB, WS_WOT1 = 22 * MiB, WS_KB1 = 24 * MiB, WS_VB1 = 28 * MiB, WS_KM = 32 * MiB, WS_VW = 48 * MiB, WS_XB = 64 * MiB;
constexpr size_t ARENA = 128 * MiB;
constexpr size_t WS_WGU = ARENA, WS_WDN = ARENA + 64 * MiB;
constexpr size_t ACT = ARENA + 96 * MiB;
constexpr size_t WS_WK = ACT, WS_WV = ACT + 4 * MiB, WS_MEMBF = ACT + 8 * MiB, WS_WQN0 = ACT + 12 * MiB, WS_WOT0 = ACT + 14 * MiB, WS_KB0 = ACT + 16 * MiB, WS_VB0 = ACT + 20 * MiB;
constexpr size_t WS_U = ACT, WS_UN = ACT + 64 * MiB, WS_YCAT = ACT + 96 * MiB, WS_ZT = ACT + 160 * MiB, WS_YP = ACT + 224 * MiB, WS_H0 = ACT;
constexpr size_t WS_SC = ACT, WS_HX = ACT + 64 * MiB;
constexpr size_t WS_XSY = ACT, WS_HID = ACT + 144 * MiB;
constexpr size_t WS_PROJ = ARENA, WS_OF = ARENA + 320 * MiB, WS_OB = ARENA + 384 * MiB;
constexpr size_t WS_END = ARENA + 448 * MiB;
constexpr int MPAD_MAX = 73728;

__device__ __forceinline__ float bf2f(bf16_t b) { return __uint_as_float(((unsigned)b) << 16); }
typedef __bf16 bf16x2_t __attribute__((ext_vector_type(2)));
__device__ __forceinline__ unsigned cvt_pk_bf16(float lo, float hi) { const bf16x2_t v = __builtin_convertvector((f32x2){lo, hi}, bf16x2_t); return __builtin_bit_cast(unsigned, v); }
__device__ __forceinline__ bf16_t f2bf(float f) { return (bf16_t)(cvt_pk_bf16(f, 0.f) & 0xffffu); }
__device__ __forceinline__ float lo_bf(unsigned w) { return __uint_as_float(w << 16); }
__device__ __forceinline__ float hi_bf(unsigned w) { return __uint_as_float(w & 0xffff0000u); }
__device__ __forceinline__ float fast_sigmoid(float p) { return __builtin_amdgcn_rcpf(1.0f + __builtin_amdgcn_exp2f(p * -1.4426950408889634f)); }
#define GAS __attribute__((address_space(1)))
template <class V> __device__ __forceinline__ void gstore(void* p, const V v) { *(GAS V*)p = v; }
__device__ __forceinline__ void gstore_wt(void* p, const u32x4 v) { asm volatile("global_store_dwordx4 %0, %1, off sc1\n\ts_nop 1" :: "v"(p), "v"(v) : "memory"); }
template <class V> __device__ __forceinline__ V gload(const void* p) { return *(const GAS V*)p; }
__device__ __forceinline__ float wave_sum(float v) {
#pragma unroll
    for (int o = 32; o >= 1; o >>= 1) v += __shfl_xor(v, o);
    return v;
}
__device__ __forceinline__ float wave_max(float v) {
#pragma unroll
    for (int o = 32; o >= 1; o >>= 1) v = fmaxf(v, __shfl_xor(v, o));
    return v;
}

#define XB_TMO      128
#define XB_XCNT(j)  (256  + 64 * (j))
#define XB_XSUB(j)  (1280 + 64 * (j))
#define XB_XGEN(j)  (2304 + 64 * (j))
#define XB_TOP      3328
#define XB_TOPGEN   3392
#define XCD_BAR_WORDS 3456
#define XB_REDEAL 3456
#define XB_SPIN_CAP (1u << 22)

__device__ __forceinline__ unsigned xb_ld(unsigned* p)              { return __hip_atomic_load(p, __ATOMIC_RELAXED, __HIP_MEMORY_SCOPE_AGENT); }
__device__ __forceinline__ unsigned xb_add(unsigned* p, unsigned v) { return __hip_atomic_fetch_add(p, v, __ATOMIC_RELAXED, __HIP_MEMORY_SCOPE_AGENT); }
__device__ __forceinline__ unsigned xb_xcc_id() { return (unsigned)__builtin_amdgcn_s_getreg((3 << 11) | 20) & 0xFu; }
#define XB_SPIN(cond, bar) do { unsigned _sp = 0; while (cond) { __builtin_amdgcn_s_sleep(1); \
    if ((++_sp & 255u) == 0u) { if (xb_ld(&(bar)[XB_TMO])) break; if (_sp > XB_SPIN_CAP) { atomicAdd(&(bar)[XB_TMO], 1u); break; } } } } while (0)

struct XcdBarrier { unsigned* bar; unsigned x; volatile LAS unsigned* st; int wave; };

__device__ __forceinline__ XcdBarrier xcd_barrier_post(unsigned* bar, volatile LAS unsigned* st, int wave_id) {
    XcdBarrier b; b.bar = bar; b.x = xb_xcc_id(); b.st = st; b.wave = wave_id;
    if (wave_id == 0 && __builtin_amdgcn_mbcnt_hi(~0u, __builtin_amdgcn_mbcnt_lo(~0u, 0u)) == 0u) (void)xb_add(&bar[XB_XCNT(b.x)], 1u);
    return b;
}
__device__ __forceinline__ void xcd_barrier_complete(unsigned* bar, unsigned x, unsigned& nloc, unsigned& nx) {
    const unsigned G = gridDim.x * gridDim.y * gridDim.z;
    unsigned sum, cnt, mine, sp = 0u;
    for (;;) {
        sum = 0u; cnt = 0u; mine = 0u;
#pragma unroll
        for (unsigned j = 0; j < 16; ++j) { const unsigned c = xb_ld(&bar[XB_XCNT(j)]); sum += c; cnt += (c > 0u) ? 1u : 0u; mine = (j == x) ? c : mine; }
        if (sum == G) break;
        __builtin_amdgcn_s_sleep(1);
        if ((++sp & 255u) == 0u) { if (xb_ld(&bar[XB_TMO])) break; if (sp > XB_SPIN_CAP) { atomicAdd(&bar[XB_TMO], 1u); break; } }
    }
    nloc = mine > 0u ? mine : 1u; nx = cnt > 0u ? cnt : 1u;
}
__device__ __forceinline__ void xcd_barrier_core(const XcdBarrier& b) {
    if (b.wave == 0 && __builtin_amdgcn_mbcnt_hi(~0u, __builtin_amdgcn_mbcnt_lo(~0u, 0u)) == 0u) {
        unsigned* bar = b.bar;
        __builtin_amdgcn_s_waitcnt(0);
        unsigned nloc = b.st[0], nx = b.st[1];
        if (nloc == 0u) { xcd_barrier_complete(bar, b.x, nloc, nx); b.st[0] = nloc; b.st[1] = nx; }
        const unsigned old = xb_add(&bar[XB_XSUB(b.x)], 1u);
        const unsigned gen = old / nloc;
        if (old + 1u == (gen + 1u) * nloc) {
            __builtin_amdgcn_fence(__ATOMIC_RELEASE, "agent");
            asm volatile("s_waitcnt vmcnt(0)" ::: "memory");
            const unsigned og = xb_add(&bar[XB_TOP], 1u);
            const unsigned tg = og / nx;
            if (og + 1u == (tg + 1u) * nx) xb_add(&bar[XB_TOPGEN], 1u);
            else XB_SPIN(xb_ld(&bar[XB_TOPGEN]) == tg, bar);
            __builtin_amdgcn_fence(__ATOMIC_ACQUIRE, "agent");
            xb_add(&bar[XB_XGEN(b.x)], 1u);
            asm volatile("s_waitcnt vmcnt(0)" ::: "memory");
        } else {
            XB_SPIN(xb_ld(&bar[XB_XGEN(b.x)]) == gen, bar);
            __builtin_amdgcn_fence(__ATOMIC_ACQUIRE, "agent");
            asm volatile("s_waitcnt vmcnt(0)" ::: "memory");
        }
    }
}
__device__ __forceinline__ void xcd_barrier(const XcdBarrier& b) {
    asm volatile("s_waitcnt vmcnt(0)" ::: "memory");
    __syncthreads();
    xcd_barrier_core(b);
    __syncthreads();
}

constexpr int BM = 256, BK = 64, HALF = 128, HTB = HALF * BK * 2, STAGE_BYTES = 8 * HTB, NXCD = 8, WGM = 8;

__device__ __forceinline__ int lds_byte(int r, int c) { const int st = (r >> 4) * 2 + (c >> 5), rr = r & 15, cc = c & 31, ob = rr * 64 + cc * 2; return st * 1024 + (ob ^ (((ob >> 9) & 1) << 5)); }
__device__ __forceinline__ void stage_rc(int b, int& R, int& C) { const int st = b / 1024, sb = b % 1024, swz = sb ^ (((sb >> 9) & 1) << 5); R = (st >> 1) * 16 + swz / 64; C = (st & 1) * 32 + (swz % 64) / 2; }
__device__ __forceinline__ int perm32(int rho) { const int n = rho >> 4, i = rho & 15; return 8 * (i >> 2) + 4 * n + (i & 3); }

struct GemmD { const bf16_t* A; const bf16_t* B; int lda, ldb; unsigned kstepA, kstepB; int K; };
struct Unit { int pm, pn, b; unsigned offA, offB; };

struct SchedB {
    static constexpr bool GATHER = false;
    int nM, nN, nB, G, c, bdiv; unsigned bsA_hi, bsA_lo, bsB_hi, bsB_lo, tsA, tsB;
    __device__ __forceinline__ bool next(int i, Unit& u) const {
        const int nMt = nB * nM, nwg = nMt * nN;
        const long L = (unsigned)i * G + c; if (L >= nwg) return false;
        int wgid = (int)L; { const int q = nwg / NXCD, r = nwg % NXCD, xcd = wgid % NXCD, off = wgid / NXCD; wgid = (xcd < r ? xcd * (q + 1) : r * (q + 1) + (xcd - r) * q) + off; }
        const int nig = WGM * nN, gid = wgid / nig, fm = gid * WGM, gsz = (nMt - fm) < WGM ? (nMt - fm) : WGM;
        const int pmt = fm + ((wgid % nig) % gsz); u.pn = (wgid % nig) / gsz;
        u.b = pmt / nM; u.pm = pmt - u.b * nM;
        const int hi = u.b / bdiv, lo = u.b - hi * bdiv;
        u.offA = (unsigned)hi * bsA_hi + (unsigned)lo * bsA_lo + (unsigned)u.pm * tsA; u.offB = (unsigned)hi * bsB_hi + (unsigned)lo * bsB_lo + (unsigned)u.pn * tsB;
        return true;
    }
};
template <bool GATHER_>
struct SchedMoe {
    static constexpr bool GATHER = GATHER_;
    int nM, nN, G, c; const int* tile_exp; unsigned tsA, tsB, esB; const int* rowtok;
    __device__ __forceinline__ bool next(int i, Unit& u) const {
        const int nwg = nM * nN;
        const long L = (unsigned)i * G + c; if (L >= nwg) return false;
        int wgid = (int)L; { const int q = nwg / NXCD, r = nwg % NXCD, xcd = wgid % NXCD, off = wgid / NXCD; wgid = (xcd < r ? xcd * (q + 1) : r * (q + 1) + (xcd - r) * q) + off; }
        const int nig = WGM * nN, gid = wgid / nig, fm = gid * WGM, gsz = (nM - fm) < WGM ? (nM - fm) : WGM;
        u.pm = fm + ((wgid % nig) % gsz); u.pn = (wgid % nig) / gsz;
        u.b = __builtin_amdgcn_readfirstlane(tile_exp[u.pm]);
        u.offA = (unsigned)u.pm * tsA; u.offB = (unsigned)u.b * esB + (unsigned)u.pn * tsB;
        return true;
    }
};

template <bool GATHER_>
struct SchedMoeLim {
    static constexpr bool GATHER = GATHER_;
    SchedMoe<GATHER_> S; int lim; const int* rowtok = nullptr;
    __device__ __forceinline__ bool next(int i, Unit& u) const { if ((long)i * S.G + S.c >= lim) return false; return S.next(i, u); }
};
__device__ __forceinline__ bool moe_redeal(int ntile, int G) { const int nun = ntile * 4, R = nun / G, rem = nun - R * G; return G == 256 && rem > 0 && 3 * rem <= G && R >= 2; }
template <bool GATHER_>
struct SchedMoeTwo {
    static constexpr bool GATHER = GATHER_;
    int nM0, nN, code0, code1; const int* tile_exp; unsigned tsA, tsB, esB; const int* rowtok;
    __device__ __forceinline__ bool next(int i, Unit& u) const {
        if (i > 1) return false;
        const int code = i ? code1 : code0; if (code == -1) return false;
        if (code >= 0) {
            const int nwg = nM0 * nN;
            int wgid = code; { const int q = nwg / NXCD, r = nwg % NXCD, xcd = wgid % NXCD, off = wgid / NXCD; wgid = (xcd < r ? xcd * (q + 1) : r * (q + 1) + (xcd - r) * q) + off; }
            const int nig = WGM * nN, gid = wgid / nig, fm = gid * WGM, gsz = (nM0 - fm) < WGM ? (nM0 - fm) : WGM;
            u.pm = fm + ((wgid % nig) % gsz); u.pn = (wgid % nig) / gsz;
        } else { const int k = -2 - code; u.pm = nM0 + k / nN; u.pn = k % nN; }
        u.b = __builtin_amdgcn_readfirstlane(tile_exp[u.pm]);
        u.offA = (unsigned)u.pm * tsA; u.offB = (unsigned)u.b * esB + (unsigned)u.pn * tsB;
        return true;
    }
};
struct EpiBf16 {
    static constexpr bool PERM = true;
    bf16_t* O; int ldc; int bdiv; unsigned bs_hi, bs_lo;
    __device__ __forceinline__ void operator()(f32x4 (&acc)[2][2][4][2], const Unit& u, int wr, int wc, int fr_, int fq_) const {
        int fr = fr_, fq = fq_; asm volatile("" : "+v"(fr), "+v"(fq));
        const int hi = u.b / bdiv, lo = u.b - hi * bdiv;
        bf16_t* base = O + (size_t)((unsigned)hi * bs_hi + (unsigned)lo * bs_lo);
        const int row0 = u.pm * BM + wr * 64 + fr, col0 = u.pn * BM + wc * 32 + 8 * fq;
#pragma unroll
        for (int ai = 0; ai < 2; ++ai)
#pragma unroll
            for (int m = 0; m < 4; ++m) { bf16_t* rowp = base + (size_t)(row0 + ai * HALF + m * 16) * ldc + col0;
#pragma unroll
                for (int bj = 0; bj < 2; ++bj) { const f32x4 v0 = acc[ai][bj][m][0], v1 = acc[ai][bj][m][1];
                    u32x4 w; w.x = cvt_pk_bf16(v0[0], v0[1]); w.y = cvt_pk_bf16(v0[2], v0[3]); w.z = cvt_pk_bf16(v1[0], v1[1]); w.w = cvt_pk_bf16(v1[2], v1[3]);
                    gstore<u32x4>(rowp + bj * HALF, w); } }
    }
};
struct EpiSoftmax {
    static constexpr bool PERM = true;
    bf16_t* P; float scale; LAS float* ex;
    __device__ __forceinline__ void operator()(f32x4 (&acc)[2][2][4][2], const Unit& u, int wr, int wc, int fr_, int fq_) const {
        int fr = fr_, fq = fq_; asm volatile("" : "+v"(fr), "+v"(fq));
#pragma unroll
        for (int ai = 0; ai < 2; ++ai)
#pragma unroll
            for (int m = 0; m < 4; ++m) {
                float mx = -3.0e38f;
#pragma unroll
                for (int bj = 0; bj < 2; ++bj)
#pragma unroll
                    for (int n = 0; n < 2; ++n) { acc[ai][bj][m][n] = acc[ai][bj][m][n] * scale; const f32x4 x = acc[ai][bj][m][n]; mx = fmaxf(mx, fmaxf(fmaxf(x[0], x[1]), fmaxf(x[2], x[3]))); }
                mx = fmaxf(mx, __shfl_xor(mx, 16)); mx = fmaxf(mx, __shfl_xor(mx, 32));
                float sm = 0.f;
#pragma unroll
                for (int bj = 0; bj < 2; ++bj)
#pragma unroll
                    for (int n = 0; n < 2; ++n) { f32x4 x = acc[ai][bj][m][n]; x[0] = __expf(x[0] - mx); x[1] = __expf(x[1] - mx); x[2] = __expf(x[2] - mx); x[3] = __expf(x[3] - mx); acc[ai][bj][m][n] = x; sm += (x[0] + x[1]) + (x[2] + x[3]); }
                sm += __shfl_xor(sm, 16); sm += __shfl_xor(sm, 32);
                if (fq == 0) *(LAS f32x2*)(ex + ((ai * HALF + wr * 64 + m * 16 + fr) * 4 + wc) * 2) = (f32x2){mx, sm};
            }
        asm volatile("s_waitcnt lgkmcnt(0)" ::: "memory"); __builtin_amdgcn_s_barrier(); asm volatile("" ::: "memory");
        bf16_t* base = P + ((size_t)(u.b >> 2) * SEQ + (size_t)(u.pm * BM + wr * 64 + fr)) * 1024 + (u.b & 3) * 256 + wc * 32 + 8 * fq;
#pragma unroll
        for (int ai = 0; ai < 2; ++ai)
#pragma unroll
            for (int m = 0; m < 4; ++m) {
                const LAS float* ep = ex + (ai * HALF + wr * 64 + m * 16 + fr) * 8;
                const f32x4 a = *(const LAS f32x4*)ep, b = *(const LAS f32x4*)(ep + 4);
                const float M = fmaxf(fmaxf(a[0], a[2]), fmaxf(b[0], b[2]));
                const float tot = a[1] * __expf(a[0] - M) + a[3] * __expf(a[2] - M) + b[1] * __expf(b[0] - M) + b[3] * __expf(b[2] - M);
                const float f = __expf(ep[2 * wc] - M) / tot;
                bf16_t* rowp = base + (size_t)(ai * HALF + m * 16) * 1024;
#pragma unroll
                for (int bj = 0; bj < 2; ++bj) { const f32x4 v0 = acc[ai][bj][m][0] * f, v1 = acc[ai][bj][m][1] * f;
                    u32x4 w; w.x = cvt_pk_bf16(v0[0], v0[1]); w.y = cvt_pk_bf16(v0[2], v0[3]); w.z = cvt_pk_bf16(v1[0], v1[1]); w.w = cvt_pk_bf16(v1[2], v1[3]);
                    gstore<u32x4>(rowp + bj * HALF, w); }
            }
    }
};
struct EpiFft1 {
    static constexpr bool PERM = true;
    bf16_t* Y; const float* tw;
    __device__ __forceinline__ void operator()(f32x4 (&acc)[2][2][4][2], const Unit& u, int wr, int wc, int fr_, int fq_) const {
        int fr = fr_, fq = fq_; asm volatile("" : "+v"(fr), "+v"(fq));
        bf16_t* base = Y + (size_t)u.b * (64 * 128 * 2 * 64);
#pragma unroll
        for (int bj = 0; bj < 2; ++bj) {
            const int c0 = u.pn * BM + bj * HALF + wc * 32 + 8 * fq, d = c0 >> 6, a0 = c0 & 63;
#pragma unroll
            for (int hf = 0; hf < 2; ++hf) {
                const int e = 32 * wr + 16 * hf + fr;
                const float* twp = tw + ((size_t)e * 64 + a0) * 2;
                const f32x4 t0 = gload<f32x4>(twp), t1 = gload<f32x4>(twp + 4), t2 = gload<f32x4>(twp + 8), t3 = gload<f32x4>(twp + 12);
                const f32x4 re0 = acc[0][bj][hf][0], re1 = acc[0][bj][hf][1], im0 = acc[0][bj][hf + 2][0], im1 = acc[0][bj][hf + 2][1];
                float yr[8], yi[8];
                yr[0] = re0[0] * t0[0] - im0[0] * t0[1]; yi[0] = re0[0] * t0[1] + im0[0] * t0[0];
                yr[1] = re0[1] * t0[2] - im0[1] * t0[3]; yi[1] = re0[1] * t0[3] + im0[1] * t0[2];
                yr[2] = re0[2] * t1[0] - im0[2] * t1[1]; yi[2] = re0[2] * t1[1] + im0[2] * t1[0];
                yr[3] = re0[3] * t1[2] - im0[3] * t1[3]; yi[3] = re0[3] * t1[3] + im0[3] * t1[2];
                yr[4] = re1[0] * t2[0] - im1[0] * t2[1]; yi[4] = re1[0] * t2[1] + im1[0] * t2[0];
                yr[5] = re1[1] * t2[2] - im1[1] * t2[3]; yi[5] = re1[1] * t2[3] + im1[1] * t2[2];
                yr[6] = re1[2] * t3[0] - im1[2] * t3[1]; yi[6] = re1[2] * t3[1] + im1[2] * t3[0];
                yr[7] = re1[3] * t3[2] - im1[3] * t3[3]; yi[7] = re1[3] * t3[3] + im1[3] * t3[2];
                bf16_t* p = base + (((size_t)e * 128 + d) * 2) * 64 + a0;
                u32x4 wr4, wi4;
                wr4.x = cvt_pk_bf16(yr[0], yr[1]); wr4.y = cvt_pk_bf16(yr[2], yr[3]); wr4.z = cvt_pk_bf16(yr[4], yr[5]); wr4.w = cvt_pk_bf16(yr[6], yr[7]);
                wi4.x = cvt_pk_bf16(yi[0], yi[1]); wi4.y = cvt_pk_bf16(yi[2], yi[3]); wi4.z = cvt_pk_bf16(yi[4], yi[5]); wi4.w = cvt_pk_bf16(yi[6], yi[7]);
                gstore<u32x4>(p, wr4); gstore<u32x4>(p + 64, wi4);
            }
        }
    }
};
struct EpiFft2 {
    static constexpr bool PERM = true;
    bf16_t* Yc;
    __device__ __forceinline__ void operator()(f32x4 (&acc)[2][2][4][2], const Unit& u, int wr, int wc, int fr_, int fq_) const {
        int fr = fr_, fq = fq_; asm volatile("" : "+v"(fr), "+v"(fq));
        if (wr != 0) return;
        const int b = u.b >> 2, h = u.b & 3;
#pragma unroll
        for (int bj = 0; bj < 2; ++bj) {
            const int n0 = u.pn * BM + bj * HALF + wc * 32 + 8 * fq, e = n0 >> 7, d0 = n0 & 127;
#pragma unroll
            for (int m = 0; m < 4; ++m) {
                const int c = 16 * m + fr, sp = 64 * c + e;
                bf16_t* p = Yc + ((size_t)(b * SEQ + sp)) * DM + 512 + h * 128 + d0;
                const f32x4 v0 = acc[0][bj][m][0], v1 = acc[0][bj][m][1];
                u32x4 w; w.x = cvt_pk_bf16(v0[0], v0[1]); w.y = cvt_pk_bf16(v0[2], v0[3]); w.z = cvt_pk_bf16(v1[0], v1[1]); w.w = cvt_pk_bf16(v1[2], v1[3]);
                *(u32x4*)p = w;
            }
        }
    }
};
template <bool WT>
struct EpiGU {
    static constexpr bool PERM = true;
    bf16_t* Hd;
    unsigned* cnt;
    __device__ __forceinline__ void operator()(f32x4 (&acc)[2][2][4][2], const Unit& u, int wr, int wc, int fr_, int fq_) const {
        int fr = fr_, fq = fq_; asm volatile("" : "+v"(fr), "+v"(fq));
        const int row0 = u.pm * BM + wr * 64 + fr, col0 = u.pn * 128 + wc * 32 + 8 * fq;
#pragma unroll
        for (int ai = 0; ai < 2; ++ai)
#pragma unroll
            for (int m = 0; m < 4; ++m) {
                float o[8];
#pragma unroll
                for (int n = 0; n < 2; ++n)
#pragma unroll
                    for (int j = 0; j < 4; ++j) { const float g = acc[ai][0][m][n][j], up = acc[ai][1][m][n][j]; o[n * 4 + j] = g * fast_sigmoid(g) * up; }
                u32x4 w; w.x = cvt_pk_bf16(o[0], o[1]); w.y = cvt_pk_bf16(o[2], o[3]); w.z = cvt_pk_bf16(o[4], o[5]); w.w = cvt_pk_bf16(o[6], o[7]);
                if constexpr (WT) gstore_wt(Hd + (size_t)(row0 + ai * HALF + m * 16) * 512 + col0, w); else gstore<u32x4>(Hd + (size_t)(row0 + ai * HALF + m * 16) * 512 + col0, w);
            }
        if constexpr (WT) { asm volatile("s_waitcnt vmcnt(0)" ::: "memory"); if ((fr | fq) == 0) (void)xb_add(cnt, 1u); }
    }
};
struct EpiDown {
    static constexpr bool PERM = true;
    bf16_t* Y; const float* gpos;
    __device__ __forceinline__ void operator()(f32x4 (&acc)[2][2][4][2], const Unit& u, int wr, int wc, int fr_, int fq_) const {
        int fr = fr_, fq = fq_; asm volatile("" : "+v"(fr), "+v"(fq));
        const int row0 = u.pm * BM + wr * 64 + fr, col0 = u.pn * BM + wc * 32 + 8 * fq;
#pragma unroll
        for (int ai = 0; ai < 2; ++ai)
#pragma unroll
            for (int m = 0; m < 4; ++m) { const int row = row0 + ai * HALF + m * 16; const float gt = gpos[row]; bf16_t* rowp = Y + (size_t)row * DM + col0;
#pragma unroll
                for (int bj = 0; bj < 2; ++bj) { const f32x4 v0 = acc[ai][bj][m][0] * gt, v1 = acc[ai][bj][m][1] * gt;
                    u32x4 w; w.x = cvt_pk_bf16(v0[0], v0[1]); w.y = cvt_pk_bf16(v0[2], v0[3]); w.z = cvt_pk_bf16(v1[0], v1[1]); w.w = cvt_pk_bf16(v1[2], v1[3]);
                    gstore<u32x4>(rowp + bj * HALF, w); } }
    }
};
struct EpiProjA {
    static constexpr bool PERM = true;
    bf16_t* P;
    __device__ __forceinline__ void operator()(f32x4 (&acc)[2][2][4][2], const Unit& u, int wr, int wc, int fr_, int fq_) const {
        int fr = fr_, fq = fq_; asm volatile("" : "+v"(fr), "+v"(fq));
        const int sec = u.pn >> 2;
        const int row0 = u.pm * BM + wr * 64 + fr, col0 = (sec == 2 ? 4096 : sec * 1024) + (u.pn & 3) * BM + wc * 32 + 8 * fq;
        if (sec == 1) {
#pragma unroll
            for (int ai = 0; ai < 2; ++ai)
#pragma unroll
                for (int m = 0; m < 4; ++m) { bf16_t* rowp = P + (size_t)(row0 + ai * HALF + m * 16) * 5120 + col0;
#pragma unroll
                    for (int bj = 0; bj < 2; ++bj) { const f32x4 v0 = acc[ai][bj][m][0], v1 = acc[ai][bj][m][1];
                        u32x4 w; w.x = cvt_pk_bf16(v0[0], v0[1]); w.y = cvt_pk_bf16(v0[2], v0[3]); w.z = cvt_pk_bf16(v1[0], v1[1]); w.w = cvt_pk_bf16(v1[2], v1[3]);
                        gstore<u32x4>(rowp + bj * HALF, w); } }
        } else {
#pragma unroll
            for (int ai = 0; ai < 2; ++ai)
#pragma unroll
                for (int m = 0; m < 4; ++m) { bf16_t* rowp = P + (size_t)(row0 + ai * HALF + m * 16) * 5120 + col0;
#pragma unroll
                    for (int bj = 0; bj < 2; ++bj) {
                        float o[8];
#pragma unroll
                        for (int n = 0; n < 2; ++n)
#pragma unroll
                            for (int j = 0; j < 4; ++j) { const float p = acc[ai][bj][m][n][j]; o[n * 4 + j] = p * fast_sigmoid(p); }
                        u32x4 w; w.x = cvt_pk_bf16(o[0], o[1]); w.y = cvt_pk_bf16(o[2], o[3]); w.z = cvt_pk_bf16(o[4], o[5]); w.w = cvt_pk_bf16(o[6], o[7]);
                        gstore<u32x4>(rowp + bj * HALF, w); } }
        }
    }
};
struct EpiProjB {
    static constexpr bool PERM = true;
    bf16_t* P; const float* lb;
    __device__ __forceinline__ void operator()(f32x4 (&acc)[2][2][4][2], const Unit& u, int wr, int wc, int fr_, int fq_) const {
        int fr = fr_, fq = fq_; asm volatile("" : "+v"(fr), "+v"(fq));
        const int row0 = u.pm * BM + wr * 64 + fr, col0 = u.pn * BM + wc * 32 + 8 * fq;
        float lbv[2][8];
#pragma unroll
        for (int bj = 0; bj < 2; ++bj) { const float* lp = lb + col0 + bj * HALF; const f32x4 l0 = *(const f32x4*)lp, l1 = gload<f32x4>(lp + 4);
#pragma unroll
            for (int j = 0; j < 4; ++j) { lbv[bj][j] = l0[j]; lbv[bj][4 + j] = l1[j]; } }
#pragma unroll
        for (int ai = 0; ai < 2; ++ai)
#pragma unroll
            for (int m = 0; m < 4; ++m) { bf16_t* rowp = P + (size_t)(row0 + ai * HALF + m * 16) * 5120 + 2048 + col0;
#pragma unroll
                for (int bj = 0; bj < 2; ++bj) {
                    float o[8];
#pragma unroll
                    for (int n = 0; n < 2; ++n)
#pragma unroll
                        for (int j = 0; j < 4; ++j) { const float sg = fast_sigmoid(acc[ai][bj][m][n][j]); o[n * 4 + j] = __builtin_amdgcn_logf(sg + lbv[bj][n * 4 + j] * (1.0f - sg)); }
                    u32x4 w; w.x = cvt_pk_bf16(o[0], o[1]); w.y = cvt_pk_bf16(o[2], o[3]); w.z = cvt_pk_bf16(o[4], o[5]); w.w = cvt_pk_bf16(o[6], o[7]);
                    gstore<u32x4>(rowp + bj * HALF, w); } }
    }
};

template <class Epi, class Sched>
__device__ __forceinline__ void gemm_phase(LAS unsigned char* lds, const GemmD g, const Sched& S, const Epi& E, const int wave_id) {
    int lane_ = (int)__builtin_amdgcn_mbcnt_hi(~0u, __builtin_amdgcn_mbcnt_lo(~0u, 0u)); asm volatile("" : "+v"(lane_));
    const int lane = lane_, wid = wave_id, tid = wid * 64 + lane, wr = wid >> 2, wc = wid & 3, fr = lane & 15, fq = lane >> 4;
    const int nt = g.K / BK;
    unsigned voffA[2], voffB[2];
#pragma unroll
    for (int i = 0; i < 2; ++i) { int R, C; stage_rc(tid * 16 + i * 8192, R, C); const int Rb = Epi::PERM ? ((R & ~31) + perm32(R & 31)) : R;
        voffA[i] = (unsigned)(R * g.lda + C) * 2u; voffB[i] = (unsigned)(Rb * g.ldb + C) * 2u; }
    const unsigned kstepA = g.kstepA, kstepB = g.kstepB;
    const unsigned hstepA = (unsigned)HALF * g.lda * 2, hstepB = (unsigned)HALF * g.ldb * 2;
    unsigned gcur[2][2], gnxt[2][2]; int gR[2], gC[2];
#pragma unroll
    for (int i = 0; i < 2; ++i) { stage_rc(tid * 16 + i * 8192, gR[i], gC[i]); }
#define PG8_GLOAD(dst, pm_) do { if constexpr (Sched::GATHER) { _Pragma("unroll") for (int h_ = 0; h_ < 2; ++h_) _Pragma("unroll") for (int i_ = 0; i_ < 2; ++i_) \
        dst[h_][i_] = (unsigned)S.rowtok[(pm_) * BM + h_ * HALF + gR[i_]] * (unsigned)(g.lda * 2) + (unsigned)gC[i_] * 2u; } } while (0)
#define PG8_STAGE_A(b, h, pn_, pg_, gv_) do { if constexpr (Sched::GATHER) PG8_STAGE(PG8_SA(b, h), pg_, gv_); else PG8_STAGE(PG8_SA(b, h), pn_, voffA); } while (0)
    const unsigned ldsw = (unsigned)wid * 1024u;
    const int aoff = lds_byte(wr * 64 + fr, fq * 8), boff = lds_byte(wc * 32 + fr, fq * 8);
#define PG8_SA(b, h) (((b) * 2 + (h)) * HTB)
#define PG8_SB(b, h) ((4 + (b) * 2 + (h)) * HTB)
#define PG8_STAGE(bufoff, gbase, voff) do { _Pragma("unroll") for (int _i = 0; _i < 2; ++_i) \
        __builtin_amdgcn_global_load_lds((const unsigned*)((const char*)(gbase) + (voff)[_i]), (LAS unsigned*)(lds + (bufoff) + ldsw + _i * 8192), 16, 0, 0); } while (0)
#define PG8_LDA(dst, b, h) do { _Pragma("unroll") for (int m = 0; m < 4; ++m) _Pragma("unroll") for (int k = 0; k < 2; ++k) dst[m][k] = *(const LAS bf16x8*)(lds + PG8_SA(b, h) + aoff + m * 2048 + k * 1024); } while (0)
#define PG8_LDB(dst, b, h) do { _Pragma("unroll") for (int n = 0; n < 2; ++n) _Pragma("unroll") for (int k = 0; k < 2; ++k) dst[n][k] = *(const LAS bf16x8*)(lds + PG8_SB(b, h) + boff + n * 2048 + k * 1024); } while (0)
#define PG8_MMA(ai, bj, At, Bt) do { __builtin_amdgcn_s_setprio(1); _Pragma("unroll") for (int m = 0; m < 4; ++m) _Pragma("unroll") for (int n = 0; n < 2; ++n) _Pragma("unroll") for (int k = 0; k < 2; ++k) \
        acc[ai][bj][m][n] = __builtin_amdgcn_mfma_f32_16x16x32_bf16(Bt[n][k], At[m][k], acc[ai][bj][m][n], 0, 0, 0); __builtin_amdgcn_s_setprio(0); } while (0)
#define PG8_WAIT_V(n) asm volatile("s_waitcnt vmcnt(" #n ")" ::: "memory")
#define PG8_WAIT_L(n) asm volatile("s_waitcnt lgkmcnt(" #n ")" ::: "memory")
#define PG8_BAR __builtin_amdgcn_s_barrier()
#define PG8_SCHED __builtin_amdgcn_sched_barrier(0)
    Unit cur, nxt; int ui = 0;
    if (!S.next(0, cur)) return;
    f32x4 acc[2][2][4][2];
#pragma unroll
    for (int a = 0; a < 2; ++a)
#pragma unroll
        for (int b = 0; b < 2; ++b)
#pragma unroll
            for (int m = 0; m < 4; ++m)
#pragma unroll
                for (int n = 0; n < 2; ++n) acc[a][b][m][n] = (f32x4){0.f, 0.f, 0.f, 0.f};
    bf16x8 At[4][2], B0[2][2], B1[2][2];
    const char* cA = (const char*)g.A + (Sched::GATHER ? 0u : cur.offA); const char* cB = (const char*)g.B + cur.offB;
    PG8_GLOAD(gcur, cur.pm);
    PG8_STAGE(PG8_SB(0, 0), cB, voffB); PG8_STAGE_A(0, 0, cA, cA, gcur[0]); PG8_STAGE(PG8_SB(0, 1), cB + hstepB, voffB); PG8_STAGE_A(0, 1, cA + hstepA, cA, gcur[1]);
    if (wr == 1) PG8_BAR;
    PG8_WAIT_V(4); PG8_BAR;
    PG8_STAGE(PG8_SB(1, 0), cB + kstepB, voffB); PG8_STAGE_A(1, 0, cA + kstepA, cA + kstepA, gcur[0]); PG8_STAGE(PG8_SB(1, 1), cB + hstepB + kstepB, voffB);
    PG8_WAIT_V(6); PG8_BAR;
    for (;;) {
        const bool has_next = S.next(ui + 1, nxt);
        const char* nA = has_next ? (const char*)g.A + (Sched::GATHER ? 0u : nxt.offA) : cA; const char* nB = has_next ? (const char*)g.B + nxt.offB : cB;
        if constexpr (Sched::GATHER) { if (has_next) PG8_GLOAD(gnxt, nxt.pm); else {
#pragma unroll
            for (int h_ = 0; h_ < 2; ++h_) { gnxt[h_][0] = gcur[h_][0]; gnxt[h_][1] = gcur[h_][1]; } } }
        for (int t = 0; t < nt; t += 2) {
            const bool last = (t == nt - 2);
            const char* a1 = cA + (size_t)(t + 1) * kstepA;
            const char* a2 = last ? nA : cA + (size_t)(t + 2) * kstepA; const char* b2 = last ? nB : cB + (size_t)(t + 2) * kstepB;
            const char* a3 = a2 + kstepA; const char* b3 = b2 + kstepB;
            unsigned gs0[2], gs1[2];
            if constexpr (Sched::GATHER) { gs0[0] = last ? gnxt[0][0] : gcur[0][0]; gs0[1] = last ? gnxt[0][1] : gcur[0][1]; gs1[0] = last ? gnxt[1][0] : gcur[1][0]; gs1[1] = last ? gnxt[1][1] : gcur[1][1]; }
            PG8_LDB(B0, 0, 0); PG8_SCHED; PG8_LDA(At, 0, 0); PG8_STAGE_A(1, 1, a1 + hstepA, a1, gcur[1]);
            PG8_WAIT_L(8); PG8_BAR; PG8_WAIT_L(0); PG8_MMA(0, 0, At, B0); PG8_BAR; PG8_SCHED;
            PG8_LDB(B1, 0, 1); PG8_STAGE(PG8_SB(0, 0), b2, voffB);
            PG8_BAR; PG8_WAIT_L(0); PG8_MMA(0, 1, At, B1); PG8_BAR;
            PG8_LDA(At, 0, 1); PG8_STAGE_A(0, 0, a2, a2, gs0);
            PG8_BAR; PG8_WAIT_L(0); PG8_MMA(1, 0, At, B0); PG8_BAR; PG8_SCHED;
            PG8_STAGE(PG8_SB(0, 1), b2 + hstepB, voffB);
            PG8_WAIT_V(6); PG8_BAR; PG8_MMA(1, 1, At, B1); PG8_BAR;
            PG8_LDB(B0, 1, 0); PG8_SCHED; PG8_LDA(At, 1, 0); PG8_STAGE_A(0, 1, a2 + hstepA, a2, gs1);
            PG8_WAIT_L(8); PG8_BAR; PG8_WAIT_L(0); PG8_MMA(0, 0, At, B0); PG8_BAR; PG8_SCHED;
            PG8_LDB(B1, 1, 1); PG8_STAGE(PG8_SB(1, 0), b3, voffB);
            PG8_BAR; PG8_WAIT_L(0); PG8_MMA(0, 1, At, B1); PG8_BAR;
            PG8_LDA(At, 1, 1); PG8_STAGE_A(1, 0, a3, a3, gs0);
            PG8_BAR; PG8_WAIT_L(0); PG8_MMA(1, 0, At, B0); PG8_BAR; PG8_SCHED;
            PG8_STAGE(PG8_SB(1, 1), b3 + hstepB, voffB);
            PG8_WAIT_V(6); PG8_BAR; PG8_MMA(1, 1, At, B1); PG8_BAR;
        }
        E(acc, cur, wr, wc, fr, fq);
        if (!has_next) break;
#pragma unroll
        for (int a = 0; a < 2; ++a)
#pragma unroll
            for (int b = 0; b < 2; ++b)
#pragma unroll
                for (int m = 0; m < 4; ++m)
#pragma unroll
                    for (int n = 0; n < 2; ++n) acc[a][b][m][n] = (f32x4){0.f, 0.f, 0.f, 0.f};
        cur = nxt; cA = nA; cB = nB; ++ui;
        if constexpr (Sched::GATHER) {
#pragma unroll
            for (int h_ = 0; h_ < 2; ++h_) { gcur[h_][0] = gnxt[h_][0]; gcur[h_][1] = gnxt[h_][1]; } }
    }
    PG8_WAIT_V(0);
    if (wr == 0) PG8_BAR;
    PG8_BAR;
#undef PG8_SA
#undef PG8_SB
#undef PG8_STAGE
#undef PG8_STAGE_A
#undef PG8_GLOAD
#undef PG8_LDA
#undef PG8_LDB
#undef PG8_MMA
#undef PG8_WAIT_V
#undef PG8_WAIT_L
#undef PG8_BAR
#undef PG8_SCHED
}

struct Args { const float* in[24]; float* out; unsigned char* ws; int ph_lo, ph_hi; };
typedef const float* cfp_t;
typedef const __attribute__((address_space(4))) cfp_t* InPtr;
struct Frame {
    InPtr in; float* out; unsigned char* ws; LAS unsigned char* lds; int tid, lane, wave, G, vb;
};
#define WSP(T, off) ((T*)(F.ws + (off)))
template <class T> __device__ __forceinline__ T* launder_ptr(T* p) {
    int z = 0; asm volatile("" : "+s"(z)); return (T*)((char*)p + z);
}
__device__ __forceinline__ Frame relaunder(const Frame& F0) {
    Frame F = F0; int ln = (int)__builtin_amdgcn_mbcnt_hi(~0u, __builtin_amdgcn_mbcnt_lo(~0u, 0u)); asm volatile("" : "+v"(ln));
    F.lane = ln; F.wave = F0.wave; F.tid = F0.wave * 64 + ln;
    F.ws = launder_ptr(F0.ws); F.out = launder_ptr(F0.out);
    { int g = F0.G, v = F0.vb; asm volatile("" : "+v"(g), "+v"(v)); F.G = __builtin_amdgcn_readfirstlane(g); F.vb = __builtin_amdgcn_readfirstlane(v); }
    return F;
}

__device__ __forceinline__ SchedB mk_sched(const Frame& F, int nB, int nM, int nN, int bdiv, unsigned bsA_hi, unsigned bsA_lo, unsigned bsB_hi, unsigned bsB_lo, unsigned tsA, unsigned tsB, int crot = 0) {
    SchedB S; S.nM = nM; S.nN = nN; S.nB = nB; S.G = F.G; S.c = (F.vb + crot) % F.G; S.bdiv = bdiv; S.bsA_hi = bsA_hi; S.bsA_lo = bsA_lo; S.bsB_hi = bsB_hi; S.bsB_lo = bsB_lo; S.tsA = tsA; S.tsB = tsB; return S;
}
__device__ __forceinline__ void gemm_plain(const Frame& F, const bf16_t* A, int lda, const bf16_t* Bw, int M, int N, int K, bf16_t* O, int ldc, int crot = 0) {
    GemmD g{A, Bw, lda, K, 128, 128, K};
    SchedB S = mk_sched(F, 1, M / 256, N / 256, 1, 0, 0, 0, 0, (unsigned)256 * lda * 2, (unsigned)256 * K * 2, crot);
    EpiBf16 E{O, ldc, 1, 0, 0};
    gemm_phase<EpiBf16, SchedB>(F.lds, g, S, E, F.wave);
}

struct TDesc { const float* src; int ldsrc; bf16_t* dst; int ldd; };
struct MatMap {
    const float* src; int ldsrc, nnt; bf16_t* dst; int ldd;
    __device__ __forceinline__ TDesc operator()(int tl) const { const int kt = tl / nnt, ntl = tl - kt * nnt; return TDesc{src + (size_t)kt * 64 * ldsrc + ntl * 64, ldsrc, dst + (size_t)ntl * 64 * ldd + kt * 64, ldd}; }
};
struct MoeMap {
    const float* wg; const float* wu; const float* wd; bf16_t* WGU; bf16_t* WDN;
    __device__ __forceinline__ TDesc operator()(int tl) const {
        const int e = tl / 384, r = tl - e * 384, which = r >> 7, q = r & 127;
        if (which < 2) { const int kt = q >> 3, ntl = q & 7, k0 = kt * 64, n0 = ntl * 64; const int row0 = (n0 >> 7) * 256 + which * 128 + (n0 & 127);
            return TDesc{(which ? wu : wg) + (size_t)e * 524288 + (size_t)k0 * 512 + n0, 512, WGU + (size_t)e * 1048576 + (size_t)row0 * 1024 + k0, 1024}; }
        const int kt = q >> 4, ntl = q & 15, k0 = kt * 64, n0 = ntl * 64;
        return TDesc{wd + (size_t)e * 524288 + (size_t)k0 * 1024 + n0, 1024, WDN + (size_t)e * 524288 + (size_t)n0 * 512 + k0, 512};
    }
};
template <class Map>
__device__ __forceinline__ void tconv_run_sub(const Frame& F, int ntiles, const Map& M, int wgi, int nwg) {
    LAS float* tile = (LAS float*)F.lds;
    const int t = F.tid, r = t >> 3, cg = t & 7;
    for (int base = wgi * 4; base < ntiles; base += nwg * 4) {
        f32x4 v[4][2]; TDesc d[4];
#pragma unroll
        for (int q = 0; q < 4; ++q) { d[q] = M(min(base + q, ntiles - 1));
            v[q][0] = gload<f32x4>(d[q].src + (size_t)r * d[q].ldsrc + cg * 8); v[q][1] = gload<f32x4>(d[q].src + (size_t)r * d[q].ldsrc + cg * 8 + 4); }
#pragma unroll
        for (int q = 0; q < 4; ++q)
#pragma unroll
            for (int j = 0; j < 4; ++j) { tile[q * 4160 + r * 65 + cg * 8 + j] = v[q][0][j]; tile[q * 4160 + r * 65 + cg * 8 + 4 + j] = v[q][1][j]; }
        __syncthreads();
#pragma unroll
        for (int q = 0; q < 4; ++q) {
            float o[8];
#pragma unroll
            for (int j = 0; j < 8; ++j) o[j] = tile[q * 4160 + (cg * 8 + j) * 65 + r];
            u32x4 w; w.x = cvt_pk_bf16(o[0], o[1]); w.y = cvt_pk_bf16(o[2], o[3]); w.z = cvt_pk_bf16(o[4], o[5]); w.w = cvt_pk_bf16(o[6], o[7]);
            if (base + q < ntiles) gstore<u32x4>(d[q].dst + (size_t)r * d[q].ldd + cg * 8, w);
        }
        __syncthreads();
    }
}
template <class Map>
__device__ __forceinline__ void tconv_run(const Frame& F, int ntiles, const Map& M, int rot) { tconv_run_sub(F, ntiles, M, (F.vb + rot) % F.G, F.G); }
__device__ __forceinline__ void tconv_matrix(const Frame& F, const float* src, int ldsrc, int Kd, int Nd, bf16_t* dst, int ldd, int rot) {
    MatMap M{src, ldsrc, Nd / 64, dst, ldd};
    tconv_run(F, (Kd / 64) * (Nd / 64), M, rot);
}
__device__ __forceinline__ void moe_convert(const Frame& F0, int l) {
    const Frame F = relaunder(F0);
    MoeMap M{F.in[19] + (size_t)l * 32 * 524288, F.in[20] + (size_t)l * 32 * 524288, F.in[21] + (size_t)l * 32 * 524288, l ? (bf16_t*)F.out : WSP(bf16_t, WS_WGU), l ? (bf16_t*)F.out + (size_t)33554432 : WSP(bf16_t, WS_WDN)};
    tconv_run(F, 32 * 384, M, 0);
}
constexpr size_t X_PRO_ELEMS = (size_t)NTOK * DM / 2;
__device__ __forceinline__ void conv_f32_bf16_sub(const Frame& F, const float* src, bf16_t* dst, size_t n, int wgi, int nwg) {
    for (size_t i = ((size_t)wgi * NTHR + F.tid) * 8; i < n; i += (size_t)nwg * NTHR * 8) {
        const f32x4 a = gload<f32x4>(src + i), b = gload<f32x4>(src + i + 4);
        u32x4 w; w.x = cvt_pk_bf16(a[0], a[1]); w.y = cvt_pk_bf16(a[2], a[3]); w.z = cvt_pk_bf16(b[0], b[1]); w.w = cvt_pk_bf16(b[2], b[3]);
        gstore<u32x4>(dst + i, w); }
}
__device__ __forceinline__ void conv_f32_bf16(const Frame& F, const float* src, bf16_t* dst, size_t n) {
    for (size_t i = ((size_t)F.vb * NTHR + F.tid) * 8; i < n; i += (size_t)F.G * NTHR * 8) {
        const f32x4 a = gload<f32x4>(src + i), b = gload<f32x4>(src + i + 4);
        u32x4 w; w.x = cvt_pk_bf16(a[0], a[1]); w.y = cvt_pk_bf16(a[2], a[3]); w.z = cvt_pk_bf16(b[0], b[1]); w.w = cvt_pk_bf16(b[2], b[3]);
        gstore<u32x4>(dst + i, w); }
}

__device__ __forceinline__ void p_prologue(const Frame& F0) {
    const Frame F = relaunder(F0);
    tconv_matrix(F, F.in[2] + 512, 1024, 1024, 512, WSP(bf16_t, WS_W1CAT) + (size_t)512 * 1024, 1024, 0);
    tconv_matrix(F, F.in[7], 1024, 1024, 1024, WSP(bf16_t, WS_PFWOUT), 1024, 32);
    { const int dsec[5] = {0, 1, 3, 4, 2};
#pragma unroll
      for (int sc = 0; sc < 5; ++sc) tconv_matrix(F, F.in[8] + sc * 1024, 5120, 1024, 1024, WSP(bf16_t, WS_HGWIN) + (size_t)dsec[sc] * 1048576, 1024, 96 + sc * 64); }
    tconv_matrix(F, F.in[11], 1024, 1024, 1024, WSP(bf16_t, WS_HGWOUT), 1024, 160);
    for (int l = 0; l < 2; ++l) {
        tconv_matrix(F, F.in[13] + (size_t)l * 2097152, 2048, 1024, 1024, WSP(bf16_t, WS_WK) + (size_t)l * 1048576, 1024, 32 + l * 256);
        tconv_matrix(F, F.in[13] + (size_t)l * 2097152 + 1024, 2048, 1024, 1024, WSP(bf16_t, WS_WV) + (size_t)l * 1048576, 1024, 96 + l * 256);
        tconv_matrix(F, F.in[14] + (size_t)l * 1048576, 1024, 1024, 1024, WSP(bf16_t, l ? WS_WOT1 : WS_WOT0), 1024, 160 + l * 256);
        conv_f32_bf16(F, F.in[12] + (size_t)l * 1048576, WSP(bf16_t, l ? WS_WQN1 : WS_WQN0), (size_t)1048576);
    }
    if (F.G != 256) moe_convert(F, 0);
    conv_f32_bf16(F, F.in[0], WSP(bf16_t, WS_XB), F.G == 256 ? X_PRO_ELEMS : (size_t)NTOK * DM);
    conv_f32_bf16(F, F.in[1], WSP(bf16_t, WS_MEMBF), (size_t)NB * MEML * DM);
    const int gt = F.vb * NTHR + F.tid, gn = F.G * NTHR;
    { const float* win = F.in[2]; const float* pw = F.in[3]; const float* ps = F.in[4]; bf16_t* W1 = WSP(bf16_t, WS_W1CAT);
      LAS float* wl = (LAS float*)F.lds;
      for (int kb = F.vb; kb < 256; kb += F.G) {
          __syncthreads();
#pragma unroll
          for (int j = 0; j < 4; ++j) wl[j * 512 + F.tid] = win[(size_t)(kb * 4 + j) * 1024 + F.tid];
          __syncthreads();
          const int gd = F.tid, g = gd >> 7, d = gd & 127; const float* pp = pw + (size_t)g * 16384 + d;
          float a0 = 0.f, a1 = 0.f, a2 = 0.f, a3 = 0.f;
#pragma unroll 8
          for (int c = 0; c < 128; ++c) { const float p = pp[c * 128]; a0 += wl[g * 128 + c] * p; a1 += wl[512 + g * 128 + c] * p; a2 += wl[1024 + g * 128 + c] * p; a3 += wl[1536 + g * 128 + c] * p; }
          const float sc = ps[gd];
          u32x2 w; w.x = cvt_pk_bf16(a0 * sc, a1 * sc); w.y = cvt_pk_bf16(a2 * sc, a3 * sc);
          gstore<u32x2>(W1 + (size_t)gd * 1024 + kb * 4, w); }
      __syncthreads(); }
    { const float* fw = F.in[6]; bf16_t* PQ = WSP(bf16_t, WS_PQT); const float norm = 0.0013810679320049757f;
      LAS float* tb = (LAS float*)F.lds;
      __syncthreads();
      if (F.tid < 128) { const float ang = (float)F.tid * (1.0f / 64.0f); tb[F.tid] = cospif(ang); tb[128 + F.tid] = sinpif(ang); }
      __syncthreads();
      for (int idx = gt; idx < 4 * 256 * 128; idx += gn) { const int h = idx >> 15, r = (idx >> 7) & 255, c = idx & 127, d = r & 127, isq = r >> 7; float a = 0.f;
          const float* fp = fw + (size_t)h * 16384 + d; const LAS float* tp = tb + isq * 128;
#pragma unroll 8
          for (int m = 0; m < 128; ++m) a += tp[(m * c) & 127] * fp[m * 128];
          PQ[idx] = f2bf(a * norm); }
      __syncthreads(); }
    { bf16_t* W1d = WSP(bf16_t, WS_W1DFT); bf16_t* W2d = WSP(bf16_t, WS_W2DFT); float* TW = WSP(float, WS_TW);
      for (int idx = gt; idx < 256 * 128; idx += gn) { const int r = idx >> 7, k = idx & 127, ri = k >> 6, bb = k & 63; float v1 = 0.f, v2 = 0.f;
          if (r < 128) { const int e = 32 * (r >> 6) + (r & 31), ro = (r >> 5) & 1; const float ang = (float)((e * bb) & 63) * (1.0f / 32.0f); const float cs = cospif(ang), sn = sinpif(ang);
              v1 = ro == 0 ? (ri == 0 ? cs : -sn) : (ri == 0 ? sn : cs); }
          if (r < 64) { const float ang = (float)((r * bb) & 63) * (1.0f / 32.0f); v2 = ri == 0 ? cospif(ang) : -sinpif(ang); }
          W1d[idx] = f2bf(v1); W2d[idx] = f2bf(v2); }
      for (int idx = gt; idx < 64 * 64; idx += gn) { const int e = idx >> 6, a = idx & 63; const float ang = (float)((e * a) & 4095) * (1.0f / 2048.0f); TW[idx * 2] = cospif(ang); TW[idx * 2 + 1] = sinpif(ang); } }
    { const float* lbin = F.in[9]; float* LB = WSP(float, WS_LB1);
      for (int idx = gt; idx < 2048; idx += gn) { const float v0 = lbin[idx], v1 = lbin[2048 + idx]; LB[idx] = 1.0f / (1.0f + expf(v0 - v1)); } }
}

__device__ __forceinline__ void p_kv_a(const Frame& F0) {
    const Frame F = relaunder(F0);
    gemm_plain(F, WSP(bf16_t, WS_MEMBF), 1024, WSP(bf16_t, WS_WK), 2048, 1024, 1024, WSP(bf16_t, WS_KB0), 1024, 0);
    gemm_plain(F, WSP(bf16_t, WS_MEMBF), 1024, WSP(bf16_t, WS_WV), 2048, 1024, 1024, WSP(bf16_t, WS_VB0), 1024, 32);
    gemm_plain(F, WSP(bf16_t, WS_MEMBF), 1024, WSP(bf16_t, WS_WK) + 1048576, 2048, 1024, 1024, WSP(bf16_t, WS_KB1), 1024, 64);
    gemm_plain(F, WSP(bf16_t, WS_MEMBF), 1024, WSP(bf16_t, WS_WV) + 1048576, 2048, 1024, 1024, WSP(bf16_t, WS_VB1), 1024, 96);
    if (F.G == 256 && F.vb >= 32 && F.vb < 160) conv_f32_bf16_sub(F, F.in[0] + X_PRO_ELEMS, WSP(bf16_t, WS_XB) + X_PRO_ELEMS, (size_t)NTOK * DM - X_PRO_ELEMS, F.vb - 32, 128);
}
__device__ __forceinline__ void p_kv_b(const Frame& F0, int l) {
    const Frame F = relaunder(F0);
    const bf16_t* KB = WSP(bf16_t, l ? WS_KB1 : WS_KB0); const bf16_t* VB = WSP(bf16_t, l ? WS_VB1 : WS_VB0);
    const bf16_t* WQN = WSP(bf16_t, l ? WS_WQN1 : WS_WQN0); const bf16_t* WOT = WSP(bf16_t, l ? WS_WOT1 : WS_WOT0);
    { GemmD g{KB, WQN, 1024, 1024, 128, 128, 256};
      SchedB S = mk_sched(F, 32, 1, 4, 4, (unsigned)256 * 1024 * 2, (unsigned)256 * 2, 0, (unsigned)256 * 2, 0, (unsigned)256 * 1024 * 2);
      EpiBf16 E{WSP(bf16_t, WS_KM), 1024, 1, (unsigned)256 * 1024, 0};
      gemm_phase<EpiBf16, SchedB>(F.lds, g, S, E, F.wave); }
    { GemmD g{WOT, VB, 1024, 1024, 128, 128, 256};
      SchedB S = mk_sched(F, 32, 4, 1, 4, 0, (unsigned)256 * 2, (unsigned)256 * 1024 * 2, (unsigned)256 * 2, (unsigned)256 * 1024 * 2, 0, 128);
      EpiBf16 E{WSP(bf16_t, WS_VW), 1024, 4, (unsigned)1024 * 1024, 256};
      gemm_phase<EpiBf16, SchedB>(F.lds, g, S, E, F.wave); }
}

__device__ __forceinline__ void p_pool_hln(const Frame& F0) {
    const Frame F = relaunder(F0);
    const bf16_t* U = WSP(bf16_t, WS_U); bf16_t* YC = WSP(bf16_t, WS_YCAT); bf16_t* UN = WSP(bf16_t, WS_UN); const float* lng = F.in[5];
    const int l = F.lane, g = l >> 4, w2 = 1 << g;
    float gam[8];
#pragma unroll
    for (int j = 0; j < 8; ++j) gam[j] = lng[8 * l + j];
#define POOL_LOAD(o_, u_, a_, d_, i_) do { const int s_ = s0 + (i_); o_ = gload<u32x4>(Ub + (size_t)s_ * DM); u_ = gload<u32x4>(Ub + (size_t)s_ * DM + 512); \
        a_ = gload<u32x4>(Ub + (size_t)min(s_ + w2, SEQ - 1) * DM); d_ = gload<u32x4>(Ub + (size_t)max(s_ - w2, 0) * DM); } while (0)
#define POOL_BODY(o_, u_, a_, d_, i_) do { const int s = s0 + (i_), tk = t0 + (i_); \
        const int lo = max(s - w2, 0), hi = min(s + w2, SEQ); \
        const u32x4 own = o_; \
        const float inv = 1.0f / (float)(hi - lo); \
        float o[8]; \
        o[0] = sum[0] * inv - lo_bf(own.x); o[1] = sum[1] * inv - hi_bf(own.x); o[2] = sum[2] * inv - lo_bf(own.y); o[3] = sum[3] * inv - hi_bf(own.y); \
        o[4] = sum[4] * inv - lo_bf(own.z); o[5] = sum[5] * inv - hi_bf(own.z); o[6] = sum[6] * inv - lo_bf(own.w); o[7] = sum[7] * inv - hi_bf(own.w); \
        u32x4 w; w.x = cvt_pk_bf16(o[0], o[1]); w.y = cvt_pk_bf16(o[2], o[3]); w.z = cvt_pk_bf16(o[4], o[5]); w.w = cvt_pk_bf16(o[6], o[7]); \
        gstore<u32x4>(YC + (size_t)tk * DM + 8 * l, w); \
        { const float ka = (s + w2 < SEQ) ? 1.0f : 0.0f, kd = (s - w2 >= 0) ? 1.0f : 0.0f; const u32x4 va = a_, vd = d_;        \
          sum[0] += ka * lo_bf(va.x) - kd * lo_bf(vd.x); sum[1] += ka * hi_bf(va.x) - kd * hi_bf(vd.x); sum[2] += ka * lo_bf(va.y) - kd * lo_bf(vd.y); sum[3] += ka * hi_bf(va.y) - kd * hi_bf(vd.y); \
          sum[4] += ka * lo_bf(va.z) - kd * lo_bf(vd.z); sum[5] += ka * hi_bf(va.z) - kd * hi_bf(vd.z); sum[6] += ka * lo_bf(va.w) - kd * lo_bf(vd.w); sum[7] += ka * hi_bf(va.w) - kd * hi_bf(vd.w); } \
          \
        const u32x4 ub = u_; \
        float x[8] = {lo_bf(ub.x), hi_bf(ub.x), lo_bf(ub.y), hi_bf(ub.y), lo_bf(ub.z), hi_bf(ub.z), lo_bf(ub.w), hi_bf(ub.w)}; \
        float sm = ((x[0] + x[1]) + (x[2] + x[3])) + ((x[4] + x[5]) + (x[6] + x[7])); \
        sm += __shfl_xor(sm, 1); sm += __shfl_xor(sm, 2); sm += __shfl_xor(sm, 4); sm += __shfl_xor(sm, 8); \
        const float mu = sm * (1.0f / 128.0f); \
        float qq = 0.f; \
        _Pragma("unroll") for (int j = 0; j < 8; ++j) { x[j] -= mu; qq += x[j] * x[j]; } \
        qq += __shfl_xor(qq, 1); qq += __shfl_xor(qq, 2); qq += __shfl_xor(qq, 4); qq += __shfl_xor(qq, 8); \
        const float rs = rsqrtf(qq * (1.0f / 128.0f) + LN_EPS); \
        _Pragma("unroll") for (int j = 0; j < 8; ++j) x[j] = x[j] * rs * gam[j]; \
        const int np = 64 * (s & 63) + (s >> 6); \
        u32x4 w2v; w2v.x = cvt_pk_bf16(x[0], x[1]); w2v.y = cvt_pk_bf16(x[2], x[3]); w2v.z = cvt_pk_bf16(x[4], x[5]); w2v.w = cvt_pk_bf16(x[6], x[7]); \
        gstore<u32x4>(UN + ((size_t)(b * SEQ + np)) * 512 + 8 * l, w2v); } while (0)
    for (int run = F.vb * 8 + F.wave; run < NTOK / 16; run += F.G * 8) {
        const int t0 = run * 16, b = t0 >> 12, s0 = t0 & 4095;
        const bf16_t* Ub = U + (size_t)b * SEQ * DM + 8 * l;
        float sum[8];
#pragma unroll
        for (int j = 0; j < 8; ++j) sum[j] = 0.f;
        {
            const int lo = max(s0 - w2, 0), hi = min(s0 + w2, SEQ);
            u32x4 wv[16];
#pragma unroll
            for (int d = 0; d < 16; ++d) { const int r = s0 - 8 + d; const int rc = min(max(r, 0), SEQ - 1); wv[d] = gload<u32x4>(Ub + (size_t)rc * DM); }
#pragma unroll
            for (int d = 0; d < 16; ++d) { const int r = s0 - 8 + d; const float k = (r >= lo && r < hi) ? 1.0f : 0.0f; const u32x4 v = wv[d];
                sum[0] += k * lo_bf(v.x); sum[1] += k * hi_bf(v.x); sum[2] += k * lo_bf(v.y); sum[3] += k * hi_bf(v.y); sum[4] += k * lo_bf(v.z); sum[5] += k * hi_bf(v.z); sum[6] += k * lo_bf(v.w); sum[7] += k * hi_bf(v.w); }
        }
        u32x4 oA, uA, aA, dA, oB, uB, aB, dB;
        POOL_LOAD(oA, uA, aA, dA, 0);
#pragma unroll 1
        for (int i = 0; i < 16; i += 2) {
            POOL_LOAD(oB, uB, aB, dB, i + 1);
            POOL_BODY(oA, uA, aA, dA, i);
            if (i + 2 < 16) POOL_LOAD(oA, uA, aA, dA, i + 2);
            POOL_BODY(oB, uB, aB, dB, i + 1);
        }
    }
#undef POOL_LOAD
#undef POOL_BODY
}

template <int MODE, bool XF32, bool FINAL>
__device__ __forceinline__ void p_ln(const Frame& F0, const float* xin, const bf16_t* hsrc, int l, int j3) {
    const Frame F = relaunder(F0);
    float* X = F.out; bf16_t* XB = WSP(bf16_t, WS_XB);
    const float* gam = F.in[22] + (size_t)(l * 3 + j3) * 1024; const float* bet = F.in[23] + (size_t)(l * 3 + j3) * 1024;
    const int ln = F.lane;
    float gv[16], bv[16];
#pragma unroll
    for (int ii = 0; ii < 2; ++ii)
#pragma unroll
        for (int j = 0; j < 8; ++j) { gv[ii * 8 + j] = gam[ii * 512 + ln * 8 + j]; bv[ii * 8 + j] = bet[ii * 512 + ln * 8 + j]; }
    LAS float* WR = (LAS float*)F.lds;
#define WR_PERM(c_) ((((c_) >> 9) * 2 + (((c_) >> 2) & 1)) * 256 + (((c_) >> 3) & 63) * 4 + ((c_) & 3))
    LAS int* hist = (LAS int*)(F.lds + 36 * 4096);
    float rbias_g = 0.f, rbias_e = 0.f;
    if (MODE == 1) {
        const float* wgp = F.in[15] + (size_t)l * 4096; const float* wep = F.in[17] + (size_t)l * 32768;
        for (int c = F.tid; c < 1024; c += NTHR) { const f32x4 v = gload<f32x4>(wgp + c * 4);
#pragma unroll
            for (int j = 0; j < 4; ++j) WR[j * 1024 + WR_PERM(c)] = v[j]; }
        for (int idx = F.tid; idx < 8192; idx += NTHR) { const int c = idx & 1023, q4 = idx >> 10; const f32x4 v = gload<f32x4>(wep + c * 32 + q4 * 4);
#pragma unroll
            for (int j = 0; j < 4; ++j) WR[(4 + q4 * 4 + j) * 1024 + WR_PERM(c)] = v[j]; }
        rbias_g = F.in[16][l * 4 + (ln & 3)]; rbias_e = F.in[18][l * 32 + (ln & 31)];
        __syncthreads();
    }
    const int2* POSS = WSP(int2, WS_POSS);
    if (MODE == 1) { int* ROWTOK = WSP(int, WS_ROWTOK); for (int i = F.vb * NTHR + F.tid; i < MPAD_MAX; i += F.G * NTHR) ROWTOK[i] = 0; }
    for (int ch = F.vb; ch < NTOK / 128; ch += F.G) {
        if (MODE == 1) { if (F.tid < 32) hist[F.tid] = 0; __syncthreads(); }
        const int t0 = ch * 128 + F.wave * 16;
        int2 myps = make_int2(0, 0);
        if (MODE == 2) myps = POSS[t0 + (ln & 15)];
        f32x4 nxf[4]; u32x4 nxb[2], nh0[2], nh1[2];
#define LN_LOAD(tt, ii_) do { const int t_ = (tt); const bf16_t* h0_ = hsrc + (size_t)t_ * DM; const bf16_t* h1_ = h0_; \
            if (MODE == 2) { const int p0_ = __shfl(myps.x, (ii_)), p1_ = __shfl(myps.y, (ii_)); h0_ = hsrc + (size_t)p0_ * DM; h1_ = hsrc + (size_t)p1_ * DM; } \
            _Pragma("unroll") for (int ii = 0; ii < 2; ++ii) { const int c0 = ii * 512 + ln * 8; \
                if (XF32) { nxf[ii * 2] = gload<f32x4>(xin + (size_t)t_ * DM + c0); nxf[ii * 2 + 1] = gload<f32x4>(xin + (size_t)t_ * DM + c0 + 4); } \
                else nxb[ii] = gload<u32x4>(XB + (size_t)t_ * DM + c0); \
                nh0[ii] = gload<u32x4>(h0_ + c0); if (MODE == 2) nh1[ii] = gload<u32x4>(h1_ + c0); } } while (0)
        LN_LOAD(t0, 0);
        for (int i = 0; i < 16; ++i) {
            const int t = t0 + i;
            float y[16];
#pragma unroll
            for (int ii = 0; ii < 2; ++ii) {
                float xx[8];
                if (XF32) {
#pragma unroll
                    for (int j = 0; j < 4; ++j) { xx[j] = nxf[ii * 2][j]; xx[4 + j] = nxf[ii * 2 + 1][j]; } }
                else { const u32x4 xv = nxb[ii];
                    xx[0] = lo_bf(xv.x); xx[1] = hi_bf(xv.x); xx[2] = lo_bf(xv.y); xx[3] = hi_bf(xv.y); xx[4] = lo_bf(xv.z); xx[5] = hi_bf(xv.z); xx[6] = lo_bf(xv.w); xx[7] = hi_bf(xv.w); }
                const u32x4 hv = nh0[ii];
                float hh[8] = {lo_bf(hv.x), hi_bf(hv.x), lo_bf(hv.y), hi_bf(hv.y), lo_bf(hv.z), hi_bf(hv.z), lo_bf(hv.w), hi_bf(hv.w)};
                if (MODE == 2) { const u32x4 h2 = nh1[ii];
                    hh[0] += lo_bf(h2.x); hh[1] += hi_bf(h2.x); hh[2] += lo_bf(h2.y); hh[3] += hi_bf(h2.y); hh[4] += lo_bf(h2.z); hh[5] += hi_bf(h2.z); hh[6] += lo_bf(h2.w); hh[7] += hi_bf(h2.w); }
#pragma unroll
                for (int j = 0; j < 8; ++j) y[ii * 8 + j] = DN_ALPHA * xx[j] + hh[j];
            }
            if (i + 1 < 16) LN_LOAD(t + 1, i + 1);
            float sm = 0.f;
#pragma unroll
            for (int j = 0; j < 16; ++j) sm += y[j];
            sm = wave_sum(sm);
            const float mu = sm * (1.0f / 1024.0f);
            float q = 0.f;
#pragma unroll
            for (int j = 0; j < 16; ++j) { y[j] -= mu; q += y[j] * y[j]; }
            q = wave_sum(q);
            const float rs = rsqrtf(q * (1.0f / 1024.0f) + LN_EPS);
#pragma unroll
            for (int j = 0; j < 16; ++j) y[j] = y[j] * rs * gv[j] + bv[j];
#pragma unroll
            for (int ii = 0; ii < 2; ++ii) {
                const int c0 = ii * 512 + ln * 8;
                if (FINAL) {
                    gstore<f32x4>(X + (size_t)t * DM + c0, (f32x4){y[ii * 8 + 0], y[ii * 8 + 1], y[ii * 8 + 2], y[ii * 8 + 3]});
                    gstore<f32x4>(X + (size_t)t * DM + c0 + 4, (f32x4){y[ii * 8 + 4], y[ii * 8 + 5], y[ii * 8 + 6], y[ii * 8 + 7]});
                } else {
                    u32x4 w; w.x = cvt_pk_bf16(y[ii * 8 + 0], y[ii * 8 + 1]); w.y = cvt_pk_bf16(y[ii * 8 + 2], y[ii * 8 + 3]); w.z = cvt_pk_bf16(y[ii * 8 + 4], y[ii * 8 + 5]); w.w = cvt_pk_bf16(y[ii * 8 + 6], y[ii * 8 + 7]);
                    gstore<u32x4>(XB + (size_t)t * DM + c0, w);
                }
            }
            if (MODE == 1) {
                const bool b0 = ln & 1, b1 = ln & 2, b2 = ln & 4;
#define ROUTER_DOT(dst, jj_) do { f32x2 a2 = (f32x2){0.f, 0.f}; _Pragma("unroll") for (int ii = 0; ii < 2; ++ii) { \
                    const f32x4 w0 = *(const LAS f32x4*)(WR + (jj_) * 1024 + ii * 512 + ln * 4), w1 = *(const LAS f32x4*)(WR + (jj_) * 1024 + ii * 512 + 256 + ln * 4); \
                    a2 += (f32x2){y[ii * 8 + 0], y[ii * 8 + 1]} * (f32x2){w0[0], w0[1]}; a2 += (f32x2){y[ii * 8 + 2], y[ii * 8 + 3]} * (f32x2){w0[2], w0[3]}; \
                    a2 += (f32x2){y[ii * 8 + 4], y[ii * 8 + 5]} * (f32x2){w1[0], w1[1]}; a2 += (f32x2){y[ii * 8 + 6], y[ii * 8 + 7]} * (f32x2){w1[2], w1[3]}; } \
                    dst = a2[0] + a2[1]; } while (0)
                float gq[4];
#pragma unroll
                for (int j = 0; j < 4; ++j) ROUTER_DOT(gq[j], j);
                float gv1[2];
#pragma unroll
                for (int k = 0; k < 2; ++k) { const float keep = b0 ? gq[2 * k + 1] : gq[2 * k], send = b0 ? gq[2 * k] : gq[2 * k + 1]; gv1[k] = keep + __shfl_xor(send, 1); }
                float gsum; { const float keep = b1 ? gv1[1] : gv1[0], send = b1 ? gv1[0] : gv1[1]; gsum = keep + __shfl_xor(send, 2); }
                gsum += __shfl_xor(gsum, 4); gsum += __shfl_xor(gsum, 8); gsum += __shfl_xor(gsum, 16); gsum += __shfl_xor(gsum, 32);
                gsum += rbias_g;
                float lg[4];
#pragma unroll
                for (int j = 0; j < 4; ++j) lg[j] = __shfl(gsum, j);
                int gi = 0; float gm = lg[0];
#pragma unroll
                for (int j = 1; j < 4; ++j) if (lg[j] > gm) { gm = lg[j]; gi = j; }
                float den = 0.f;
#pragma unroll
                for (int j = 0; j < 4; ++j) den += __expf(lg[j] - gm);
                const float pg = 1.0f / den;
                const int gib = __builtin_amdgcn_readfirstlane(gi) * 8 + 4;
                float eq[8];
#pragma unroll
                for (int j = 0; j < 8; ++j) ROUTER_DOT(eq[j], gib + j);
                float ev1[4], ev2[2];
#pragma unroll
                for (int k = 0; k < 4; ++k) { const float keep = b0 ? eq[2 * k + 1] : eq[2 * k], send = b0 ? eq[2 * k] : eq[2 * k + 1]; ev1[k] = keep + __shfl_xor(send, 1); }
#pragma unroll
                for (int k = 0; k < 2; ++k) { const float keep = b1 ? ev1[2 * k + 1] : ev1[2 * k], send = b1 ? ev1[2 * k] : ev1[2 * k + 1]; ev2[k] = keep + __shfl_xor(send, 2); }
                float esum; { const float keep = b2 ? ev2[1] : ev2[0], send = b2 ? ev2[0] : ev2[1]; esum = keep + __shfl_xor(send, 4); }
                esum += __shfl_xor(esum, 8); esum += __shfl_xor(esum, 16); esum += __shfl_xor(esum, 32);
                esum += __shfl(rbias_e, gi * 8 + (ln & 7));
                float le[8];
#pragma unroll
                for (int j = 0; j < 8; ++j) le[j] = __shfl(esum, j);
#undef ROUTER_DOT
                int i0 = 0; float m0 = le[0];
#pragma unroll
                for (int j = 1; j < 8; ++j) if (le[j] > m0) { m0 = le[j]; i0 = j; }
                int i1 = -1; float m1 = -3.0e38f;
#pragma unroll
                for (int j = 0; j < 8; ++j) if (j != i0 && le[j] > m1) { m1 = le[j]; i1 = j; }
                const float p1 = __expf(m1 - m0), rden = 1.0f / (1.0f + p1);
                if (ln == 0) {
                    const int e0 = gi * 8 + i0, e1 = gi * 8 + i1;
                    WSP(int2, WS_TOKE)[t] = make_int2(e0, e1);
                    WSP(float2, WS_TOKG)[t] = make_float2(pg * rden, pg * p1 * rden);
                    atomicAdd((int*)&hist[e0], 1); atomicAdd((int*)&hist[e1], 1);
                }
            }
        }
#undef LN_LOAD
        if (MODE == 1) { __syncthreads(); if (F.tid < 32) WSP(int, WS_HIST)[ch * 32 + F.tid] = hist[F.tid]; __syncthreads(); }
    }
}

__device__ __forceinline__ void p_dispatch(const Frame& F0) {
    const Frame F = relaunder(F0);
    LAS int* hsum = (LAS int*)F.lds; LAS int* hpre = hsum + 32; LAS int* off = hsum + 64; LAS int* cursor = hsum + 128;
    const int* HIST = WSP(int, WS_HIST); const int2* TOKE = WSP(int2, WS_TOKE); const float2* TOKG = WSP(float2, WS_TOKG);
    int2* POSS = WSP(int2, WS_POSS); float* GPOS = WSP(float, WS_GPOS); int* TEXP = WSP(int, WS_TILEEXP);
    int* ROWTOK = WSP(int, WS_ROWTOK);
    for (int ch = F.vb; ch < NTOK / 128; ch += F.G) {
        if (F.tid < 32) { hsum[F.tid] = 0; hpre[F.tid] = 0; cursor[F.tid] = 0; }
        __syncthreads();
        { const int e = F.tid & 31, part = F.tid >> 5; int tot = 0, pre = 0;
          for (int cc = part * 16; cc < part * 16 + 16; ++cc) { const int v = HIST[cc * 32 + e]; tot += v; if (cc < ch) pre += v; }
          atomicAdd((int*)&hsum[e], tot); atomicAdd((int*)&hpre[e], pre); }
        __syncthreads();
        if (F.tid == 0) { int o = 0; for (int e = 0; e < 32; ++e) { off[e] = o; o += (hsum[e] + 255) & ~255; } off[32] = o; }
        __syncthreads();
        if (ch == 0) { const int ntile = off[32] >> 8;
            if (F.tid < 320) { int e = 0; for (int k = 0; k < 32; ++k) if (F.tid * 256 >= off[k + 1]) e = k + 1; if (F.tid < ntile) TEXP[F.tid] = e < 32 ? e : 31; }
            if (F.tid == 0) TEXP[320] = ntile; }
        {
            const int t0 = ch * 128 + F.wave * 16;
            int p0 = 0, p1 = 0;
            if (F.lane < 16) { const int t = t0 + F.lane; const int2 ee = TOKE[t]; const float2 gg = TOKG[t];
                const int r0 = atomicAdd((int*)&cursor[ee.x], 1); const int r1 = atomicAdd((int*)&cursor[ee.y], 1);
                p0 = off[ee.x] + hpre[ee.x] + r0; p1 = off[ee.y] + hpre[ee.y] + r1;
                POSS[t] = make_int2(p0, p1); GPOS[p0] = gg.x; GPOS[p1] = gg.y; ROWTOK[p0] = t; ROWTOK[p1] = t; }
        }
        __syncthreads();
    }
}

typedef short s16x4 __attribute__((ext_vector_type(4)));
typedef float f32x16 __attribute__((ext_vector_type(16)));
__device__ __forceinline__ s16x4 tr16(const LAS unsigned char* p) { return __builtin_amdgcn_ds_read_tr16_b64_v4i16((LAS s16x4*)p); }
__device__ __forceinline__ bf16x8 cat8(s16x4 a, s16x4 b) { return (bf16x8){a[0], a[1], a[2], a[3], b[0], b[1], b[2], b[3]}; }
constexpr int GQ_S = 288, GV_S = 128, GT_S = 128, GST_S = 288, GA_S = 128;
constexpr int G_QR = 0, G_LR = 64 * GQ_S, G_VR = 2 * 64 * GQ_S, G_VRSZ = 64 * GV_S, G_QTT = G_VR + 2 * G_VRSZ, G_TSZ = 128 * GT_S, G_KTT = G_QTT + 2 * G_TSZ,
              G_ST = G_KTT + 2 * G_TSZ, G_AM = G_ST + 64 * GST_S, G_VEC = G_AM + 64 * GA_S, G_VECSZ = 3 * 512, G_END = G_VEC + 2 * G_VECSZ;
static_assert(G_END <= LDS_MISC, "GLA LDS map");
static_assert((G_VR % 128) == 0 && (G_QTT % 128) == 0 && (G_KTT % 128) == 0 && (G_ST % 128) == 0 && (G_AM % 128) == 0 && (G_TSZ % 128) == 0 && (G_VRSZ % 128) == 0, "GLA LDS alignment");

struct GlaLane { int w, g, c, q, p, hi, c32, blk; };
__device__ __forceinline__ const LAS unsigned char* vbase(const LAS unsigned char* p) { asm volatile("" : "+v"(p)); return p; }
__device__ __forceinline__ LAS unsigned char* vbasew(LAS unsigned char* p) { asm volatile("" : "+v"(p)); return p; }
__device__ __forceinline__ const LAS unsigned char* lxor(const LAS unsigned char* p, unsigned x) { return (const LAS unsigned char*)(uintptr_t)((unsigned)(uintptr_t)p ^ x); }
__device__ __forceinline__ LAS unsigned char* lxorw(LAS unsigned char* p, unsigned x) { return (LAS unsigned char*)(uintptr_t)((unsigned)(uintptr_t)p ^ x); }
__device__ __forceinline__ int s13(int r) { return ((r >> 1) & 1) | (((r >> 3) & 1) << 1); }
__device__ __forceinline__ int s31(int r) { return ((r >> 3) & 1) | (((r >> 1) & 1) << 1); }
__device__ __forceinline__ void gla_secB(const GlaLane& t, const LAS unsigned char* QR, const LAS unsigned char* LR, LAS unsigned char* QTT, LAS unsigned char* KTT, LAS float* vec) {
    const int w = t.w, g = t.g, c = t.c, q = t.q, p = t.p;
    const int k = 16 * w + c;
    const LAS unsigned char* lb8 = vbase(LR + (8 * g + q) * GQ_S + (((16 * w + 4 * p) * 2) ^ ((g & 1) << 7)));
    const LAS unsigned char* lb4 = vbase(LR + (4 * g + q) * GQ_S + (((16 * w + 4 * p) * 2) ^ (((g >> 1) & 1) << 7)));
    const LAS unsigned char* qb4 = vbase(QR + (4 * g + q) * GQ_S + (((16 * w + 4 * p) * 2) ^ (((g >> 1) & 1) << 7)));
    s16x4 b0 = tr16(lb8), b1 = tr16(lb8 + 4 * GQ_S), b2 = tr16(lb8 + 32 * GQ_S), b3 = tr16(lb8 + 36 * GQ_S);
    s16x4 qv[4], lv[4];
#pragma unroll
    for (int lt = 0; lt < 4; ++lt) { qv[lt] = tr16(qb4 + 16 * lt * GQ_S); lv[lt] = tr16(lb4 + 16 * lt * GQ_S); }
    bf16x8 bf[2]; bf[0] = cat8(b0, b1); bf[1] = cat8(b2, b3);
    f32x4 cb[4];
#pragma unroll
    for (int lt = 0; lt < 4; ++lt) {
        cb[lt] = (f32x4){0.f, 0.f, 0.f, 0.f};
#pragma unroll
        for (int ks = 0; ks < 2; ++ks) {
            if (ks == 1 && lt < 2) continue;
            bf16x8 tri;
#pragma unroll
            for (int j = 0; j < 8; ++j) tri[j] = (32 * ks + 8 * g + j <= 16 * lt + c) ? (short)0x3F80 : (short)0;
            cb[lt] = __builtin_amdgcn_mfma_f32_16x16x32_bf16(tri, bf[ks], cb[lt], 0, 0, 0);
        }
    }
    const float bmid = __shfl(cb[2][0], c), blast = __shfl(cb[3][3], 48 + c);
    LAS unsigned char* qw = vbasew(QTT + k * GT_S + 32 * s13(c) + 16 * ((g >> 1) ^ (c & 1)) + 8 * ((g & 1) ^ ((c >> 2) & 1)));
    LAS unsigned char* kw = vbasew(KTT + k * GT_S + 32 * s13(c) + 16 * ((g >> 1) ^ ((c >> 2) & 1)) + 8 * (g & 1));
#pragma unroll
    for (int lt = 0; lt < 4; ++lt) {
        float qt[4], kt[4], fe[4];
#pragma unroll
        for (int e = 0; e < 4; ++e) fe[e] = __builtin_amdgcn_exp2f(bf2f((bf16_t)lv[lt][e]));
        float up[4], dn[4];
        up[0] = __builtin_amdgcn_exp2f(cb[lt][0] - bmid); up[1] = up[0] * fe[1]; up[2] = up[1] * fe[2]; up[3] = up[2] * fe[3];
        dn[3] = __builtin_amdgcn_exp2f(bmid - cb[lt][3]); dn[2] = dn[3] * fe[3]; dn[1] = dn[2] * fe[2]; dn[0] = dn[1] * fe[1];
#pragma unroll
        for (int e = 0; e < 4; ++e) qt[e] = bf2f((bf16_t)qv[lt][e]) * up[e];
        kt[0] = dn[0] - dn[0] * fe[0]; kt[1] = dn[1] - dn[0]; kt[2] = dn[2] - dn[1]; kt[3] = dn[3] - dn[2];
        u32x2 wq, wk; wq.x = cvt_pk_bf16(qt[0], qt[1]); wq.y = cvt_pk_bf16(qt[2], qt[3]); wk.x = cvt_pk_bf16(kt[0], kt[1]); wk.y = cvt_pk_bf16(kt[2], kt[3]);
        *(LAS u32x2*)lxorw(qw, 32 * lt) = wq;
        *(LAS u32x2*)lxorw(kw, 32 * lt) = wk;
    }
    if (g == 0) { vec[k] = __builtin_amdgcn_exp2f(bmid); vec[128 + k] = __builtin_amdgcn_exp2f(blast); vec[256 + k] = __builtin_amdgcn_exp2f(blast - bmid); }
}
__device__ __forceinline__ void gla_secC(const GlaLane& t, const f32x16& S, const LAS float* ebm, LAS unsigned char* ST, const LAS unsigned char* QTT, const LAS unsigned char* KTT, LAS unsigned char* AM) {
    const int w = t.w, g = t.g, c = t.c, q = t.q, p = t.p, hi = t.hi, c32 = t.c32;
    const int kb = w >> 1, vb = w & 1, v = 32 * vb + c32;
    int ti = w;
    int mt = ti < 4 ? 0 : (ti < 7 ? 1 : (ti < 9 ? 2 : 3)), lt = ti - (mt == 0 ? 0 : (mt == 1 ? 3 : (mt == 2 ? 5 : 6)));
    const int sl = s13(8 * g + q);
    const LAS unsigned char* kl0 = vbase(KTT + (8 * g + q) * GT_S + 32 * sl + 16 * (p >> 1) + 8 * (p & 1));
    const LAS unsigned char* kl4 = vbase(KTT + (8 * g + q + 4) * GT_S + 32 * sl + 16 * ((p >> 1) ^ 1) + 8 * (p & 1));
    const LAS unsigned char* ql0 = vbase(QTT + (8 * g + q) * GT_S + 32 * sl + 16 * ((p >> 1) ^ (q & 1)) + 8 * (p & 1));
    const LAS unsigned char* ql4 = vbase(QTT + (8 * g + q + 4) * GT_S + 32 * sl + 16 * ((p >> 1) ^ (q & 1)) + 8 * ((p & 1) ^ 1));
    const LAS unsigned char* ka0 = vbase(lxor(kl0, 32 * mt)); const LAS unsigned char* ka4 = vbase(lxor(kl4, 32 * mt));
    const LAS unsigned char* qa0 = vbase(lxor(ql0, 32 * lt)); const LAS unsigned char* qa4 = vbase(lxor(ql4, 32 * lt));
    s16x4 ka[8], qb[8];
#pragma unroll
    for (int ks = 0; ks < 4; ++ks) { ka[2 * ks] = tr16(ka0 + 32 * ks * GT_S); ka[2 * ks + 1] = tr16(ka4 + 32 * ks * GT_S);
        qb[2 * ks] = tr16(qa0 + 32 * ks * GT_S); qb[2 * ks + 1] = tr16(qa4 + 32 * ks * GT_S); }
    const LAS unsigned char* eb = vbase((const LAS unsigned char*)(ebm + 32 * kb + 4 * hi));
    f32x4 em[4];
#pragma unroll
    for (int gg = 0; gg < 4; ++gg) em[gg] = *(const LAS f32x4*)(eb + 32 * gg);
    const int su = (c32 >> 2) & 1;
    LAS unsigned char* st0 = vbasew(ST + v * GST_S + 64 * kb + 8 * hi + 16 * su);
    LAS unsigned char* st1 = vbasew(ST + v * GST_S + 64 * kb + 8 * hi + 16 * (su ^ 1));
#pragma unroll
    for (int gg = 0; gg < 4; ++gg) {
        u32x2 ws; ws.x = cvt_pk_bf16(S[4 * gg + 0] * em[gg][0], S[4 * gg + 1] * em[gg][1]); ws.y = cvt_pk_bf16(S[4 * gg + 2] * em[gg][2], S[4 * gg + 3] * em[gg][3]);
        *(LAS u32x2*)(((gg & 1) ? st1 : st0) + 32 * (gg >> 1)) = ws;
    }
    LAS unsigned char* aml = vbasew(AM + c * GA_S + 32 * s13(c) + 16 * ((g >> 1) ^ (c & 1)) + 8 * (g & 1));
    for (;;) {
        f32x4 a4 = (f32x4){0.f, 0.f, 0.f, 0.f};
#pragma unroll
        for (int ks = 0; ks < 4; ++ks) a4 = __builtin_amdgcn_mfma_f32_16x16x32_bf16(cat8(ka[2 * ks], ka[2 * ks + 1]), cat8(qb[2 * ks], qb[2 * ks + 1]), a4, 0, 0, 0);
        if (mt == lt) {
#pragma unroll
            for (int r = 0; r < 4; ++r) a4[r] = (4 * g + r <= c) ? a4[r] : 0.f;
        }
        u32x2 wa; wa.x = cvt_pk_bf16(a4[0], a4[1]); wa.y = cvt_pk_bf16(a4[2], a4[3]);
        *(LAS u32x2*)(lxorw(aml, 32 * mt) + 16 * lt * GA_S) = wa;
        ti += 8; if (ti >= 10) break;
        mt = ti < 9 ? 2 : 3; lt = 3;
        const LAS unsigned char* kb0 = vbase(lxor(kl0, 32 * mt)); const LAS unsigned char* kb4 = vbase(lxor(kl4, 32 * mt));
        const LAS unsigned char* qc0 = lxor(ql0, 96); const LAS unsigned char* qc4 = lxor(ql4, 96);
#pragma unroll
        for (int ks = 0; ks < 4; ++ks) { ka[2 * ks] = tr16(kb0 + 32 * ks * GT_S); ka[2 * ks + 1] = tr16(kb4 + 32 * ks * GT_S);
            qb[2 * ks] = tr16(qc0 + 32 * ks * GT_S); qb[2 * ks + 1] = tr16(qc4 + 32 * ks * GT_S); }
    }
}
__device__ __forceinline__ void gla_secD(const GlaLane& t, f32x16& S, const LAS unsigned char* AM, const LAS unsigned char* QTT, const LAS unsigned char* KTT, const LAS unsigned char* VR,
                                         const LAS unsigned char* ST, const LAS float* vec, bf16_t* orow  ) {
    const int w = t.w, g = t.g, c = t.c, q = t.q, p = t.p, hi = t.hi, c32 = t.c32, blk = t.blk;
    const int lt = w & 3, vt0 = 2 * (w >> 2);
    const int nka = lt < 2 ? 1 : 2;
    const int kb = w >> 1, vb = w & 1;
    bf16x8 bA[2], sa[2][4], kaw[4];
    s16x4 bq[8], va[2][4], vw[8];
    const int sl = s13(8 * g + q);
    const LAS unsigned char* amb = vbase(AM + (16 * lt + c) * GA_S + 32 * ((g >> 1) ^ s13(c)) + 16 * ((g & 1) ^ (c & 1)));
    const LAS unsigned char* qt0 = vbase(QTT + (8 * g + q) * GT_S + 32 * (lt ^ sl) + 16 * ((p >> 1) ^ (q & 1)) + 8 * (p & 1));
    const LAS unsigned char* qt4 = vbase(QTT + (8 * g + q + 4) * GT_S + 32 * (lt ^ sl) + 16 * ((p >> 1) ^ (q & 1)) + 8 * ((p & 1) ^ 1));
    const LAS unsigned char* vrb = vbase(VR + (8 * g + q) * GV_S + 32 * (vt0 ^ s31(8 * g + q)) + 8 * p);
    const LAS unsigned char* stb = vbase(ST + (16 * vt0 + c) * GST_S + 32 * (g >> 1) + 16 * ((g & 1) ^ ((c >> 2) & 1)));
#pragma unroll
    for (int ks = 0; ks < 2; ++ks) bA[ks] = *(const LAS bf16x8*)lxor(amb, 64 * ks);
#pragma unroll
    for (int ks = 0; ks < 4; ++ks) { bq[2 * ks] = tr16(qt0 + 32 * ks * GT_S); bq[2 * ks + 1] = tr16(qt4 + 32 * ks * GT_S); }
#pragma unroll
    for (int vi = 0; vi < 2; ++vi) {
        const LAS unsigned char* vv = lxor(vrb, 32 * vi);
#pragma unroll
        for (int ks = 0; ks < 2; ++ks) { va[vi][2 * ks] = tr16(vv + 32 * ks * GV_S); va[vi][2 * ks + 1] = tr16(vv + (32 * ks + 4) * GV_S); }
#pragma unroll
        for (int ks = 0; ks < 4; ++ks) sa[vi][ks] = *(const LAS bf16x8*)(stb + 16 * vi * GST_S + 64 * ks); }
#pragma unroll
    for (int vi = 0; vi < 2; ++vi) {
        const int vt = vt0 + vi;
        f32x4 o4 = (f32x4){0.f, 0.f, 0.f, 0.f};
#pragma unroll
        for (int ks = 0; ks < 2; ++ks) if (ks < nka) o4 = __builtin_amdgcn_mfma_f32_16x16x32_bf16(cat8(va[vi][2 * ks], va[vi][2 * ks + 1]), bA[ks], o4, 0, 0, 0);
#pragma unroll
        for (int ks = 0; ks < 4; ++ks) o4 = __builtin_amdgcn_mfma_f32_16x16x32_bf16(sa[vi][ks], cat8(bq[2 * ks], bq[2 * ks + 1]), o4, 0, 0, 0);
        u32x2 wo; wo.x = cvt_pk_bf16(o4[0], o4[1]); wo.y = cvt_pk_bf16(o4[2], o4[3]);
        gstore<u32x2>(orow + 16 * vt + 4 * g, wo);
    }
    const LAS unsigned char* ktb = vbase(KTT + (32 * kb + c32) * GT_S + 32 * s13(c32) + 16 * (hi ^ ((c32 >> 2) & 1)));
    const LAS unsigned char* vwb = vbase(VR + (8 * hi + q) * GV_S + 32 * ((2 * vb + blk) ^ s31(8 * hi + q)) + 8 * p);
#pragma unroll
    for (int ks = 0; ks < 4; ++ks) { kaw[ks] = *(const LAS bf16x8*)lxor(ktb, 32 * ks);
        vw[2 * ks] = tr16(vwb + 16 * ks * GV_S); vw[2 * ks + 1] = tr16(vwb + (16 * ks + 4) * GV_S); }
    const LAS unsigned char* veb = vbase((const LAS unsigned char*)(vec + 128 + 32 * kb + 4 * hi));
    f32x4 el[4], ed[4];
#pragma unroll
    for (int gg = 0; gg < 4; ++gg) { el[gg] = *(const LAS f32x4*)(veb + 32 * gg); ed[gg] = *(const LAS f32x4*)(veb + 512 + 32 * gg); }
    f32x16 W;
#pragma unroll
    for (int j = 0; j < 16; ++j) W[j] = 0.f;
#pragma unroll
    for (int ks = 0; ks < 4; ++ks) W = __builtin_amdgcn_mfma_f32_32x32x16_bf16(kaw[ks], cat8(vw[2 * ks], vw[2 * ks + 1]), W, 0, 0, 0);
#pragma unroll
    for (int gg = 0; gg < 4; ++gg)
#pragma unroll
        for (int r = 0; r < 4; ++r) S[4 * gg + r] = el[gg][r] * S[4 * gg + r] + ed[gg][r] * W[4 * gg + r];
}

__device__ __forceinline__ void p_gla(const Frame& F0) {
    const Frame F = relaunder(F0);
    const bf16_t* PR = WSP(bf16_t, WS_PROJ);
    LAS unsigned char* L = F.lds;
    const int tid = F.tid, lane = F.lane;
    GlaLane t; t.w = F.wave; t.g = lane >> 4; t.c = lane & 15; t.q = t.c >> 2; t.p = lane & 3; t.hi = lane >> 5; t.c32 = lane & 31; t.blk = (lane >> 4) & 1;
    constexpr int NCH = SEQ / 64;
    for (int un0 = F.vb; un0 < 256; un0 += F.G) {
        const int un = (((un0 >> 5) * 8 + (un0 & 7)) << 2) | ((un0 >> 3) & 3);
        const int b = un >> 5, h = (un >> 2) & 7, dir = (un >> 1) & 1, vh = un & 1;
        bf16_t* O = WSP(bf16_t, dir ? WS_OB : WS_OF);
        const bf16_t* prb = PR + (size_t)b * SEQ * 5120 + h * 128;
        __syncthreads();
        for (int i = tid; i < 64 * GA_S / 4; i += NTHR) ((LAS unsigned*)(L + G_AM))[i] = 0u;
        f32x16 S;
#pragma unroll
        for (int j = 0; j < 16; ++j) S[j] = 0.f;
        u32x4 qreg[2], lreg[2], vreg;
#define GLA_LOAD(n) do { _Pragma("unroll") for (int i_ = 0; i_ < 2; ++i_) { const int idx = tid + 512 * i_, r_ = idx >> 4, c16 = idx & 15; const int tau = (n) * 64 + r_, t_ = dir ? (SEQ - 1 - tau) : tau; \
            const bf16_t* rp = prb + (size_t)t_ * 5120; qreg[i_] = gload<u32x4>(rp + c16 * 8); lreg[i_] = gload<u32x4>(rp + (2 + dir) * 1024 + c16 * 8); } \
          { const int r_ = tid >> 3, c16 = tid & 7; const int tau = (n) * 64 + r_, t_ = dir ? (SEQ - 1 - tau) : tau; vreg = gload<u32x4>(prb + (size_t)t_ * 5120 + 1024 + vh * 64 + c16 * 8); } } while (0)
#define GLA_WRITE(pv) do { _Pragma("unroll") for (int i_ = 0; i_ < 2; ++i_) { const int idx = tid + 512 * i_, r_ = idx >> 4, c16 = idx & 15; \
            const int co_ = (c16 * 16) ^ (((r_ >> 3) & 1) << 7); *(LAS u32x4*)(L + G_QR + r_ * GQ_S + co_) = qreg[i_]; *(LAS u32x4*)(L + G_LR + r_ * GQ_S + co_) = lreg[i_]; } \
          { const int r_ = tid >> 3, c16 = tid & 7; *(LAS u32x4*)(L + G_VR + (pv) * G_VRSZ + r_ * GV_S + 32 * ((c16 >> 1) ^ s31(r_)) + 16 * (c16 & 1)) = vreg; } } while (0)
        GLA_LOAD(0); GLA_WRITE(0); GLA_LOAD(1);
        __syncthreads();
        gla_secB(t, L + G_QR, L + G_LR, L + G_QTT, L + G_KTT, (LAS float*)(L + G_VEC));
        for (int n = 0; n < NCH; ++n) {
            const int pb = n & 1;
            __syncthreads();
            if (n + 1 < NCH) { GLA_WRITE(pb ^ 1); if (n + 2 < NCH) GLA_LOAD(n + 2); }
            gla_secC(t, S, (const LAS float*)(L + G_VEC + pb * G_VECSZ), L + G_ST, L + G_QTT + pb * G_TSZ, L + G_KTT + pb * G_TSZ, L + G_AM);
            __syncthreads();
            { const int tau = n * 64 + 16 * (t.w & 3) + t.c, tt = dir ? (SEQ - 1 - tau) : tau;
              gla_secD(t, S, L + G_AM, L + G_QTT + pb * G_TSZ, L + G_KTT + pb * G_TSZ, L + G_VR + pb * G_VRSZ, L + G_ST, (const LAS float*)(L + G_VEC + pb * G_VECSZ),
                       O + ((size_t)(b * SEQ + tt)) * DM + h * 128 + vh * 64); }
            if (n + 1 < NCH) gla_secB(t, L + G_QR, L + G_LR, L + G_QTT + (pb ^ 1) * G_TSZ, L + G_KTT + (pb ^ 1) * G_TSZ, (LAS float*)(L + G_VEC + (pb ^ 1) * G_VECSZ));
        }
#undef GLA_LOAD
#undef GLA_WRITE
    }
    __syncthreads();
}

__device__ __forceinline__ void p_gate(const Frame& F0) {
    const Frame F = relaunder(F0);
    bf16_t* OFp = WSP(bf16_t, WS_OF); const bf16_t* OBp = WSP(bf16_t, WS_OB); const bf16_t* PR = WSP(bf16_t, WS_PROJ); const float* ng = F.in[10];
    const int ln = F.lane;
    float gv[8];
#pragma unroll
    for (int j = 0; j < 8; ++j) gv[j] = ng[(8 * ln + j) & 127];
    for (int tb = (F.vb * 8 + F.wave) * 2; tb < NTOK; tb += F.G * 8 * 2) {
        u32x4 av[2][2], bv[2][2], gqv[2][2];
#pragma unroll
        for (int u2 = 0; u2 < 2; ++u2)
#pragma unroll
            for (int ii = 0; ii < 2; ++ii) { const int t = tb + u2, c0 = ii * 512 + ln * 8;
                av[u2][ii] = gload<u32x4>(OFp + (size_t)t * DM + c0); bv[u2][ii] = gload<u32x4>(OBp + (size_t)t * DM + c0); gqv[u2][ii] = gload<u32x4>(PR + (size_t)t * 5120 + 4096 + c0); }
#pragma unroll
        for (int u2 = 0; u2 < 2; ++u2)
#pragma unroll
        for (int ii = 0; ii < 2; ++ii) {
            const int t = tb + u2, c0 = ii * 512 + ln * 8;
            const u32x4 a = av[u2][ii], bq = bv[u2][ii], gq = gqv[u2][ii];
            float o[8] = {lo_bf(a.x) + lo_bf(bq.x), hi_bf(a.x) + hi_bf(bq.x), lo_bf(a.y) + lo_bf(bq.y), hi_bf(a.y) + hi_bf(bq.y), lo_bf(a.z) + lo_bf(bq.z), hi_bf(a.z) + hi_bf(bq.z), lo_bf(a.w) + lo_bf(bq.w), hi_bf(a.w) + hi_bf(bq.w)};
            const float gs[8] = {lo_bf(gq.x), hi_bf(gq.x), lo_bf(gq.y), hi_bf(gq.y), lo_bf(gq.z), hi_bf(gq.z), lo_bf(gq.w), hi_bf(gq.w)};
            float q = 0.f;
#pragma unroll
            for (int j = 0; j < 8; ++j) q += o[j] * o[j];
            q += __shfl_xor(q, 1); q += __shfl_xor(q, 2); q += __shfl_xor(q, 4); q += __shfl_xor(q, 8);
            const float rs = rsqrtf(q * (1.0f / 128.0f) + LN_EPS);
#pragma unroll
            for (int j = 0; j < 8; ++j) o[j] = o[j] * rs * gv[j] * gs[j];
            u32x4 w; w.x = cvt_pk_bf16(o[0], o[1]); w.y = cvt_pk_bf16(o[2], o[3]); w.z = cvt_pk_bf16(o[4], o[5]); w.w = cvt_pk_bf16(o[6], o[7]);
            gstore<u32x4>(OFp + (size_t)t * DM + c0, w);
        }
    }
}

constexpr int FILL_TILES = 1, MOE_TILES = 32 * 384;
constexpr int TAIL_GU = 20, TAIL_DN = 16, FILL_L1_FS = 16;
__device__ __forceinline__ int moe_idle_wgs(int ntile, int G) { const int rem = (ntile * 4) % G; return rem > 0 ? G - rem : 0; }
constexpr int TAIL_RC = 16, TAIL_RA = 8;
__device__ __forceinline__ bool moe_redeal(int ntile, int G);
__device__ __forceinline__ int moe_tail_done(int ntile, int G) {
    int d;
    if (moe_redeal(ntile, G)) { const int rem = (ntile * 4) % G; d = (G - 3 * rem) * TAIL_RC + rem * TAIL_RA; }
    else d = moe_idle_wgs(ntile, G) * (TAIL_GU + TAIL_DN);
    return d < MOE_TILES ? d : MOE_TILES; }
__device__ __forceinline__ bf16_t* moe_wgu(const Frame& F, int l) { return l ? (bf16_t*)F.out : WSP(bf16_t, WS_WGU); }
__device__ __forceinline__ bf16_t* moe_wdn(const Frame& F, int l) { return l ? (bf16_t*)F.out + (size_t)33554432 : WSP(bf16_t, WS_WDN); }
__device__ __forceinline__ void fill_tile(const Frame& F, int gid) {
    int ln = (int)__builtin_amdgcn_mbcnt_hi(~0u, __builtin_amdgcn_mbcnt_lo(~0u, 0u)); asm volatile("" : "+v"(ln));
    const int l = gid >= MOE_TILES ? 1 : 0, tl = gid - l * MOE_TILES;
    MoeMap M{F.in[19] + (size_t)l * 32 * 524288, F.in[20] + (size_t)l * 32 * 524288, F.in[21] + (size_t)l * 32 * 524288, moe_wgu(F, l), moe_wdn(F, l)};
    const TDesc d = M(tl);
    LAS unsigned char* img = F.lds + (F.wave - 1) * 8192;
    const int kp = ln >> 3, ng = ln & 7;
    f32x4 v[4][2][2];
#pragma unroll
    for (int p = 0; p < 4; ++p)
#pragma unroll
        for (int h = 0; h < 2; ++h) { const float* sp = d.src + (size_t)(16 * p + 2 * kp + h) * d.ldsrc + 8 * ng; v[p][h][0] = gload<f32x4>(sp); v[p][h][1] = gload<f32x4>(sp + 4); }
#pragma unroll
    for (int p = 0; p < 4; ++p)
#pragma unroll
        for (int j = 0; j < 8; ++j) { const int n = 8 * ng + j, kd = (8 * p + kp) ^ (ng << 2);
            *(LAS unsigned*)(img + n * 128 + kd * 4) = cvt_pk_bf16(v[p][0][j >> 2][j & 3], v[p][1][j >> 2][j & 3]); }
    asm volatile("s_waitcnt lgkmcnt(0)" ::: "memory");
#pragma unroll
    for (int r = 0; r < 8; ++r) { const int n = 8 * r + kp, kc = ng;
        const u32x4 w = *(const LAS u32x4*)(img + n * 128 + ((kc ^ r) << 4));
        gstore<u32x4>(d.dst + (size_t)n * d.ldd + 8 * kc, w); }
    asm volatile("s_waitcnt lgkmcnt(0)" ::: "memory");
}
__device__ __forceinline__ void xcd_barrier_fill(const XcdBarrier& b, const Frame& F0, int& fs) {
    asm volatile("s_waitcnt vmcnt(0)" ::: "memory");
    __syncthreads();
    if (b.wave == 0) xcd_barrier_core(b);
    else if (F0.G == 256) {
        const Frame F = relaunder(F0);
#pragma unroll
        for (int i = 0; i < FILL_TILES; ++i) {
            if (fs < 7) { const int q = fs * 7 + (F.wave - 1); const int gid = q * 256 + F.vb; if (gid < MOE_TILES) fill_tile(F, gid); }
            else if (fs >= FILL_L1_FS && fs < FILL_L1_FS + 8) {
                const int ntile = __builtin_amdgcn_readfirstlane(WSP(int, WS_TILEEXP)[320]);
                const int q = (fs - FILL_L1_FS) * 7 + (F.wave - 1); const int tl = moe_tail_done(ntile, F.G) + q * 256 + F.vb; if (tl < MOE_TILES) fill_tile(F, MOE_TILES + tl); }
        }
    }
    ++fs;
    __syncthreads();
}

struct MoeOffMap { MoeMap M; int off; __device__ __forceinline__ TDesc operator()(int tl) const { return M(tl + off); } };
__device__ __forceinline__ void moe_tail_convert(const Frame& F, int ntile, int which) {
    const int idle = moe_idle_wgs(ntile, F.G), rem = F.G - idle, j = F.vb - rem;
    if (F.G != 256 || idle == 0 || j < 0) return;
    const int per = which ? TAIL_DN : TAIL_GU, first = which ? idle * TAIL_GU : 0;
    int cnt = idle * per; if (first + cnt > MOE_TILES) cnt = MOE_TILES - first; if (cnt <= 0) return;
    MoeOffMap T{MoeMap{F.in[19] + (size_t)32 * 524288, F.in[20] + (size_t)32 * 524288, F.in[21] + (size_t)32 * 524288, (bf16_t*)F.out, (bf16_t*)F.out + (size_t)33554432}, first};
    __syncthreads();
    tconv_run_sub(F, cnt, T, j, idle);
}
__device__ __forceinline__ void moe_convert_range(const Frame& F, int first, int cnt, int j, int n) {
    if (first + cnt > MOE_TILES) cnt = MOE_TILES - first; if (cnt <= 0) return;
    MoeOffMap T{MoeMap{F.in[19] + (size_t)32 * 524288, F.in[20] + (size_t)32 * 524288, F.in[21] + (size_t)32 * 524288, (bf16_t*)F.out, (bf16_t*)F.out + (size_t)33554432}, first};
    __syncthreads();
    tconv_run_sub(F, cnt, T, j, n);
}
__device__ __forceinline__ bool phase_in(int lo, int hi, int k) {
#if ONE_LAUNCH
    asm volatile("" : "+s"(lo), "+s"(hi));
#endif
    return lo <= k && k < hi;
}
constexpr int N_PHASES = 34;
__global__ void __launch_bounds__(NTHR, 2) mk_fwd(Args args) {
    extern __shared__ __attribute__((aligned(1024))) unsigned char lds_raw[];
    Frame F0;
    const __attribute__((address_space(4))) Args* kp = (const __attribute__((address_space(4))) Args*)__builtin_amdgcn_kernarg_segment_ptr();
    F0.in = (InPtr)(kp->in); F0.out = kp->out; F0.ws = kp->ws; F0.lds = (LAS unsigned char*)lds_raw;
    F0.tid = threadIdx.x; F0.lane = F0.tid & 63; F0.wave = __builtin_amdgcn_readfirstlane(F0.tid >> 6); F0.G = gridDim.x; F0.vb = blockIdx.x;
    volatile LAS unsigned* misc = (volatile LAS unsigned*)(F0.lds + LDS_MISC);
    if (F0.tid < 4) misc[F0.tid] = 0u;
    __syncthreads();
    XcdBarrier bar; bar.bar = (unsigned*)(F0.ws + WS_CTL); bar.x = 0; bar.st = misc; bar.wave = F0.wave;
#if ONE_LAUNCH
    bar = xcd_barrier_post((unsigned*)(F0.ws + WS_CTL), misc, F0.wave);
#endif
#if ONE_LAUNCH
    int lo = 0, hi = N_PHASES;
#define OPAQUE_RANGE() do { asm volatile("" : "+s"(lo), "+s"(hi)); } while (0)
#else
    const int lo = kp->ph_lo, hi = kp->ph_hi;
#define OPAQUE_RANGE() do { } while (0)
#endif
#ifndef PHASE_MASK
#define PHASE_MASK 0xFFFFFFFFFFull
#endif
#define IN(k) ((((unsigned long long)PHASE_MASK >> (k)) & 1ull) && phase_in(lo, hi, (k)))
#define SEAM(k) do { if (IN(k) && IN((k) + 1)) xcd_barrier_fill(bar, F0, fs); } while (0)
#define INC(k) ((((unsigned long long)PHASE_MASK >> (9 + (k))) & 1ull) && phase_in(lo, hi, pb + (k)))
#define SEAMC(k) do { if (lo <= pb + (k) && pb + (k) + 1 < hi) xcd_barrier_fill(bar, F0, fs); } while (0)

#ifndef REPEAT_MASK
#define REPEAT_MASK 0ull
#endif
#define NREP(k) ((((unsigned long long)REPEAT_MASK >> (k)) & 1ull) ? 2 : 1)
    int fs = 0;
    if (IN(0)) { p_prologue(F0); } SEAM(0);
    if (IN(1)) { p_kv_a(F0); xcd_barrier_fill(bar, F0, fs); p_kv_b(F0, 0); } SEAM(1);
    for (int l = 0; l < 2; ++l) {
        if (l == 0) {
            if (IN(2)) { const Frame F = relaunder(F0); gemm_plain(F, WSP(bf16_t, WS_XB), 1024, WSP(bf16_t, WS_W1CAT), NTOK, 1024, 1024, WSP(bf16_t, WS_U), 1024); } SEAM(2);
            if (IN(3)) { p_pool_hln(F0); } SEAM(3);
            if (IN(4)) { const Frame F = relaunder(F0);
                GemmD g{WSP(bf16_t, WS_PQT), WSP(bf16_t, WS_UN), 128, 512, 128, 128, 128};
                SchedB S = mk_sched(F, 32, 1, 16, 4, 0, (unsigned)256 * 128 * 2, (unsigned)SEQ * 512 * 2, (unsigned)128 * 2, 0, (unsigned)256 * 512 * 2);
                EpiBf16 E{WSP(bf16_t, WS_ZT), 4096, 1, (unsigned)256 * 4096, 0};
                gemm_phase<EpiBf16, SchedB>(F.lds, g, S, E, F.wave);
            } SEAM(4);
            if (IN(5)) { const Frame F = relaunder(F0);
                GemmD g{WSP(bf16_t, WS_W1DFT), WSP(bf16_t, WS_ZT), 128, 64, 128, (unsigned)128 * 4096 * 2, 128};
                SchedB S = mk_sched(F, 32, 1, 32, 1, 0, 0, (unsigned)256 * 4096 * 2, 0, 0, (unsigned)256 * 64 * 2);
                EpiFft1 E{WSP(bf16_t, WS_YP), WSP(float, WS_TW)};
                gemm_phase<EpiFft1, SchedB>(F.lds, g, S, E, F.wave);
            } SEAM(5);
            if (IN(6)) { const Frame F = relaunder(F0);
                GemmD g{WSP(bf16_t, WS_W2DFT), WSP(bf16_t, WS_YP), 128, 128, 128, 128, 128};
                SchedB S = mk_sched(F, 32, 1, 32, 1, 0, 0, (unsigned)8192 * 128 * 2, 0, 0, (unsigned)256 * 128 * 2);
                EpiFft2 E{WSP(bf16_t, WS_YCAT)};
                gemm_phase<EpiFft2, SchedB>(F.lds, g, S, E, F.wave);
            } SEAM(6);
            if (IN(7)) { const Frame F = relaunder(F0); gemm_plain(F, WSP(bf16_t, WS_YCAT), 1024, WSP(bf16_t, WS_PFWOUT), NTOK, 1024, 1024, WSP(bf16_t, WS_H0), 1024); } SEAM(7);
            if (IN(8)) { p_ln<0, false, false>(F0, nullptr, (bf16_t*)(F0.ws + WS_H0), 0, 0); } SEAM(8);
        } else {
            if (IN(19)) { const Frame F = relaunder(F0);
                { GemmD g{WSP(bf16_t, WS_XB), WSP(bf16_t, WS_HGWIN), 1024, 1024, 128, 128, 1024};
                  SchedB S = mk_sched(F, 1, NTOK / 256, 12, 1, 0, 0, 0, 0, (unsigned)256 * 1024 * 2, (unsigned)256 * 1024 * 2);
                  EpiProjA E{WSP(bf16_t, WS_PROJ)};
                  gemm_phase<EpiProjA, SchedB>(F.lds, g, S, E, F.wave); }
                { GemmD g{WSP(bf16_t, WS_XB), WSP(bf16_t, WS_HGWIN) + (size_t)3072 * 1024, 1024, 1024, 128, 128, 1024};
                  SchedB S = mk_sched(F, 1, NTOK / 256, 8, 1, 0, 0, 0, 0, (unsigned)256 * 1024 * 2, (unsigned)256 * 1024 * 2);
                  EpiProjB E{WSP(bf16_t, WS_PROJ), WSP(float, WS_LB1)};
                  gemm_phase<EpiProjB, SchedB>(F.lds, g, S, E, F.wave); }
            } SEAM(19);
            if (IN(20)) { { p_gla(F0); } } SEAM(20);
            if (IN(21)) { p_gate(F0); p_kv_b(F0, 1); } SEAM(21);
            if (IN(22)) { const Frame F = relaunder(F0); gemm_plain(F, WSP(bf16_t, WS_OF), 1024, WSP(bf16_t, WS_HGWOUT), NTOK, 1024, 1024, WSP(bf16_t, WS_OB), 1024); } SEAM(22);
            if (IN(23)) { p_ln<0, false, false>(F0, nullptr, (bf16_t*)(F0.ws + WS_OB), 1, 0); if (F0.G != 256) { __syncthreads(); moe_convert(F0, 1); } } SEAM(23);
        }
        const int pb = l ? 24 : 9;
        if (INC(1)) { const Frame F = relaunder(F0);
            GemmD g{WSP(bf16_t, WS_XB), WSP(bf16_t, WS_KM), 1024, 1024, 128, 128, 1024};
            SchedB S = mk_sched(F, 32, 16, 1, 4, (unsigned)SEQ * 1024 * 2, 0, (unsigned)4 * 256 * 1024 * 2, (unsigned)256 * 1024 * 2, (unsigned)256 * 1024 * 2, 0);
            EpiSoftmax E{WSP(bf16_t, WS_SC), 0.0625f, (LAS float*)(F.lds + STAGE_BYTES)};
            gemm_phase<EpiSoftmax, SchedB>(F.lds, g, S, E, F.wave);
        } SEAMC(1);
        if (INC(3)) { const Frame F = relaunder(F0);
            GemmD g{WSP(bf16_t, WS_SC), WSP(bf16_t, WS_VW), 1024, 1024, 128, 128, 1024};
            SchedB S = mk_sched(F, 8, 16, 4, 1, (unsigned)SEQ * 1024 * 2, 0, (unsigned)1024 * 1024 * 2, 0, (unsigned)256 * 1024 * 2, (unsigned)256 * 1024 * 2);
            EpiBf16 E{WSP(bf16_t, WS_HX), 1024, 1, (unsigned)SEQ * 1024, 0};
            gemm_phase<EpiBf16, SchedB>(F.lds, g, S, E, F.wave);
        } SEAMC(3);
        if (INC(5)) { p_ln<1, false, false>(F0, nullptr, (bf16_t*)(F0.ws + WS_HX), l, 1); } SEAMC(5);
        if (INC(6)) { p_dispatch(F0); } SEAMC(6);
        if (INC(7)) { const Frame F = relaunder(F0);
            const int ntile = __builtin_amdgcn_readfirstlane(WSP(int, WS_TILEEXP)[320]);
            GemmD g{WSP(bf16_t, WS_XB), l ? (bf16_t*)F.out : WSP(bf16_t, WS_WGU), 1024, 1024, 128, 128, 1024};
            const bool rd = moe_redeal(ntile, F.G);
            const int nmain = rd ? (ntile * 4 / F.G) * (F.G / 4) : ntile;
            SchedMoe<true> S{nmain, 4, F.G, F.vb, WSP(int, WS_TILEEXP), (unsigned)256 * 1024 * 2, (unsigned)256 * 1024 * 2, (unsigned)1048576 * 2, WSP(int, WS_ROWTOK)};
            EpiGU<false> E{WSP(bf16_t, WS_HID), nullptr};
            gemm_phase<EpiGU<false>, SchedMoe<true>>(F.lds, g, S, E, F.wave);
            if (l == 0 && !rd) moe_tail_convert(F, ntile, 0);
        } SEAMC(7);
        if (INC(8)) { const Frame F = relaunder(F0);
            const int ntile = __builtin_amdgcn_readfirstlane(WSP(int, WS_TILEEXP)[320]);
            GemmD g{WSP(bf16_t, WS_HID), l ? (bf16_t*)F.out + (size_t)33554432 : WSP(bf16_t, WS_WDN), 512, 512, 128, 128, 512};
            EpiDown E{WSP(bf16_t, WS_XSY), WSP(float, WS_GPOS)};
            if (moe_redeal(ntile, F.G)) {
                const int R = ntile * 4 / F.G, rem = ntile * 4 - R * F.G, T0 = R * (F.G / 4), c = F.vb;
                unsigned* cnt = (unsigned*)(F.ws + WS_CTL) + XB_REDEAL + l;
                if (c < rem) {
                    GemmD gg{WSP(bf16_t, WS_XB), l ? (bf16_t*)F.out : WSP(bf16_t, WS_WGU), 1024, 1024, 128, 128, 1024};
                    SchedMoeTwo<true> SG{T0, 4, -2 - c, -1, WSP(int, WS_TILEEXP), (unsigned)256 * 1024 * 2, (unsigned)256 * 1024 * 2, (unsigned)1048576 * 2, WSP(int, WS_ROWTOK)};
                    EpiGU<true> EG{WSP(bf16_t, WS_HID), cnt};
                    gemm_phase<EpiGU<true>, SchedMoeTwo<true>>(F.lds, gg, SG, EG, F.wave);
                }
                { SchedMoe<false> SA{T0, 4, F.G, c, WSP(int, WS_TILEEXP), (unsigned)256 * 512 * 2, (unsigned)256 * 512 * 2, (unsigned)524288 * 2, nullptr};
                  SchedMoeLim<false> SL{SA, (R - 1) * F.G};
                  gemm_phase<EpiDown, SchedMoeLim<false>>(F.lds, g, SL, E, F.wave); }
                if (F.wave == 0 && F.lane == 0) { unsigned* bw = (unsigned*)(F.ws + WS_CTL); XB_SPIN(xb_ld(cnt) < (unsigned)(rem * 8), bw); __builtin_amdgcn_fence(__ATOMIC_ACQUIRE, "agent"); }
                __syncthreads();
                { const int j = c - rem;
                  const int code0 = c >= rem ? (R - 1) * F.G + c : -1;
                  const int code1 = (c >= rem && j < 2 * rem) ? (j < rem ? (R - 1) * F.G + j : -2 - (j - rem)) : -1;
                  SchedMoeTwo<false> SB{T0, 4, code0, code1, WSP(int, WS_TILEEXP), (unsigned)256 * 512 * 2, (unsigned)256 * 512 * 2, (unsigned)524288 * 2, nullptr};
                  gemm_phase<EpiDown, SchedMoeTwo<false>>(F.lds, g, SB, E, F.wave); }
                if (l == 0) {
                    const int nC = F.G - 3 * rem;
                    if (c >= 3 * rem) moe_convert_range(F, 0, nC * TAIL_RC, c - 3 * rem, nC);
                    else if (c < rem) moe_convert_range(F, nC * TAIL_RC, rem * TAIL_RA, c, rem);
                }
            } else {
                SchedMoe<false> S{ntile, 4, F.G, F.vb, WSP(int, WS_TILEEXP), (unsigned)256 * 512 * 2, (unsigned)256 * 512 * 2, (unsigned)524288 * 2, nullptr};
                gemm_phase<EpiDown, SchedMoe<false>>(F.lds, g, S, E, F.wave);
                if (l == 0) moe_tail_convert(F, ntile, 1);
            }
        } SEAMC(8);
        if (INC(9)) { if (l == 0) p_ln<2, false, false>(F0, nullptr, (bf16_t*)(F0.ws + WS_XSY), l, 2); else p_ln<2, false, true>(F0, nullptr, (bf16_t*)(F0.ws + WS_XSY), l, 2); } SEAMC(9);
    }
#undef IN
#undef SEAM
#undef INC
#undef SEAMC
}

extern "C" void kernel_launch(void* const* d_in, const int* in_sizes, int n_in, void* d_out, int out_size, void* d_ws, size_t ws_size, hipStream_t stream) {
    static int grid = 0;
    if (grid == 0) {
        if (n_in != 24 || out_size != NTOK * DM || ws_size < WS_END) { fprintf(stderr, "kernel_launch: unexpected shapes (n_in %d, out %d, ws %zu, need %zu)\n", n_in, out_size, ws_size, (size_t)WS_END); grid = -1; return; }
        int dev = 0, cus = 0;
        if (hipGetDevice(&dev) != hipSuccess || hipDeviceGetAttribute(&cus, hipDeviceAttributeMultiprocessorCount, dev) != hipSuccess) { grid = -1; return; }
        if (hipFuncSetAttribute((const void*)mk_fwd, hipFuncAttributeMaxDynamicSharedMemorySize, LDS_BYTES) != hipSuccess) { fprintf(stderr, "kernel_launch: hipFuncSetAttribute failed\n"); grid = -1; return; }
        int per_cu = 0;
        if (hipOccupancyMaxActiveBlocksPerMultiprocessor(&per_cu, (const void*)mk_fwd, NTHR, LDS_BYTES) != hipSuccess || per_cu < 1) fprintf(stderr, "kernel_launch: occupancy query reports %d\n", per_cu);
        (void)hipGetLastError();
        grid = cus;
    }
    if (grid < 0) return;
    (void)hipMemsetAsync((char*)d_ws + WS_CTL, 0, CTL_ZERO_BYTES, stream);
    Args a{};
    for (int i = 0; i < 24; ++i) a.in[i] = (const float*)d_in[i];
    a.out = (float*)d_out; a.ws = (unsigned char*)d_ws;
#if ONE_LAUNCH
    a.ph_lo = 0; a.ph_hi = N_PHASES;
    hipLaunchKernelGGL(mk_fwd, dim3(grid), dim3(NTHR), LDS_BYTES, stream, a);
#else
    for (int p = 0; p < N_PHASES; ++p) { a.ph_lo = p; a.ph_hi = p + 1; hipLaunchKernelGGL(mk_fwd, dim3(grid), dim3(NTHR), LDS_BYTES, stream, a); }
#endif
}
```
